# Optimizing an MI355X kernel written in HIP

```python
import math
import jax, jax.numpy as jnp
from jax import lax
import numpy as np

D_MODEL = 1024
BATCH = 2
SEQ = 8192
DEPTH = 1
DEC_BATCH = 8
DEC_SEQ = 8192
PAST_LEN = 128

MIX_WIDTH = D_MODEL
ATTN_WIDTH = MIX_WIDTH // 2
REC_WIDTH = MIX_WIDTH - ATTN_WIDTH
ATTN_HEADS = 4
ATTN_VDIM = ATTN_WIDTH // ATTN_HEADS
ATTN_QKDIM = ATTN_VDIM // 2
REC_HEADS = 4
REC_KDIM = REC_WIDTH // REC_HEADS
REC_VDIM = REC_WIDTH // REC_HEADS
D_FF = ((8 * D_MODEL // 3 + 127) // 128) * 128
CONV_WIDTH = 3
Q_BLOCK = 128
CHUNK = 64
NORM_EPS = 1e-6
IN_WIDTH = 3 * ATTN_WIDTH + 5 * REC_WIDTH

kernel_name = "hymba_diffattn_hgrn2_convffn_encoder"


def rms_norm(x, w, eps=NORM_EPS):
    x32 = x.astype(jnp.float32)
    y = x32 * lax.rsqrt(jnp.mean(x32 * x32, axis=-1, keepdims=True) + eps)
    return (y * w.astype(jnp.float32)).astype(x.dtype)


def alibi_slopes(n_heads):
    start = 2.0 ** (-8.0 / n_heads)
    return jnp.asarray(np.array([start ** (i + 1) for i in range(n_heads)], dtype=np.float32))


def diff_attention(q, k, v, lam, slopes):
    B, H, _, L, dk = q.shape
    nb = L // Q_BLOCK
    qb = q.reshape(B, H, 2, nb, Q_BLOCK, dk).transpose(3, 0, 1, 2, 4, 5)
    qpos = jnp.arange(L, dtype=jnp.int32).reshape(nb, Q_BLOCK)
    kpos = jnp.arange(L, dtype=jnp.int32)
    scale = dk ** -0.5

    def block(args):
        qblk, pos = args
        s = jnp.einsum('bhjqd,bhjkd->bhjqk', qblk, k) * scale
        dist = jnp.abs(pos[:, None] - kpos[None, :]).astype(jnp.float32)
        s = s - slopes[None, :, None, None, None] * dist[None, None, None]
        p = jax.nn.softmax(s, axis=-1)
        a = p[:, :, 0] - lam * p[:, :, 1]
        return jnp.einsum('bhqk,bhkv->bhqv', a, v)

    o = lax.map(block, (qb, qpos))
    return o.transpose(1, 0, 3, 2, 4).reshape(B, L, H, -1)


def gla_chunk_scan(q, k, v, logf):
    B, H, L, K = q.shape
    V = v.shape[-1]
    n = L // CHUNK

    def to_chunks(t):
        return t.reshape(B, H, n, CHUNK, t.shape[-1]).transpose(2, 0, 1, 3, 4)

    mask = jnp.tril(jnp.ones((CHUNK, CHUNK), dtype=bool))

    def step(S, xs):
        qc, kc, vc, lfc = xs
        G = jnp.cumsum(lfc, axis=-2)
        o_inter = jnp.einsum('bhtk,bhkv->bhtv', qc * jnp.exp(G), S)
        diff = G[:, :, :, None, :] - G[:, :, None, :, :]
        decay = jnp.exp(jnp.where(mask[:, :, None], diff, -jnp.inf))
        A = jnp.einsum('bhtk,bhsk,bhtsk->bhts', qc, kc, decay)
        o_intra = jnp.einsum('bhts,bhsv->bhtv', A, vc)
        G_last = G[:, :, -1:, :]
        S_new = (jnp.exp(G_last[:, :, 0, :])[..., None] * S
                 + jnp.einsum('bhsk,bhsv->bhkv', kc * jnp.exp(G_last - G), vc))
        return S_new, o_inter + o_intra

    S0 = jnp.zeros((B, H, K, V), jnp.float32)
    _, o = lax.scan(step, S0, (to_chunks(q), to_chunks(k), to_chunks(v), to_chunks(logf)))
    return o.transpose(1, 2, 0, 3, 4).reshape(B, H, L, V)


def encoder_layer(x, l, norm_mix_w, w_in, q_norm_w, k_norm_w, lambda_q1, lambda_k1,
                  lambda_q2, lambda_k2, attn_out_norm_w, lb_fwd, lb_bwd, rec_out_norm_w,
                  w_out, norm_ffn_w, w_up, conv_w, conv_b, w_down):
    f32 = jnp.float32
    B, L, _ = x.shape
    h = rms_norm(x, norm_mix_w)
    proj = h @ w_in
    sizes = [ATTN_WIDTH] * 3 + [REC_WIDTH] * 5
    idx = np.cumsum(sizes)[:-1].tolist()
    aq, ak, av, rq, rf_f, rf_b, ri, rg = jnp.split(proj, idx, axis=-1)

    aq = rms_norm(aq.reshape(B, L, ATTN_HEADS, 2, ATTN_QKDIM), q_norm_w)
    ak = rms_norm(ak.reshape(B, L, ATTN_HEADS, 2, ATTN_QKDIM), k_norm_w)
    aq = aq.transpose(0, 2, 3, 1, 4).astype(f32)
    ak = ak.transpose(0, 2, 3, 1, 4).astype(f32)
    av = av.reshape(B, L, ATTN_HEADS, ATTN_VDIM).transpose(0, 2, 1, 3).astype(f32)
    lam_init = 0.8 - 0.6 * math.exp(-0.3 * l)
    lam = (jnp.exp(jnp.sum(lambda_q1.astype(f32) * lambda_k1.astype(f32)))
           - jnp.exp(jnp.sum(lambda_q2.astype(f32) * lambda_k2.astype(f32))) + lam_init)
    ao = diff_attention(aq, ak, av, lam, alibi_slopes(ATTN_HEADS))
    ao = rms_norm(ao, attn_out_norm_w) * (1.0 - lam_init)
    ao = ao.reshape(B, L, ATTN_WIDTH).astype(x.dtype)

    def heads(t):
        return t.reshape(B, L, REC_HEADS, -1).transpose(0, 2, 1, 3).astype(f32)

    rq_h = heads(jax.nn.silu(rq))
    ri_h = heads(ri)

    def direction(f_logits, lb_table, reverse):
        lb = jnp.cumsum(jax.nn.softmax(lb_table.astype(f32), axis=0), axis=0)[l]
        f = heads(lb + (1.0 - lb) * jax.nn.sigmoid(f_logits.astype(f32)))
        logf = jnp.log(f)
        kk = 1.0 - f
        qq, vv = rq_h, ri_h
        if reverse:
            qq, kk, vv, logf = (jnp.flip(t, axis=2) for t in (qq, kk, vv, logf))
        o = gla_chunk_scan(qq, kk, vv, logf)
        return jnp.flip(o, axis=2) if reverse else o

    ro = direction(rf_f, lb_fwd, False) + direction(rf_b, lb_bwd, True)
    ro = ro.transpose(0, 2, 1, 3)
    ro = rms_norm(ro, rec_out_norm_w) * jax.nn.silu(
        rg.reshape(B, L, REC_HEADS, REC_VDIM).astype(f32))
    ro = ro.reshape(B, L, REC_WIDTH).astype(x.dtype)

    x = x + jnp.concatenate([ao, ro], axis=-1) @ w_out

    h = rms_norm(x, norm_ffn_w)
    u = h @ w_up
    pad = CONV_WIDTH // 2
    u_pad = jnp.pad(u, ((0, 0), (pad, pad), (0, 0)))
    c = conv_b
    for j in range(CONV_WIDTH):
        c = c + u_pad[:, j:j + L] * conv_w[j]
    gate, up = jnp.split(c, 2, axis=-1)
    x = x + (jax.nn.silu(gate) * up) @ w_down
    return x


def setup_inputs(seed: int = 0) -> dict:
    key = jax.random.key(seed)
    ks = jax.random.split(key, 24)
    f32 = jnp.float32

    def nrm(k, shape, scale):
        return jax.random.normal(k, shape, f32) * scale

    return {
        "x_prompt": nrm(ks[0], (BATCH, SEQ, D_MODEL), 1.0),
        "x_sample": nrm(ks[1], (DEC_BATCH, DEC_SEQ, D_MODEL), 1.0),
        "norm_mix_w": 1.0 + nrm(ks[2], (DEPTH, D_MODEL), 0.02),
        "w_in": nrm(ks[3], (DEPTH, D_MODEL, IN_WIDTH), D_MODEL ** -0.5),
        "q_norm_w": 1.0 + nrm(ks[4], (DEPTH, ATTN_QKDIM), 0.02),
        "k_norm_w": 1.0 + nrm(ks[5], (DEPTH, ATTN_QKDIM), 0.02),
        "lambda_q1": nrm(ks[6], (DEPTH, ATTN_QKDIM), 0.1),
        "lambda_k1": nrm(ks[7], (DEPTH, ATTN_QKDIM), 0.1),
        "lambda_q2": nrm(ks[8], (DEPTH, ATTN_QKDIM), 0.1),
        "lambda_k2": nrm(ks[9], (DEPTH, ATTN_QKDIM), 0.1),
        "attn_out_norm_w": 1.0 + nrm(ks[10], (DEPTH, ATTN_VDIM), 0.02),
        "lb_fwd": nrm(ks[11], (DEPTH + 1, REC_WIDTH), 0.5),
        "lb_bwd": nrm(ks[12], (DEPTH + 1, REC_WIDTH), 0.5),
        "rec_out_norm_w": 1.0 + nrm(ks[13], (DEPTH, REC_VDIM), 0.02),
        "w_out": nrm(ks[14], (DEPTH, MIX_WIDTH, D_MODEL), MIX_WIDTH ** -0.5),
        "norm_ffn_w": 1.0 + nrm(ks[15], (DEPTH, D_MODEL), 0.02),
        "w_up": nrm(ks[16], (DEPTH, D_MODEL, 2 * D_FF), D_MODEL ** -0.5),
        "conv_w": nrm(ks[17], (DEPTH, CONV_WIDTH, 2 * D_FF), CONV_WIDTH ** -0.5),
        "conv_b": nrm(ks[18], (DEPTH, 2 * D_FF), 0.02),
        "w_down": nrm(ks[19], (DEPTH, D_FF, D_MODEL), D_FF ** -0.5),
    }


def run_trunk(x, norm_mix_w, w_in, q_norm_w, k_norm_w, lambda_q1, lambda_k1, lambda_q2,
              lambda_k2, attn_out_norm_w, lb_fwd, lb_bwd, rec_out_norm_w, w_out,
              norm_ffn_w, w_up, conv_w, conv_b, w_down):
    for l in range(DEPTH):
        x = encoder_layer(x, l, norm_mix_w[l], w_in[l], q_norm_w[l], k_norm_w[l],
                          lambda_q1[l], lambda_k1[l], lambda_q2[l], lambda_k2[l],
                          attn_out_norm_w[l], lb_fwd, lb_bwd, rec_out_norm_w[l], w_out[l],
                          norm_ffn_w[l], w_up[l], conv_w[l], conv_b[l], w_down[l])
    return x


def reference(x_prompt, x_sample, norm_mix_w, w_in, q_norm_w, k_norm_w, lambda_q1,
              lambda_k1, lambda_q2, lambda_k2, attn_out_norm_w, lb_fwd, lb_bwd,
              rec_out_norm_w, w_out, norm_ffn_w, w_up, conv_w, conv_b, w_down):
    y_prompt = run_trunk(x_prompt, norm_mix_w, w_in, q_norm_w, k_norm_w, lambda_q1,
                         lambda_k1, lambda_q2, lambda_k2, attn_out_norm_w, lb_fwd, lb_bwd,
                         rec_out_norm_w, w_out, norm_ffn_w, w_up, conv_w, conv_b, w_down)
    y_sample = run_trunk(x_sample, norm_mix_w, w_in, q_norm_w, k_norm_w, lambda_q1,
                         lambda_k1, lambda_q2, lambda_k2, attn_out_norm_w, lb_fwd, lb_bwd,
                         rec_out_norm_w, w_out, norm_ffn_w, w_up, conv_w, conv_b, w_down)
    return (y_prompt, y_sample)
```

```cpp
#include <hip/hip_runtime.h>
#include <hip/hip_cooperative_groups.h>
#include <cstdio>
#include <cstdint>
namespace cg = cooperative_groups;

namespace pg8 {
#define PG8_LAS __attribute__((address_space(3)))
typedef unsigned short bf16_t;
typedef short bf16x8 __attribute__((ext_vector_type(8)));
typedef float f32x4 __attribute__((ext_vector_type(4)));
typedef unsigned u32x4 __attribute__((ext_vector_type(4)));
constexpr int BM = 256, BK = 64, HALF = 128, HTB = HALF * BK * 2  , STAGE_BYTES = 8 * HTB, NXCD = 8, WGM = 8;

__host__ __device__ __forceinline__ int lds_byte(int r, int c) { const int st = (r >> 4) * 2 + (c >> 5), rr = r & 15, cc = c & 31, ob = rr * 64 + cc * 2; return st * 1024 + (ob ^ (((ob >> 9) & 1) << 5)); }
__host__ __device__ __forceinline__ void stage_rc(int b, int& R, int& C) { const int st = b / 1024, sb = b % 1024, swz = sb ^ (((sb >> 9) & 1) << 5); R = (st >> 1) * 16 + swz / 64; C = (st & 1) * 32 + (swz % 64) / 2; }
__host__ __device__ __forceinline__ int perm32(int rho) { const int n = rho >> 4, i = rho & 15; return 8 * (i >> 2) + 4 * n + (i & 3); }

struct Unit { int pm, pn; };
struct Gemm { const bf16_t* A; const bf16_t* Bt; int M, N, K; };

struct StaticOrder {
    int nM, nN, nwg, G, c;
    __host__ __device__ void init(int M, int N, int G_, int c_) { nM = M / BM; nN = N / BM; nwg = nM * nN; G = G_; c = c_; }
    __host__ __device__ bool next(int i, Unit& u) const {
        const long L = (long)i * G + c; if (L >= nwg) return false;
        int wgid = (int)L; { const int q = nwg / NXCD, r = nwg % NXCD, xcd = wgid % NXCD, off = wgid / NXCD; wgid = (xcd < r ? xcd * (q + 1) : r * (q + 1) + (xcd - r) * q) + off; }
        const int nig = WGM * nN, gid = wgid / nig, fm = gid * WGM, gsz = (nM - fm) < WGM ? (nM - fm) : WGM;
        u.pm = fm + ((wgid % nig) % gsz); u.pn = (wgid % nig) / gsz; return true;
    }
    int ovl = 0;
    __device__ __forceinline__ long arow(const Unit& u) const { return ovl ? (long)(u.pm / 33) * 8192 + 254 * (u.pm % 33) - 1 : (long)u.pm * BM; }
    __device__ __forceinline__ void a_ready(const Unit&) const {}
    __device__ __forceinline__ void done(const Unit&) const {}
};

__device__ __forceinline__ unsigned cvt_pk_bf16(float lo, float hi) { unsigned r; asm volatile("v_cvt_pk_bf16_f32 %0, %1, %2" : "=v"(r) : "v"(lo), "v"(hi)); return r; }
typedef float f32x2 __attribute__((ext_vector_type(2)));
template <class Epi, class Sched, bool ALIGN_EPI = false, bool SP2 = false>
__device__ __forceinline__ void gemm_phase(PG8_LAS unsigned char* lds, const Gemm g, const Sched& S, const Epi& E) {
    int tid = threadIdx.x; asm volatile("" : "+v"(tid));
    const int wid = __builtin_amdgcn_readfirstlane(tid >> 6), lane = tid & 63, wr = wid >> 2, wc = wid & 3, fr = lane & 15, fq = lane >> 4;
    const int K = g.K, nt = K / BK;
    unsigned voffA[2], voffB[2];
#pragma unroll
    for (int i = 0; i < 2; ++i) { int R, C; stage_rc(tid * 16 + i * 8192, R, C); const int Rb = Epi::PERM ? ((R & ~31) + perm32(R & 31)) : R;
        voffA[i] = (unsigned)(R * K + C) * 2u; voffB[i] = (unsigned)(Rb * K + C) * 2u; }
    const size_t kstep = (size_t)(BK * 2);
    const size_t hstep = (size_t)HALF * K * 2;
    const size_t tstep = 2 * hstep;
    const unsigned ldsw = (unsigned)wid * 1024u;
    const int aoff = lds_byte(wr * 64 + fr, fq * 8), boff = lds_byte(wc * 32 + fr, fq * 8);
#define PG8_SA(b, h) (((b) * 2 + (h)) * HTB)
#define PG8_SB(b, h) ((4 + (b) * 2 + (h)) * HTB)
#define PG8_STAGE(bufoff, gbase, voff) do { _Pragma("unroll") for (int _i = 0; _i < 2; ++_i) \
        __builtin_amdgcn_global_load_lds((const unsigned*)((const char*)(gbase) + (voff)[_i]), (PG8_LAS unsigned*)(lds + (bufoff) + ldsw + _i * 8192), 16, 0, 0); } while (0)
#define PG8_LDA(dst, b, h) do { _Pragma("unroll") for (int m = 0; m < 4; ++m) _Pragma("unroll") for (int k = 0; k < 2; ++k) dst[m][k] = *(const PG8_LAS bf16x8*)(lds + PG8_SA(b, h) + aoff + m * 2048 + k * 1024); } while (0)
#define PG8_LDB(dst, b, h) do { _Pragma("unroll") for (int n = 0; n < 2; ++n) _Pragma("unroll") for (int k = 0; k < 2; ++k) dst[n][k] = *(const PG8_LAS bf16x8*)(lds + PG8_SB(b, h) + boff + n * 2048 + k * 1024); } while (0)
#define PG8_MMA(ai, bj, At, Bt) do { __builtin_amdgcn_s_setprio(1); _Pragma("unroll") for (int m = 0; m < 4; ++m) _Pragma("unroll") for (int n = 0; n < 2; ++n) _Pragma("unroll") for (int k = 0; k < 2; ++k) \
        acc[ai][bj][m][n] = __builtin_amdgcn_mfma_f32_16x16x32_bf16(Bt[n][k], At[m][k], acc[ai][bj][m][n], 0, 0, 0); __builtin_amdgcn_s_setprio(0); } while (0)
#define PG8_WAIT_V(n) asm volatile("s_waitcnt vmcnt(" #n ")" ::: "memory")
#define PG8_WAIT_L(n) asm volatile("s_waitcnt lgkmcnt(" #n ")" ::: "memory")
#define PG8_BAR __builtin_amdgcn_s_barrier()
#define PG8_SCHED __builtin_amdgcn_sched_barrier(0)
    Unit cur, nxt; int ui = 0;
    if (!S.next(0, cur)) return;
    f32x4 acc[2][2][4][2];
#pragma unroll
    for (int a = 0; a < 2; ++a)
#pragma unroll
        for (int b = 0; b < 2; ++b)
#pragma unroll
            for (int m = 0; m < 4; ++m)
#pragma unroll
                for (int n = 0; n < 2; ++n) acc[a][b][m][n] = (f32x4){0.f, 0.f, 0.f, 0.f};
    bf16x8 At[4][2], B0[2][2], B1[2][2];
    const long rowb = (long)K * 2;
    const char* cA = (const char*)g.A + S.arow(cur) * rowb; const char* cB = (const char*)g.Bt + (size_t)cur.pn * tstep;
    S.a_ready(cur);
    if constexpr (SP2) {
        PG8_STAGE(PG8_SB(0, 0), cB, voffB); PG8_STAGE(PG8_SB(0, 1), cB + hstep, voffB); PG8_STAGE(PG8_SA(0, 0), cA, voffA); PG8_STAGE(PG8_SA(0, 1), cA + hstep, voffA);
        if (wr == 1) PG8_BAR;
        PG8_WAIT_V(2); PG8_BAR;
        PG8_STAGE(PG8_SB(1, 0), cB + kstep, voffB); PG8_STAGE(PG8_SA(1, 0), cA + kstep, voffA); PG8_STAGE(PG8_SB(1, 1), cB + hstep + kstep, voffB);
        PG8_WAIT_V(6); PG8_BAR;
    } else {
        PG8_STAGE(PG8_SB(0, 0), cB, voffB); PG8_STAGE(PG8_SA(0, 0), cA, voffA); PG8_STAGE(PG8_SB(0, 1), cB + hstep, voffB); PG8_STAGE(PG8_SA(0, 1), cA + hstep, voffA);
        if (wr == 1) PG8_BAR;
        PG8_WAIT_V(4); PG8_BAR;
        PG8_STAGE(PG8_SB(1, 0), cB + kstep, voffB); PG8_STAGE(PG8_SA(1, 0), cA + kstep, voffA); PG8_STAGE(PG8_SB(1, 1), cB + hstep + kstep, voffB);
        PG8_WAIT_V(6); PG8_BAR;
    }
    for (;;) {
        const bool has_next = S.next(ui + 1, nxt);
        const char* nA = has_next ? (const char*)g.A + S.arow(nxt) * rowb : cA; const char* nB = has_next ? (const char*)g.Bt + (size_t)nxt.pn * tstep : cB;
        for (int t = 0; t < nt; t += 2) {
            const bool last = (t == nt - 2);
            const char* a1 = cA + (size_t)(t + 1) * kstep;
            const char* a2 = last ? nA : cA + (size_t)(t + 2) * kstep; const char* b2 = last ? nB : cB + (size_t)(t + 2) * kstep;
            const char* a3 = a2 + kstep; const char* b3 = b2 + kstep;
            if (last && has_next) S.a_ready(nxt);
            if constexpr (SP2) {
            PG8_LDB(B0, 0, 0); PG8_LDB(B1, 0, 1); PG8_SCHED; PG8_LDA(At, 0, 0); PG8_STAGE(PG8_SA(1, 1), a1 + hstep, voffA);
            PG8_WAIT_V(8); PG8_WAIT_L(0); PG8_BAR; PG8_MMA(0, 0, At, B0); PG8_MMA(0, 1, At, B1); PG8_BAR; PG8_SCHED;
            PG8_LDA(At, 0, 1); PG8_STAGE(PG8_SB(0, 0), b2, voffB); PG8_STAGE(PG8_SB(0, 1), b2 + hstep, voffB); PG8_STAGE(PG8_SA(0, 0), a2, voffA);
            PG8_WAIT_V(8); PG8_WAIT_L(0); PG8_BAR; PG8_MMA(1, 0, At, B0); PG8_MMA(1, 1, At, B1); PG8_BAR; PG8_SCHED;
            PG8_LDB(B0, 1, 0); PG8_LDB(B1, 1, 1); PG8_SCHED; PG8_LDA(At, 1, 0); PG8_STAGE(PG8_SA(0, 1), a2 + hstep, voffA);
            PG8_WAIT_V(8); PG8_WAIT_L(0); PG8_BAR; PG8_MMA(0, 0, At, B0); PG8_MMA(0, 1, At, B1); PG8_BAR; PG8_SCHED;
            PG8_LDA(At, 1, 1); PG8_STAGE(PG8_SB(1, 0), b3, voffB); PG8_STAGE(PG8_SB(1, 1), b3 + hstep, voffB); PG8_STAGE(PG8_SA(1, 0), a3, voffA);
            PG8_WAIT_V(8); PG8_WAIT_L(0); PG8_BAR; PG8_MMA(1, 0, At, B0); PG8_MMA(1, 1, At, B1); PG8_BAR; PG8_SCHED;
            } else {
            PG8_LDB(B0, 0, 0); PG8_SCHED; PG8_LDA(At, 0, 0); PG8_STAGE(PG8_SA(1, 1), a1 + hstep, voffA);
            PG8_WAIT_L(8); PG8_BAR; PG8_WAIT_L(0); PG8_MMA(0, 0, At, B0); PG8_BAR; PG8_SCHED;
            PG8_LDB(B1, 0, 1); PG8_STAGE(PG8_SB(0, 0), b2, voffB);
            PG8_BAR; PG8_WAIT_L(0); PG8_MMA(0, 1, At, B1); PG8_BAR;
            PG8_LDA(At, 0, 1); PG8_STAGE(PG8_SA(0, 0), a2, voffA);
            PG8_BAR; PG8_WAIT_L(0); PG8_MMA(1, 0, At, B0); PG8_BAR; PG8_SCHED;
            PG8_STAGE(PG8_SB(0, 1), b2 + hstep, voffB);
            PG8_WAIT_V(6); PG8_BAR; PG8_MMA(1, 1, At, B1); PG8_BAR;
            PG8_LDB(B0, 1, 0); PG8_SCHED; PG8_LDA(At, 1, 0); PG8_STAGE(PG8_SA(0, 1), a2 + hstep, voffA);
            PG8_WAIT_L(8); PG8_BAR; PG8_WAIT_L(0); PG8_MMA(0, 0, At, B0); PG8_BAR; PG8_SCHED;
            PG8_LDB(B1, 1, 1); PG8_STAGE(PG8_SB(1, 0), b3, voffB);
            PG8_BAR; PG8_WAIT_L(0); PG8_MMA(0, 1, At, B1); PG8_BAR;
            PG8_LDA(At, 1, 1); PG8_STAGE(PG8_SA(1, 0), a3, voffA);
            PG8_BAR; PG8_WAIT_L(0); PG8_MMA(1, 0, At, B0); PG8_BAR; PG8_SCHED;
            PG8_STAGE(PG8_SB(1, 1), b3 + hstep, voffB);
            PG8_WAIT_V(6); PG8_BAR; PG8_MMA(1, 1, At, B1); PG8_BAR;
            }
        }
        if constexpr (ALIGN_EPI) { if (wr == 0) PG8_BAR; }
        if constexpr (!Epi::AFTER_DRAIN) { E(acc, cur, wr, wc, fr, fq); S.done(cur); }
        if (!has_next) break;
#pragma unroll
        for (int a = 0; a < 2; ++a)
#pragma unroll
            for (int b = 0; b < 2; ++b)
#pragma unroll
                for (int m = 0; m < 4; ++m)
#pragma unroll
                    for (int n = 0; n < 2; ++n) acc[a][b][m][n] = (f32x4){0.f, 0.f, 0.f, 0.f};
        cur = nxt; cA = nA; cB = nB; ++ui;
        if constexpr (ALIGN_EPI) { if (wr == 1) PG8_BAR; }
    }
    PG8_WAIT_V(0);
    if constexpr (!ALIGN_EPI) { if (wr == 0) PG8_BAR; }
    PG8_BAR;
    if constexpr (Epi::AFTER_DRAIN) { E.fused(acc, cur, wr, wc, fr, fq, lds, wid, lane); S.done(cur); }
#undef PG8_SA
#undef PG8_SB
#undef PG8_STAGE
#undef PG8_LDA
#undef PG8_LDB
#undef PG8_MMA
#undef PG8_WAIT_V
#undef PG8_WAIT_L
#undef PG8_BAR
#undef PG8_SCHED
}
}

constexpr int DM = 1024, SEQL = 8192, NSEQ = 10, MTOK = NSEQ * SEQL, INW = 4096, DFF = 2816, DFF2 = 5632, NHEAD = 4;
constexpr int MPROMPT = 2 * SEQL;
constexpr float NORM_EPS = 1e-6f;
constexpr float LOG2E = 1.4426950408889634f;
typedef unsigned short bf16_t;
typedef short bf16x8 __attribute__((ext_vector_type(8)));
typedef short s16x4 __attribute__((ext_vector_type(4)));
typedef float f32x4 __attribute__((ext_vector_type(4)));
typedef float f32x16 __attribute__((ext_vector_type(16)));
typedef unsigned u32x4 __attribute__((ext_vector_type(4)));
typedef unsigned u32x2 __attribute__((ext_vector_type(2)));
typedef float f32x2 __attribute__((ext_vector_type(2)));
#define LAS __attribute__((address_space(3)))

constexpr size_t MiB = 1u << 20;
constexpr size_t WS_CTL = 0;
constexpr size_t WS_WIN = 1 * MiB;
constexpr size_t WS_WOUT = 9 * MiB;
constexpr size_t WS_WUP = 11 * MiB;
constexpr size_t WS_WDOWN = 22 * MiB;
constexpr size_t WS_XN = 32 * MiB;
constexpr size_t WS_PROJ = 192 * MiB;
constexpr size_t WS_OF = 832 * MiB;
constexpr size_t WS_OB = 912 * MiB;
constexpr size_t WS_U = 192 * MiB;
constexpr size_t WS_ACT = 192 * MiB;
constexpr size_t WS_END = 992 * MiB;
constexpr int NSLAB = 2, SLABROWS = MTOK / NSLAB;

constexpr int LDS_BYTES = 143360;
constexpr int LDS_MISC = 131072 + 8192;

__device__ __forceinline__ unsigned cvtpk(float lo, float hi) { unsigned r; asm("v_cvt_pk_bf16_f32 %0, %1, %2" : "=v"(r) : "v"(lo), "v"(hi)); return r; }
__device__ __forceinline__ float bf_lo(unsigned u) { return __uint_as_float(u << 16); }
__device__ __forceinline__ float bf_hi(unsigned u) { return __uint_as_float(u & 0xffff0000u); }
__device__ __forceinline__ float ex2(float x) { return __builtin_amdgcn_exp2f(x); }
__device__ __forceinline__ float lg2(float x) { return __builtin_amdgcn_logf(x); }
__device__ __forceinline__ float rcpf(float x) { return __builtin_amdgcn_rcpf(x); }
__device__ __forceinline__ float siluf(float x) { return x * rcpf(1.f + ex2(-x * LOG2E)); }
__device__ __forceinline__ float wave_sum(float v) {
#pragma unroll
    for (int o = 1; o < 64; o <<= 1) v += __shfl_xor(v, o);
    return v;
}
__device__ __forceinline__ const float* xrow_ptr(const float* xp, const float* xs, int row) {
    return row < MPROMPT ? xp + (size_t)row * DM : xs + (size_t)(row - MPROMPT) * DM;
}

struct EpiInProj {
    static constexpr bool PERM = true, AFTER_DRAIN = false;
    bf16_t* P; const float* lbf; const float* lbb; const float* qnw; const float* knw; PG8_LAS float* ex;
    __device__ __forceinline__ void operator()(const pg8::f32x4 (&acc)[2][2][4][2], const pg8::Unit& u, int wr, int wc, int fr, int fq) const {
        const int sec = u.pn >> 1;
        int row0 = u.pm * 256 + wr * 64 + fr, col0 = u.pn * 256 + wc * 32 + 8 * fq;
        asm volatile("" : "+v"(row0), "+v"(col0));
        if (sec < 2) {
            float ps[2][4][2];
#pragma unroll
            for (int ai = 0; ai < 2; ++ai)
#pragma unroll
                for (int m = 0; m < 4; ++m)
#pragma unroll
                    for (int bj = 0; bj < 2; ++bj) { float q = 0.f;
#pragma unroll
                        for (int n = 0; n < 2; ++n)
#pragma unroll
                            for (int e = 0; e < 4; ++e) q += acc[ai][bj][m][n][e] * acc[ai][bj][m][n][e];
                        q += __shfl_xor(q, 16); q += __shfl_xor(q, 32); ps[ai][m][bj] = q; }
            const int wid = wr * 4 + wc;
            if (fq == 0) {
#pragma unroll
                for (int ai = 0; ai < 2; ++ai)
#pragma unroll
                    for (int m = 0; m < 4; ++m)
#pragma unroll
                        for (int bj = 0; bj < 2; ++bj) ex[(wid * 16 + (ai * 8 + m * 2 + bj)) * 16 + fr] = ps[ai][m][bj];
            }
            asm volatile("s_waitcnt lgkmcnt(0)" ::: "memory"); __builtin_amdgcn_s_barrier();
            const float* nw = (sec == 0) ? qnw : knw; const float sc = (sec == 0) ? 0.125f * LOG2E : 1.f;
            float w8[8];
#pragma unroll
            for (int e = 0; e < 8; ++e) w8[e] = nw[32 * (wc & 1) + 8 * fq + e] * sc;
#pragma unroll
            for (int ai = 0; ai < 2; ++ai)
#pragma unroll
                for (int m = 0; m < 4; ++m) {
                    bf16_t* rowp = P + (size_t)(row0 + ai * 128 + m * 16) * INW + col0;
#pragma unroll
                    for (int bj = 0; bj < 2; ++bj) {
                        const float tot = ps[ai][m][bj] + ex[((wid ^ 1) * 16 + (ai * 8 + m * 2 + bj)) * 16 + fr];
                        const float rs = __builtin_amdgcn_rsqf(tot * (1.f / 64.f) + NORM_EPS);
                        const pg8::f32x4 v0 = acc[ai][bj][m][0], v1 = acc[ai][bj][m][1];
                        u32x4 w; w.x = cvtpk(v0[0] * rs * w8[0], v0[1] * rs * w8[1]); w.y = cvtpk(v0[2] * rs * w8[2], v0[3] * rs * w8[3]);
                        w.z = cvtpk(v1[0] * rs * w8[4], v1[1] * rs * w8[5]); w.w = cvtpk(v1[2] * rs * w8[6], v1[3] * rs * w8[7]);
                        __builtin_nontemporal_store(w, (u32x4*)(rowp + bj * 128));
                    }
                }
            return;
        }
        float lbv[2][8];
        if (sec == 4 || sec == 5) {
            const float* t = (sec == 4) ? lbf : lbb; const int cs = col0 - sec * 512;
#pragma unroll
            for (int bj = 0; bj < 2; ++bj)
#pragma unroll
                for (int e = 0; e < 8; ++e) { const int c = cs + bj * 128 + e; lbv[bj][e] = rcpf(1.f + ex2((t[512 + c] - t[c]) * LOG2E)); }
        }
#pragma unroll
        for (int ai = 0; ai < 2; ++ai)
#pragma unroll
            for (int m = 0; m < 4; ++m) {
                bf16_t* rowp = P + (size_t)(row0 + ai * 128 + m * 16) * INW + col0;
#pragma unroll
                for (int bj = 0; bj < 2; ++bj) {
                    float v[8];
#pragma unroll
                    for (int e = 0; e < 4; ++e) { v[e] = acc[ai][bj][m][0][e]; v[4 + e] = acc[ai][bj][m][1][e]; }
                    if (sec == 3 || sec == 7) {
#pragma unroll
                        for (int e = 0; e < 8; ++e) v[e] = siluf(v[e]);
                    } else if (sec == 4 || sec == 5) {
#pragma unroll
                        for (int e = 0; e < 8; ++e) { const float sg = rcpf(1.f + ex2(-v[e] * LOG2E)); const float lb = lbv[bj][e]; v[e] = lg2(lb + (1.f - lb) * sg); }
                    }
                    u32x4 w; w.x = cvtpk(v[0], v[1]); w.y = cvtpk(v[2], v[3]); w.z = cvtpk(v[4], v[5]); w.w = cvtpk(v[6], v[7]);
                    __builtin_nontemporal_store(w, (u32x4*)(rowp + bj * 128));
                }
            }
    }
};
struct EpiBf16Plain {
    static constexpr bool PERM = true, AFTER_DRAIN = false;
    bf16_t* O; int ldc;
    __device__ __forceinline__ void operator()(const pg8::f32x4 (&acc)[2][2][4][2], const pg8::Unit& u, int wr, int wc, int fr, int fq) const {
        int row0 = u.pm * 256 + wr * 64 + fr, col0 = u.pn * 256 + wc * 32 + 8 * fq;
        asm volatile("" : "+v"(row0), "+v"(col0));
#pragma unroll
        for (int ai = 0; ai < 2; ++ai)
#pragma unroll
            for (int m = 0; m < 4; ++m) {
                bf16_t* rowp = O + (size_t)(row0 + ai * 128 + m * 16) * ldc + col0;
#pragma unroll
                for (int bj = 0; bj < 2; ++bj) {
                    const pg8::f32x4 v0 = acc[ai][bj][m][0], v1 = acc[ai][bj][m][1];
                    u32x4 w; w.x = cvtpk(v0[0], v0[1]); w.y = cvtpk(v0[2], v0[3]); w.z = cvtpk(v1[0], v1[1]); w.w = cvtpk(v1[2], v1[3]);
                    *(u32x4*)(rowp + bj * 128) = w;
                }
            }
    }
};
struct EpiResid {
    static constexpr bool PERM = true, AFTER_DRAIN = false;
    const float* xp; const float* xs; float* out; int row_off; int self;
    __device__ __forceinline__ void operator()(const pg8::f32x4 (&acc)[2][2][4][2], const pg8::Unit& u, int wr, int wc, int fr, int fq) const {
        const int rowt = row_off + u.pm * 256;
        const float* rb = self ? (const float*)out + (size_t)rowt * DM : xrow_ptr(xp, xs, rowt);
        float* ob = out + (size_t)rowt * DM;
        int r0 = wr * 64 + fr, col0 = u.pn * 256 + wc * 32 + 8 * fq;
        asm volatile("" : "+v"(r0), "+v"(col0));
#pragma unroll
        for (int ai = 0; ai < 2; ++ai)
#pragma unroll
            for (int m = 0; m < 4; ++m) {
                const size_t ro = (size_t)(r0 + ai * 128 + m * 16) * DM + col0;
#pragma unroll
                for (int bj = 0; bj < 2; ++bj)
#pragma unroll
                    for (int n = 0; n < 2; ++n) {
                        const f32x4 r = *(const f32x4*)(rb + ro + bj * 128 + 4 * n);
                        const pg8::f32x4 a = acc[ai][bj][m][n];
                        f32x4 o; o[0] = r[0] + a[0]; o[1] = r[1] + a[1]; o[2] = r[2] + a[2]; o[3] = r[3] + a[3];
                        *(f32x4*)(ob + ro + bj * 128 + 4 * n) = o;
                    }
            }
    }
};

struct EpiResidB {
    static constexpr bool PERM = true, AFTER_DRAIN = false;
    const float* xp; const float* xs; bf16_t* X1B;
    __device__ __forceinline__ void operator()(const pg8::f32x4 (&acc)[2][2][4][2], const pg8::Unit& u, int wr, int wc, int fr, int fq) const {
        const int rowt = u.pm * 256;
        const float* rb = xrow_ptr(xp, xs, rowt);
        bf16_t* ob = X1B + (size_t)rowt * DM;
        int r0 = wr * 64 + fr, col0 = u.pn * 256 + wc * 32 + 8 * fq;
        asm volatile("" : "+v"(r0), "+v"(col0));
#pragma unroll
        for (int ai = 0; ai < 2; ++ai)
#pragma unroll
            for (int m = 0; m < 4; ++m) {
                const size_t ro = (size_t)(r0 + ai * 128 + m * 16) * DM + col0;
#pragma unroll
                for (int bj = 0; bj < 2; ++bj) {
                    const f32x4 ra = *(const f32x4*)(rb + ro + bj * 128), rc = *(const f32x4*)(rb + ro + bj * 128 + 4);
                    const pg8::f32x4 a = acc[ai][bj][m][0], c = acc[ai][bj][m][1];
                    u32x4 w; w.x = cvtpk(ra[0] + a[0], ra[1] + a[1]); w.y = cvtpk(ra[2] + a[2], ra[3] + a[3]); w.z = cvtpk(rc[0] + c[0], rc[1] + c[1]); w.w = cvtpk(rc[2] + c[2], rc[3] + c[3]);
                    *(u32x4*)(ob + ro + bj * 128) = w;
                }
            }
    }
};
struct EpiFinal {
    static constexpr bool PERM = true, AFTER_DRAIN = false;
    const bf16_t* X1B; float* out;
    __device__ __forceinline__ void operator()(const pg8::f32x4 (&acc)[2][2][4][2], const pg8::Unit& u, int wr, int wc, int fr, int fq) const {
        const int rowt = u.pm * 256;
        const bf16_t* rb = X1B + (size_t)rowt * DM;
        float* ob = out + (size_t)rowt * DM;
        int r0 = wr * 64 + fr, col0 = u.pn * 256 + wc * 32 + 8 * fq;
        asm volatile("" : "+v"(r0), "+v"(col0));
#pragma unroll
        for (int ai = 0; ai < 2; ++ai)
#pragma unroll
            for (int m = 0; m < 4; ++m) {
                const size_t ro = (size_t)(r0 + ai * 128 + m * 16) * DM + col0;
#pragma unroll
                for (int bj = 0; bj < 2; ++bj) {
                    const u32x4 r = *(const u32x4*)(rb + ro + bj * 128);
                    const pg8::f32x4 a = acc[ai][bj][m][0], c = acc[ai][bj][m][1];
                    f32x4 o0, o1;
                    o0[0] = bf_lo(r.x) + a[0]; o0[1] = bf_hi(r.x) + a[1]; o0[2] = bf_lo(r.y) + a[2]; o0[3] = bf_hi(r.y) + a[3];
                    o1[0] = bf_lo(r.z) + c[0]; o1[1] = bf_hi(r.z) + c[1]; o1[2] = bf_lo(r.w) + c[2]; o1[3] = bf_hi(r.w) + c[3];
                    *(f32x4*)(ob + ro + bj * 128) = o0; *(f32x4*)(ob + ro + bj * 128 + 4) = o1;
                }
            }
    }
};

#define DPP_SHR1 0x111
#define DPP_SHL1 0x101
#define DPP_ROR1 0x121
#define DPP_ROR15 0x12F
__device__ __forceinline__ float dppf(float old, float src, const int ctrl_sel) {
    int r;
    if (ctrl_sel == 0) r = __builtin_amdgcn_update_dpp(__float_as_int(old), __float_as_int(src), DPP_SHR1, 0xf, 0xf, false);
    else if (ctrl_sel == 1) r = __builtin_amdgcn_update_dpp(__float_as_int(old), __float_as_int(src), DPP_SHL1, 0xf, 0xf, false);
    else if (ctrl_sel == 2) r = __builtin_amdgcn_update_dpp(__float_as_int(old), __float_as_int(src), DPP_ROR1, 0xf, 0xf, false);
    else r = __builtin_amdgcn_update_dpp(__float_as_int(old), __float_as_int(src), DPP_ROR15, 0xf, 0xf, false);
    return __int_as_float(r);
}
struct EpiConvAct {
    static constexpr bool PERM = true, AFTER_DRAIN = false;
    bf16_t* ACT; const float* cw; const float* cb; PG8_LAS float* ex;
    __device__ __forceinline__ void operator()(const pg8::f32x4 (&acc)[2][2][4][2], const pg8::Unit& u, int wr, int wc, int fr, int fq) const {
        int seq = u.pm / 33, pt = u.pm % 33;
        asm volatile("" : "+s"(seq), "+s"(pt));
        const int t0 = 254 * pt - 1;
        int cl = wc * 32 + 8 * fq;
        asm volatile("" : "+v"(cl));
#pragma unroll
        for (int ai = 0; ai < 2; ++ai) { const int g = ai * 2 + wr;
            if (fr == 0) {
#pragma unroll
                for (int bj = 0; bj < 2; ++bj)
#pragma unroll
                    for (int n = 0; n < 2; ++n) *(PG8_LAS pg8::f32x4*)(ex + ((g * 2 + 0) * 2 + bj) * 128 + cl + 4 * n) = acc[ai][bj][0][n]; }
            if (fr == 15) {
#pragma unroll
                for (int bj = 0; bj < 2; ++bj)
#pragma unroll
                    for (int n = 0; n < 2; ++n) *(PG8_LAS pg8::f32x4*)(ex + ((g * 2 + 1) * 2 + bj) * 128 + cl + 4 * n) = acc[ai][bj][3][n]; }
        }
        asm volatile("s_waitcnt lgkmcnt(0)" ::: "memory"); __builtin_amdgcn_s_barrier();
        const int chb = u.pn * 128 + cl;
#pragma unroll
        for (int n = 0; n < 2; ++n) {
            const int ch = chb + 4 * n;
            const f32x4 bg = *(const f32x4*)(cb + ch), bu = *(const f32x4*)(cb + DFF + ch);
            const f32x4 g0 = *(const f32x4*)(cw + ch), g1 = *(const f32x4*)(cw + DFF2 + ch), g2 = *(const f32x4*)(cw + 2 * DFF2 + ch);
            const f32x4 u0 = *(const f32x4*)(cw + DFF + ch), u1 = *(const f32x4*)(cw + DFF2 + DFF + ch), u2 = *(const f32x4*)(cw + 2 * DFF2 + DFF + ch);
#pragma unroll
            for (int ai = 0; ai < 2; ++ai) { const int g = ai * 2 + wr;
#pragma unroll
                for (int m = 0; m < 4; ++m) {
                    const int row = 64 * g + 16 * m + fr, t = t0 + row;
                    pg8::f32x4 pb[2], nb[2];
                    if (m == 0) {
#pragma unroll
                        for (int bj = 0; bj < 2; ++bj) pb[bj] = *(const PG8_LAS pg8::f32x4*)(ex + ((((g + 3) & 3) * 2 + 1) * 2 + bj) * 128 + cl + 4 * n);
                    }
                    if (m == 3) {
#pragma unroll
                        for (int bj = 0; bj < 2; ++bj) nb[bj] = *(const PG8_LAS pg8::f32x4*)(ex + ((((g + 1) & 3) * 2 + 0) * 2 + bj) * 128 + cl + 4 * n);
                    }
                    const bool keep = (row >= 1) && (row <= 254) && (t < SEQL);
                    float o4[4];
#pragma unroll
                    for (int e = 0; e < 4; ++e) {
                        float cv[2];
#pragma unroll
                        for (int bj = 0; bj < 2; ++bj) {
                            const float X = acc[ai][bj][m][n][e];
                            const float p0v = (m > 0) ? dppf(0.f, acc[ai][bj][m > 0 ? m - 1 : 0][n][e], 2) : pb[bj][e];
                            const float n0v = (m < 3) ? dppf(0.f, acc[ai][bj][m < 3 ? m + 1 : 3][n][e], 3) : nb[bj][e];
                            float pv = dppf(p0v, X, 0), nv = dppf(n0v, X, 1);
                            pv = (t == 0) ? 0.f : pv; nv = (t == SEQL - 1) ? 0.f : nv;
                            cv[bj] = bj == 0 ? bg[e] + g0[e] * pv + g1[e] * X + g2[e] * nv : bu[e] + u0[e] * pv + u1[e] * X + u2[e] * nv;
                        }
                        o4[e] = siluf(cv[0]) * cv[1];
                    }
                    if (keep) { u32x2 w; w.x = cvtpk(o4[0], o4[1]); w.y = cvtpk(o4[2], o4[3]); *(u32x2*)(ACT + ((size_t)seq * SEQL + t) * DFF + ch) = w; }
                }
            }
        }
    }
};

__device__ __forceinline__ void p0_transpose_item(const float* W, int K, int N, bf16_t* WT, LAS float* scr, int item, int lane, bool perm_up = false) {
    const int nblk = N / 32, kb = item / nblk, nb = item % nblk, k0 = 64 * kb, n0 = 32 * nb;
#pragma unroll 8
    for (int i = 0; i < 32; ++i) { const int kk = 2 * i + (lane >> 5); scr[kk * 33 + (lane & 31)] = W[(size_t)(k0 + kk) * N + n0 + (lane & 31)]; }
    asm volatile("s_waitcnt lgkmcnt(0)" ::: "memory");
    const int c = lane & 7;
#pragma unroll
    for (int j = 0; j < 4; ++j) { const int n = (lane >> 3) + 8 * j; const LAS float* s = scr + (8 * c) * 33 + n;
        u32x4 o; o.x = cvtpk(s[0 * 33], s[1 * 33]); o.y = cvtpk(s[2 * 33], s[3 * 33]); o.z = cvtpk(s[4 * 33], s[5 * 33]); o.w = cvtpk(s[6 * 33], s[7 * 33]);
        int nd = n0 + n; if (perm_up) { const int hf = nd / DFF, rr = nd - hf * DFF; nd = (rr >> 7) * 256 + hf * 128 + (rr & 127); }
        *(u32x4*)(WT + (size_t)nd * K + k0 + 8 * c) = o; }
    asm volatile("s_waitcnt lgkmcnt(0)" ::: "memory");
}
__device__ __forceinline__ void rms_row2_to_bf16(const float* xrow0, const float* xrow1, const float* w, bf16_t* orow0, bf16_t* orow1, int lane) {
    const f32x4* xr0 = (const f32x4*)xrow0 + lane; const f32x4* xr1 = (const f32x4*)xrow1 + lane; const f32x4* wr = (const f32x4*)w + lane;
    f32x4 v0[4], v1[4]; float s0 = 0.f, s1 = 0.f;
#pragma unroll
    for (int j = 0; j < 4; ++j) { v0[j] = xr0[64 * j]; v1[j] = xr1[64 * j]; }
#pragma unroll
    for (int j = 0; j < 4; ++j) { s0 += (v0[j][0] * v0[j][0] + v0[j][1] * v0[j][1]) + (v0[j][2] * v0[j][2] + v0[j][3] * v0[j][3]); s1 += (v1[j][0] * v1[j][0] + v1[j][1] * v1[j][1]) + (v1[j][2] * v1[j][2] + v1[j][3] * v1[j][3]); }
    const float r0 = __builtin_amdgcn_rsqf(wave_sum(s0) * (1.f / DM) + NORM_EPS), r1 = __builtin_amdgcn_rsqf(wave_sum(s1) * (1.f / DM) + NORM_EPS);
    u32x2* o0 = (u32x2*)orow0 + lane; u32x2* o1 = (u32x2*)orow1 + lane;
#pragma unroll
    for (int j = 0; j < 4; ++j) { const f32x4 ww = wr[64 * j]; u32x2 o;
        o.x = cvtpk(v0[j][0] * r0 * ww[0], v0[j][1] * r0 * ww[1]); o.y = cvtpk(v0[j][2] * r0 * ww[2], v0[j][3] * r0 * ww[3]); o0[64 * j] = o;
        o.x = cvtpk(v1[j][0] * r1 * ww[0], v1[j][1] * r1 * ww[1]); o.y = cvtpk(v1[j][2] * r1 * ww[2], v1[j][3] * r1 * ww[3]); o1[64 * j] = o; }
}
__device__ __forceinline__ void rms_rowb2_to_bf16(const bf16_t* xrow0, const bf16_t* xrow1, const float* w, bf16_t* orow0, bf16_t* orow1, int lane) {
    const u32x4 a0 = *((const u32x4*)xrow0 + lane), a1 = *((const u32x4*)xrow0 + 64 + lane), b0 = *((const u32x4*)xrow1 + lane), b1 = *((const u32x4*)xrow1 + 64 + lane);
    float va[16], vb[16]; float s0 = 0.f, s1 = 0.f;
#pragma unroll
    for (int e = 0; e < 4; ++e) { va[2 * e] = bf_lo(a0[e]); va[2 * e + 1] = bf_hi(a0[e]); va[8 + 2 * e] = bf_lo(a1[e]); va[8 + 2 * e + 1] = bf_hi(a1[e]);
        vb[2 * e] = bf_lo(b0[e]); vb[2 * e + 1] = bf_hi(b0[e]); vb[8 + 2 * e] = bf_lo(b1[e]); vb[8 + 2 * e + 1] = bf_hi(b1[e]); }
#pragma unroll
    for (int e = 0; e < 16; ++e) { s0 += va[e] * va[e]; s1 += vb[e] * vb[e]; }
    const float r0 = __builtin_amdgcn_rsqf(wave_sum(s0) * (1.f / DM) + NORM_EPS), r1 = __builtin_amdgcn_rsqf(wave_sum(s1) * (1.f / DM) + NORM_EPS);
    const f32x4 w0 = *((const f32x4*)w + 2 * lane), w1 = *((const f32x4*)w + 2 * lane + 1), w2 = *((const f32x4*)w + 128 + 2 * lane), w3 = *((const f32x4*)w + 128 + 2 * lane + 1);
    u32x4 o;
    o.x = cvtpk(va[0] * r0 * w0[0], va[1] * r0 * w0[1]); o.y = cvtpk(va[2] * r0 * w0[2], va[3] * r0 * w0[3]); o.z = cvtpk(va[4] * r0 * w1[0], va[5] * r0 * w1[1]); o.w = cvtpk(va[6] * r0 * w1[2], va[7] * r0 * w1[3]);
    *((u32x4*)orow0 + lane) = o;
    o.x = cvtpk(va[8] * r0 * w2[0], va[9] * r0 * w2[1]); o.y = cvtpk(va[10] * r0 * w2[2], va[11] * r0 * w2[3]); o.z = cvtpk(va[12] * r0 * w3[0], va[13] * r0 * w3[1]); o.w = cvtpk(va[14] * r0 * w3[2], va[15] * r0 * w3[3]);
    *((u32x4*)orow0 + 64 + lane) = o;
    o.x = cvtpk(vb[0] * r1 * w0[0], vb[1] * r1 * w0[1]); o.y = cvtpk(vb[2] * r1 * w0[2], vb[3] * r1 * w0[3]); o.z = cvtpk(vb[4] * r1 * w1[0], vb[5] * r1 * w1[1]); o.w = cvtpk(vb[6] * r1 * w1[2], vb[7] * r1 * w1[3]);
    *((u32x4*)orow1 + lane) = o;
    o.x = cvtpk(vb[8] * r1 * w2[0], vb[9] * r1 * w2[1]); o.y = cvtpk(vb[10] * r1 * w2[2], vb[11] * r1 * w2[3]); o.z = cvtpk(vb[12] * r1 * w3[0], vb[13] * r1 * w3[1]); o.w = cvtpk(vb[14] * r1 * w3[2], vb[15] * r1 * w3[3]);
    *((u32x4*)orow1 + 64 + lane) = o;
}

namespace att {
constexpr int KVBLK = 64, LDK = INW;
constexpr int SHM_V = KVBLK * 128 * 2, SHM_K = KVBLK * 128 * 2;
constexpr float THR2 = 11.5f;
#ifndef ATT_SDEPTH
#define ATT_SDEPTH 2
#endif
constexpr int SDEPTH = ATT_SDEPTH;
#define KSWZ(row, colB) ((row) * 256 + ((colB) ^ (((row) & 7) << 4)))
#define SBAR() __builtin_amdgcn_sched_barrier(0)
__device__ __forceinline__ int crow(int r, int hi) { return (r & 3) + 8 * (r >> 2) + 4 * hi; }
__device__ __forceinline__ unsigned cvtpkv(float lo, float hi) { unsigned r; asm volatile("v_cvt_pk_bf16_f32 %0, %1, %2" : "=v"(r) : "v"(lo), "v"(hi)); return r; }

__device__ __forceinline__ void partialSM(f32x16& p0, f32x16& p1, float dq, float c2) {
#pragma unroll
  for (int r = 0; r < 16; ++r) { p0[r] = fmaf(-c2, fabsf(dq - (float)((r & 3) + 8 * (r >> 2))), p0[r]); p1[r] = fmaf(-c2, fabsf(dq - (float)(32 + (r & 3) + 8 * (r >> 2))), p1[r]); }
#pragma unroll
  for (int r = 0; r < 16; ++r) p0[r] = __builtin_amdgcn_exp2f(p0[r]);
}
__device__ __forceinline__ void finishSM(f32x16& p0, f32x16& p1, float& l_reg, bf16x8& pa0, bf16x8& pa1, bf16x8& pa2, bf16x8& pa3) {
#pragma unroll
  for (int r = 0; r < 16; ++r) p1[r] = __builtin_amdgcn_exp2f(p1[r]);
  float ps = 0;
#pragma unroll
  for (int r = 0; r < 16; ++r) ps += p0[r];
#pragma unroll
  for (int r = 0; r < 16; ++r) ps += p1[r];
  { auto rr = __builtin_amdgcn_permlane32_swap(__float_as_uint(ps), __float_as_uint(ps), false, false);
    ps = __uint_as_float(rr[0]) + __uint_as_float(rr[1]); }
  l_reg += ps;
#define PK4(P, BASE, OUT) do { unsigned a0 = cvtpkv(P[BASE + 0], P[BASE + 1]), a1 = cvtpkv(P[BASE + 2], P[BASE + 3]);   \
    unsigned b0 = cvtpkv(P[BASE + 4], P[BASE + 5]), b1 = cvtpkv(P[BASE + 6], P[BASE + 7]);                              \
    auto r0 = __builtin_amdgcn_permlane32_swap(a0, b0, false, false); auto r1 = __builtin_amdgcn_permlane32_swap(a1, b1, false, false); \
    u32x4 w = {r0[0], r1[0], r0[1], r1[1]}; OUT = *reinterpret_cast<bf16x8*>(&w); } while (0)
  PK4(p0, 0, pa0); PK4(p0, 8, pa1); PK4(p1, 0, pa2); PK4(p1, 8, pa3);
#undef PK4
}
__device__ __forceinline__ void qkt(f32x16& p0, f32x16& p1, const char* Ks, const bf16x8* qr, int r32, int hi, int map) {
  p0 = f32x16{}; p1 = f32x16{};
#pragma unroll
  for (int d0 = 0; d0 < 4; ++d0) { const int cb = (map * 64 + d0 * 16 + hi * 8) * 2;
    bf16x8 b0 = *reinterpret_cast<const bf16x8*>(Ks + KSWZ(r32, cb));
    bf16x8 b1 = *reinterpret_cast<const bf16x8*>(Ks + KSWZ(32 + r32, cb));
    p0 = __builtin_amdgcn_mfma_f32_32x32x16_bf16(b0, qr[d0], p0, 0, 0, 0);
    p1 = __builtin_amdgcn_mfma_f32_32x32x16_bf16(b1, qr[d0], p1, 0, 0, 0); }
}
__device__ __forceinline__ int v_st(int k, int c) { const int kk = (k & ~0xC) | ((k & 4) << 1) | ((k & 8) >> 1); return ((kk >> 3) * 4 + (c >> 5)) * 512 + ((kk & 7) * 32 + (c & 31)) * 2; }
__device__ __forceinline__ int v_rd_base(int lane) { return ((lane & 3) << 3) | (((lane >> 2) & 3) << 6) | (((lane >> 4) & 1) << 5) | (((lane >> 5) & 1) << 8); }
constexpr int v_rd_off(int d0, int ks, int half) { return d0 * 512 + ks * 4096 + half * 2048; }
template <int OFF> __device__ __forceinline__ s16x4 tr_read(int vb) {
  s16x4 r; asm volatile("ds_read_b64_tr_b16 %0, %1 offset:%2" : "=&v"(r) : "v"(vb), "i"(OFF) : "memory"); return r;
}
template <int D0> __device__ __forceinline__ void pv_one(f32x16& od, int vb, bf16x8 pa0, bf16x8 pa1, bf16x8 pa2, bf16x8 pa3) {
#define PK(L, H) (bf16x8){L[0], L[1], L[2], L[3], H[0], H[1], H[2], H[3]}
  { const s16x4 l0 = tr_read<v_rd_off(D0, 0, 0)>(vb), h0 = tr_read<v_rd_off(D0, 0, 1)>(vb), l1 = tr_read<v_rd_off(D0, 1, 0)>(vb), h1 = tr_read<v_rd_off(D0, 1, 1)>(vb);
    asm volatile("s_waitcnt lgkmcnt(0)" ::: "memory"); SBAR();
    od = __builtin_amdgcn_mfma_f32_32x32x16_bf16(pa0, PK(l0, h0), od, 0, 0, 0);
    od = __builtin_amdgcn_mfma_f32_32x32x16_bf16(pa1, PK(l1, h1), od, 0, 0, 0); }
  { const s16x4 l2 = tr_read<v_rd_off(D0, 2, 0)>(vb), h2 = tr_read<v_rd_off(D0, 2, 1)>(vb), l3 = tr_read<v_rd_off(D0, 3, 0)>(vb), h3 = tr_read<v_rd_off(D0, 3, 1)>(vb);
    asm volatile("s_waitcnt lgkmcnt(0)" ::: "memory"); SBAR();
    od = __builtin_amdgcn_mfma_f32_32x32x16_bf16(pa2, PK(l2, h2), od, 0, 0, 0);
    od = __builtin_amdgcn_mfma_f32_32x32x16_bf16(pa3, PK(l3, h3), od, 0, 0, 0); }
#undef PK
}
__device__ __forceinline__ void pv_d0(f32x16* o, int vb, bf16x8 pa0, bf16x8 pa1, bf16x8 pa2, bf16x8 pa3) {
  pv_one<0>(o[0], vb, pa0, pa1, pa2, pa3); pv_one<1>(o[1], vb, pa0, pa1, pa2, pa3); pv_one<2>(o[2], vb, pa0, pa1, pa2, pa3); pv_one<3>(o[3], vb, pa0, pa1, pa2, pa3);
}

#define SM_CHUNK(c) do { _Pragma("unroll") for (int r = 2 * (c); r < 2 * (c) + 2; ++r) { \
    p0[r] = __builtin_amdgcn_exp2f(fmaf(-c2, fabsf(dq - (float)((r & 3) + 8 * (r >> 2))), p0[r])); p1[r] = fmaf(-c2, fabsf(dq - (float)(32 + (r & 3) + 8 * (r >> 2))), p1[r]); } } while (0)
#define RD4(X, D0, HF) do { X##0 = tr_read<v_rd_off(D0, 2 * (HF), 0)>(vb); X##1 = tr_read<v_rd_off(D0, 2 * (HF), 1)>(vb); X##2 = tr_read<v_rd_off(D0, 2 * (HF) + 1, 0)>(vb); X##3 = tr_read<v_rd_off(D0, 2 * (HF) + 1, 1)>(vb); } while (0)
#define PKV(L, H) (bf16x8){L[0], L[1], L[2], L[3], H[0], H[1], H[2], H[3]}
#define MM2(OD, X, PA, PB) do { OD = __builtin_amdgcn_mfma_f32_32x32x16_bf16(PA, PKV(X##0, X##1), OD, 0, 0, 0); OD = __builtin_amdgcn_mfma_f32_32x32x16_bf16(PB, PKV(X##2, X##3), OD, 0, 0, 0); } while (0)
#define WL4() asm volatile("s_waitcnt lgkmcnt(4)" ::: "memory")
__device__ __forceinline__ void pv_sm(f32x16* o, int vb, bf16x8 pa0, bf16x8 pa1, bf16x8 pa2, bf16x8 pa3, f32x16& p0, f32x16& p1, float dq, float c2) {
  s16x4 A0, A1, A2, A3, B0, B1, B2, B3;
  RD4(A, 0, 0);
  RD4(B, 0, 1); WL4(); SBAR(); MM2(o[0], A, pa0, pa1); SM_CHUNK(0); SBAR();
  RD4(A, 1, 0); WL4(); SBAR(); MM2(o[0], B, pa2, pa3); SM_CHUNK(1); SBAR();
  RD4(B, 1, 1); WL4(); SBAR(); MM2(o[1], A, pa0, pa1); SM_CHUNK(2); SBAR();
  RD4(A, 2, 0); WL4(); SBAR(); MM2(o[1], B, pa2, pa3); SM_CHUNK(3); SBAR();
  RD4(B, 2, 1); WL4(); SBAR(); MM2(o[2], A, pa0, pa1); SM_CHUNK(4); SBAR();
  RD4(A, 3, 0); WL4(); SBAR(); MM2(o[2], B, pa2, pa3); SM_CHUNK(5); SBAR();
  RD4(B, 3, 1); WL4(); SBAR(); MM2(o[3], A, pa0, pa1); SM_CHUNK(6); SBAR();
  asm volatile("s_waitcnt lgkmcnt(0)" ::: "memory"); SBAR(); MM2(o[3], B, pa2, pa3); SM_CHUNK(7); SBAR();
}
#undef SM_CHUNK
#undef RD4
#undef MM2
#undef WL4
#undef PKV

__device__ __forceinline__ void attn_unit(const bf16_t* __restrict__ P, bf16_t* __restrict__ MIX, const float* __restrict__ onw, float lam, int bh, int qb, int W, char* lds) {
  const int tid = threadIdx.x, wid = tid >> 6, lane = tid & 63, r32 = lane & 31, hi = lane >> 5;
  const int qg = wid & 3, map = wid >> 2, b = bh >> 2, h = bh & 3;
  const size_t tok0 = (size_t)b * SEQL; const int q0 = qb * 128;
  char* K_lds = lds; char* V_lds = lds + 3 * SHM_K;
  float* ws = (float*)(lds + 3 * SHM_V + 3 * SHM_K) + wid * 64; float* li_l = ws; float* al_l = ws + 32;
  const float c2 = LOG2E * (h == 0 ? 0.25f : h == 1 ? 0.0625f : h == 2 ? 0.015625f : 0.00390625f);
  const int qpos = q0 + qg * 32 + r32;
  float l_reg = 0; f32x16 o[4] = {}; bf16x8 qr[4];
  const int qbase = __builtin_amdgcn_readfirstlane(q0 + qg * 32);
  const bf16_t* Qw = P + (tok0 + qpos) * INW + h * 128 + map * 64 + hi * 8;
#pragma unroll
  for (int d0 = 0; d0 < 4; ++d0) qr[d0] = *reinterpret_cast<const bf16x8*>(Qw + d0 * 16);
  const bf16_t* Kh = P + tok0 * INW + 512 + h * 128; const bf16_t* Vh = P + tok0 * INW + 1024 + h * 128;
  const int sr = tid >> 4, sc = (tid & 15) * 8, vst0 = v_st(sr, sc), vst1 = v_st(32 + sr, sc);
  const int vb0 = (int)(uintptr_t)V_lds + v_rd_base(lane);
  struct { bf16x8 vs0, vs1, ks0, ks1; } sr_;
#define SLOAD(k0) do { sr_.vs0 = *(const bf16x8*)(&Vh[(size_t)((k0) + sr) * LDK + sc]); sr_.vs1 = *(const bf16x8*)(&Vh[(size_t)((k0) + 32 + sr) * LDK + sc]); \
    sr_.ks0 = *(const bf16x8*)(&Kh[(size_t)((k0) + sr) * LDK + sc]); sr_.ks1 = *(const bf16x8*)(&Kh[(size_t)((k0) + 32 + sr) * LDK + sc]); } while (0)
#define SWRITE(slot) do { *(bf16x8*)(V_lds + (slot) * SHM_V + vst0) = sr_.vs0;          \
    *(bf16x8*)(V_lds + (slot) * SHM_V + vst1) = sr_.vs1; const int kc = sc * 2;               \
    *(bf16x8*)(K_lds + (slot) * SHM_K + KSWZ(sr, kc)) = sr_.ks0;                       \
    *(bf16x8*)(K_lds + (slot) * SHM_K + KSWZ(32 + sr, kc)) = sr_.ks1; } while (0)
#define DQ(j) ((float)(qpos - (j) * KVBLK - 4 * hi))
  f32x16 pA0, pA1, pB0, pB1; bf16x8 pa0, pa1, pa2, pa3;
  int jlo = (q0 - W) / KVBLK; if (q0 - W < 0) jlo = 0;
  int jhi = (q0 + 127 + W) / KVBLK + 1; if (jhi > SEQL / KVBLK) jhi = SEQL / KVBLK;
  if ((jhi - jlo) & 1) { if (jhi < SEQL / KVBLK) ++jhi; else --jlo; }
  const int NT = jhi - jlo;
#define TK(i) ((jlo + (i)) * KVBLK)
  if (map == 1) __builtin_amdgcn_s_setprio(1);
  SLOAD(TK(0)); asm volatile("s_waitcnt vmcnt(0)" ::: "memory"); SWRITE(0);
  SLOAD(TK(1)); asm volatile("s_waitcnt vmcnt(0)" ::: "memory"); SWRITE(1);
  if (2 < NT) SLOAD(TK(2));
  __syncthreads();
  qkt(pA0, pA1, K_lds, qr, r32, hi, map); partialSM(pA0, pA1, DQ(jlo), c2);
  int sk = 1, sv = 0, sw = 2;
#define STEP(pC0, pC1, pP0, pP1, ii, more) do { \
    SBAR(); qkt(pC0, pC1, K_lds + sk * SHM_K, qr, r32, hi, map); \
    finishSM(pP0, pP1, l_reg, pa0, pa1, pa2, pa3); SBAR(); \
    asm volatile("s_waitcnt vmcnt(0)" ::: "memory"); SWRITE(sw); if (more) SLOAD(TK((ii) + 2)); SBAR(); \
    pv_sm(o, vb0 + sv * SHM_V, pa0, pa1, pa2, pa3, pC0, pC1, DQ(jlo + (ii)), c2); \
    __syncthreads(); \
    sv = sk; sk = sw; sw = (sw == 2) ? 0 : sw + 1; } while (0)
  for (int i = 1; i + 1 < NT; i += 2) {
    STEP(pB0, pB1, pA0, pA1, i, true);
    STEP(pA0, pA1, pB0, pB1, i + 1, (i + 3 < NT));
  }
  SBAR(); qkt(pB0, pB1, K_lds + sk * SHM_K, qr, r32, hi, map);
  finishSM(pA0, pA1, l_reg, pa0, pa1, pa2, pa3); SBAR();
  pv_sm(o, vb0 + sv * SHM_V, pa0, pa1, pa2, pa3, pB0, pB1, DQ(jlo + NT - 1), c2);
  finishSM(pB0, pB1, l_reg, pa0, pa1, pa2, pa3); SBAR();
  pv_d0(o, vb0 + sk * SHM_V, pa0, pa1, pa2, pa3);
#undef STEP
#undef TK
  __builtin_amdgcn_s_setprio(0);
  if (hi == 0) li_l[r32] = l_reg; asm volatile("s_waitcnt lgkmcnt(0)" ::: "memory");
  float rli[16];
#pragma unroll
  for (int r = 0; r < 16; ++r) rli[r] = __builtin_amdgcn_rcpf(li_l[crow(r, hi)]);
  __syncthreads();
  float* X = (float*)lds + qg * 4096;
  if (map == 1) {
#pragma unroll
    for (int r = 0; r < 16; ++r) { const float s = rli[r] * lam;
#pragma unroll
      for (int d0 = 0; d0 < 4; ++d0) X[crow(r, hi) * 128 + d0 * 32 + r32] = o[d0][r] * s; }
  }
  __syncthreads();
  if (map == 0) {
#pragma unroll
    for (int r = 0; r < 16; ++r) { float ss = 0.f;
#pragma unroll
      for (int d0 = 0; d0 < 4; ++d0) { const int ix = crow(r, hi) * 128 + d0 * 32 + r32; const float v = o[d0][r] * rli[r] - X[ix]; X[ix] = v; ss += v * v; }
#pragma unroll
      for (int of = 1; of < 32; of <<= 1) ss += __shfl_xor(ss, of);
      if (r32 == 0) al_l[crow(r, hi)] = __builtin_amdgcn_rsqf(ss * (1.f / 128.f) + NORM_EPS) * 0.8f;
    }
    asm volatile("s_waitcnt lgkmcnt(0)" ::: "memory");
    const int cc = lane & 15;
    float wv[8];
#pragma unroll
    for (int e = 0; e < 8; ++e) wv[e] = onw[cc * 8 + e];
    bf16_t* Ob = MIX + (tok0 + q0 + qg * 32 + (lane >> 4)) * DM + h * 128 + cc * 8;
    const float* Xr = X + (lane >> 4) * 128 + cc * 8;
#pragma unroll
    for (int it = 0; it < 8; ++it) {
      const f32x4 x0 = *(const f32x4*)(Xr + it * 512), x1 = *(const f32x4*)(Xr + it * 512 + 4); const float rs = al_l[it * 4 + (lane >> 4)];
      u32x4 w; w.x = cvtpk(x0[0] * rs * wv[0], x0[1] * rs * wv[1]); w.y = cvtpk(x0[2] * rs * wv[2], x0[3] * rs * wv[3]);
      w.z = cvtpk(x1[0] * rs * wv[4], x1[1] * rs * wv[5]); w.w = cvtpk(x1[2] * rs * wv[6], x1[3] * rs * wv[7]);
      *(u32x4*)(Ob + (size_t)it * 4 * DM) = w;
    }
  }
  __syncthreads();
#undef SLOAD
#undef SWRITE
#undef DQ
#undef REL
}
}

namespace rec {
constexpr int CH = 32, NCH = SEQL / CH, QP = 136, SP = 40;
constexpr int OFF_QT = 0, OFF_KH = CH * QP * 2, OFF_KT = 2 * CH * QP * 2, OFF_VT = OFF_KT + 128 * SP * 2, OFF_DD = OFF_VT + 128 * SP * 2, OFF_TOT = OFF_DD + 512, DIRB = OFF_TOT + 2048;
static_assert(DIRB % 16 == 0 && 2 * DIRB <= 131072, "rec LDS map");
__device__ __forceinline__ int crow(int r, int hi) { return (r & 3) + 8 * (r >> 2) + 4 * hi; }
__device__ __forceinline__ bf16x8 pack8(float a0, float a1, float a2, float a3, float a4, float a5, float a6, float a7) {
  u32x4 w = {cvtpk(a0, a1), cvtpk(a2, a3), cvtpk(a4, a5), cvtpk(a6, a7)}; return *reinterpret_cast<bf16x8*>(&w);
}
__device__ __forceinline__ void rec_unit(const bf16_t* __restrict__ P, bf16_t* __restrict__ OF, bf16_t* __restrict__ OB, int bh, unsigned char* ldsg) {
  const int tid = threadIdx.x, wid = __builtin_amdgcn_readfirstlane(tid >> 6), lane = tid & 63, r32 = lane & 31, hi = lane >> 5;
  const int dir = wid >> 2, wv = wid & 3, b = bh >> 2, h = bh & 3;
  unsigned char* lb = ldsg + dir * DIRB;
  bf16_t* Qt = (bf16_t*)(lb + OFF_QT); bf16_t* Kh = (bf16_t*)(lb + OFF_KH); bf16_t* KtT = (bf16_t*)(lb + OFF_KT); bf16_t* VT = (bf16_t*)(lb + OFF_VT);
  float* dd = (float*)(lb + OFF_DD); float* tot = (float*)(lb + OFF_TOT);
  const bf16_t* base = P + (size_t)b * SEQL * INW;
  const int cq = 1536 + h * 128 + 2 * lane, cgt = (dir ? 2560 : 2048) + h * 128 + 2 * lane, cv = 3072 + h * 128 + 2 * lane;
  bf16_t* O = (dir ? OB : OF) + (size_t)b * SEQL * 512 + h * 128 + wv * 32 + r32;
  f32x16 S[4];
#pragma unroll
  for (int k = 0; k < 4; ++k) S[k] = f32x16{};
  unsigned pq[8], pg[8], pv[8];
#define TOKOF(s) (dir ? (SEQL - 1 - (s)) : (s))
#define LOADCHUNK(c) do { _Pragma("unroll") for (int i = 0; i < 8; ++i) { const bf16_t* rp = base + (size_t)TOKOF((c) * CH + wv * 8 + i) * INW; \
    pq[i] = *(const unsigned*)(rp + cq); pg[i] = *(const unsigned*)(rp + cgt); pv[i] = *(const unsigned*)(rp + cv); } } while (0)
  LOADCHUNK(0);
#define RBAR() asm volatile("s_waitcnt lgkmcnt(0)\n\ts_barrier" ::: "memory")
  if (dir == 1) { RBAR(); RBAR(); }
  for (int c = 0; c < NCH; ++c) {
    float gl0[8], gl1[8]; float G0 = 0.f, G1 = 0.f;
#pragma unroll
    for (int i = 0; i < 8; ++i) { G0 += bf_lo(pg[i]); G1 += bf_hi(pg[i]); gl0[i] = G0; gl1[i] = G1; }
    *(f32x2*)&tot[wv * 128 + 2 * lane] = (f32x2){G0, G1};
    RBAR();
    float P0 = 0.f, P1 = 0.f, C0 = 0.f, C1 = 0.f;
#pragma unroll
    for (int w = 0; w < 4; ++w) { const f32x2 t = *(const f32x2*)&tot[w * 128 + 2 * lane]; if (w < wv) { P0 += t[0]; P1 += t[1]; } C0 += t[0]; C1 += t[1]; }
    float kta[8], ktb[8];
#pragma unroll
    for (int i = 0; i < 8; ++i) {
      const float Ga = P0 + gl0[i], Gb = P1 + gl1[i];
      const float kfa = 1.f - ex2(bf_lo(pg[i])), kfb = 1.f - ex2(bf_hi(pg[i]));
      *(unsigned*)&Qt[(wv * 8 + i) * QP + 2 * lane] = cvtpk(bf_lo(pq[i]) * ex2(Ga), bf_hi(pq[i]) * ex2(Gb));
      *(unsigned*)&Kh[(wv * 8 + i) * QP + 2 * lane] = cvtpk(kfa * ex2(fminf(-Ga, 100.f)), kfb * ex2(fminf(-Gb, 100.f)));
      kta[i] = kfa * ex2(C0 - Ga); ktb[i] = kfb * ex2(C1 - Gb);
    }
    *(bf16x8*)&KtT[(2 * lane) * SP + wv * 8] = pack8(kta[0], kta[1], kta[2], kta[3], kta[4], kta[5], kta[6], kta[7]);
    *(bf16x8*)&KtT[(2 * lane + 1) * SP + wv * 8] = pack8(ktb[0], ktb[1], ktb[2], ktb[3], ktb[4], ktb[5], ktb[6], ktb[7]);
    { u32x4 a, bb;
      a.x = (pv[0] & 0xffffu) | (pv[1] << 16); a.y = (pv[2] & 0xffffu) | (pv[3] << 16); a.z = (pv[4] & 0xffffu) | (pv[5] << 16); a.w = (pv[6] & 0xffffu) | (pv[7] << 16);
      bb.x = (pv[0] >> 16) | (pv[1] & 0xffff0000u); bb.y = (pv[2] >> 16) | (pv[3] & 0xffff0000u); bb.z = (pv[4] >> 16) | (pv[5] & 0xffff0000u); bb.w = (pv[6] >> 16) | (pv[7] & 0xffff0000u);
      *(u32x4*)&VT[(2 * lane) * SP + wv * 8] = a; *(u32x4*)&VT[(2 * lane + 1) * SP + wv * 8] = bb; }
    if (wv == 0) *(f32x2*)&dd[2 * lane] = (f32x2){ex2(C0), ex2(C1)};
    if (c + 1 < NCH) LOADCHUNK(c + 1);
    RBAR();
    f32x16 aT = f32x16{};
#pragma unroll
    for (int ks = 0; ks < 8; ++ks) { const bf16x8 a = *(const bf16x8*)&Kh[r32 * QP + ks * 16 + hi * 8]; const bf16x8 bq = *(const bf16x8*)&Qt[r32 * QP + ks * 16 + hi * 8];
      aT = __builtin_amdgcn_mfma_f32_32x32x16_bf16(a, bq, aT, 0, 0, 0); }
#pragma unroll
    for (int r = 0; r < 16; ++r) if (crow(r, hi) > r32) aT[r] = 0.f;
    f32x16 o = f32x16{};
#pragma unroll
    for (int kt = 0; kt < 4; ++kt)
#pragma unroll
      for (int hh = 0; hh < 2; ++hh) {
        const s16x4 lo4 = *(const s16x4*)&Qt[r32 * QP + kt * 32 + hh * 16 + hi * 4], hi4 = *(const s16x4*)&Qt[r32 * QP + kt * 32 + hh * 16 + 8 + hi * 4];
        const bf16x8 a = {lo4[0], lo4[1], lo4[2], lo4[3], hi4[0], hi4[1], hi4[2], hi4[3]};
        const bf16x8 bs = pack8(S[kt][hh * 8 + 0], S[kt][hh * 8 + 1], S[kt][hh * 8 + 2], S[kt][hh * 8 + 3], S[kt][hh * 8 + 4], S[kt][hh * 8 + 5], S[kt][hh * 8 + 6], S[kt][hh * 8 + 7]);
        o = __builtin_amdgcn_mfma_f32_32x32x16_bf16(a, bs, o, 0, 0, 0);
      }
#pragma unroll
    for (int hh = 0; hh < 2; ++hh) {
      const bf16x8 a = pack8(aT[hh * 8 + 0], aT[hh * 8 + 1], aT[hh * 8 + 2], aT[hh * 8 + 3], aT[hh * 8 + 4], aT[hh * 8 + 5], aT[hh * 8 + 6], aT[hh * 8 + 7]);
      const s16x4 lo4 = *(const s16x4*)&VT[(wv * 32 + r32) * SP + hh * 16 + hi * 4], hi4 = *(const s16x4*)&VT[(wv * 32 + r32) * SP + hh * 16 + 8 + hi * 4];
      const bf16x8 bv = {lo4[0], lo4[1], lo4[2], lo4[3], hi4[0], hi4[1], hi4[2], hi4[3]};
      o = __builtin_amdgcn_mfma_f32_32x32x16_bf16(a, bv, o, 0, 0, 0);
    }
    RBAR();
#pragma unroll
    for (int kt = 0; kt < 4; ++kt) {
#pragma unroll
      for (int q4 = 0; q4 < 4; ++q4) { const f32x4 d4 = *(const f32x4*)&dd[kt * 32 + q4 * 8 + hi * 4];
#pragma unroll
        for (int j = 0; j < 4; ++j) S[kt][q4 * 4 + j] *= d4[j]; }
#pragma unroll
      for (int ks = 0; ks < 2; ++ks) { const bf16x8 a = *(const bf16x8*)&KtT[(kt * 32 + r32) * SP + ks * 16 + hi * 8]; const bf16x8 bv = *(const bf16x8*)&VT[(wv * 32 + r32) * SP + ks * 16 + hi * 8];
        S[kt] = __builtin_amdgcn_mfma_f32_32x32x16_bf16(a, bv, S[kt], 0, 0, 0); }
    }
#pragma unroll
    for (int r = 0; r < 16; ++r) { const int tk = TOKOF(c * CH + crow(r, hi)); O[(size_t)tk * 512] = (bf16_t)(cvtpk(o[r], 0.f) & 0xffffu); }
    RBAR();
  }
  if (dir == 0) { RBAR(); RBAR(); }
  __syncthreads();
#undef RBAR
#undef TOKOF
#undef LOADCHUNK
}
}

#define XB_TMO      128
#define XB_XCNT(j)  (256  + 64 * (j))
#define XB_XSUB(j)  (1280 + 64 * (j))
#define XB_XGEN(j)  (2304 + 64 * (j))
#define XB_TOP      3328
#define XB_TOPGEN   3392
#define XCD_BAR_WORDS 3456
#define XB_SPIN_CAP (1u << 18)

__device__ __forceinline__ unsigned xb_ld(unsigned* p)              { return __hip_atomic_load(p, __ATOMIC_RELAXED, __HIP_MEMORY_SCOPE_AGENT); }
__device__ __forceinline__ unsigned xb_add(unsigned* p, unsigned v) { return __hip_atomic_fetch_add(p, v, __ATOMIC_RELAXED, __HIP_MEMORY_SCOPE_AGENT); }
__device__ __forceinline__ unsigned xb_xcc_id() { return (unsigned)__builtin_amdgcn_s_getreg((3 << 11) | 20) & 0xFu; }
#define XB_SPIN(cond, bar) do { unsigned _sp = 0; while (cond) { __builtin_amdgcn_s_sleep(1); \
    if ((++_sp & 255u) == 0u) { if (xb_ld(&(bar)[XB_TMO])) break; if (_sp > XB_SPIN_CAP) { atomicAdd(&(bar)[XB_TMO], 1u); break; } } } } while (0)

struct XcdBarrier {
    unsigned* bar; unsigned x;
    volatile LAS unsigned* st;
};

__device__ __forceinline__ XcdBarrier xcd_barrier_post(unsigned* bar, volatile LAS unsigned* st) {
    XcdBarrier b; b.bar = bar; b.x = xb_xcc_id(); b.st = st;
    if (threadIdx.x == 0) (void)xb_add(&bar[XB_XCNT(b.x)], 1u);
    return b;
}
__device__ __forceinline__ void xcd_barrier_complete(unsigned* bar, unsigned x, unsigned& nloc, unsigned& nx) {
    const unsigned G = gridDim.x * gridDim.y * gridDim.z;
    unsigned sum, cnt, mine, sp = 0u;
    for (;;) {
        sum = 0u; cnt = 0u; mine = 0u;
#pragma unroll
        for (unsigned j = 0; j < 16; ++j) { const unsigned c = xb_ld(&bar[XB_XCNT(j)]); sum += c; cnt += (c > 0u) ? 1u : 0u; mine = (j == x) ? c : mine; }
        if (sum == G) break;
        __builtin_amdgcn_s_sleep(1);
        if ((++sp & 255u) == 0u) { if (xb_ld(&bar[XB_TMO])) break; if (sp > XB_SPIN_CAP) { atomicAdd(&bar[XB_TMO], 1u); break; } }
    }
    nloc = mine > 0u ? mine : 1u; nx = cnt > 0u ? cnt : 1u;
}

__device__ __forceinline__ void xcd_barrier(const XcdBarrier& b) {
    asm volatile("s_waitcnt vmcnt(0)" ::: "memory");
    __syncthreads();
    if (threadIdx.x == 0) {
        unsigned* bar = b.bar;
        __builtin_amdgcn_s_waitcnt(0);
        unsigned nloc = b.st[0], nx = b.st[1];
        if (nloc == 0u) { xcd_barrier_complete(bar, b.x, nloc, nx); b.st[0] = nloc; b.st[1] = nx; }
        const unsigned old = xb_add(&bar[XB_XSUB(b.x)], 1u);
        const unsigned gen = old / nloc;
        if (old + 1u == (gen + 1u) * nloc) {
            __builtin_amdgcn_fence(__ATOMIC_RELEASE, "agent");
            asm volatile("s_waitcnt vmcnt(0)" ::: "memory");
            const unsigned og = xb_add(&bar[XB_TOP], 1u);
            const unsigned tg = og / nx;
            if (og + 1u == (tg + 1u) * nx) xb_add(&bar[XB_TOPGEN], 1u);
            else XB_SPIN(xb_ld(&bar[XB_TOPGEN]) == tg, bar);
            __builtin_amdgcn_fence(__ATOMIC_ACQUIRE, "agent");
            xb_add(&bar[XB_XGEN(b.x)], 1u);
            asm volatile("s_waitcnt vmcnt(0)" ::: "memory");
        } else {
            XB_SPIN(xb_ld(&bar[XB_XGEN(b.x)]) == gen, bar);
            __builtin_amdgcn_fence(__ATOMIC_ACQUIRE, "agent");
            asm volatile("s_waitcnt vmcnt(0)" ::: "memory");
        }
    }
    __syncthreads();
}

struct Args { const float* in[20]; float* out; unsigned char* ws; int ph_lo, ph_hi; };
constexpr int NPH = 9;
constexpr int N_ATT_UNITS = NSEQ * NHEAD * (SEQL / 128), N_REC_UNITS = NSEQ * NHEAD;

__global__ void __launch_bounds__(512, 2) fwd_kernel(Args args) {
    extern __shared__ __attribute__((aligned(16))) unsigned char lds[];
    cg::grid_group grid = cg::this_grid();
    const int wave = __builtin_amdgcn_readfirstlane((int)threadIdx.x >> 6);
#define PHASE_IDS int tid = threadIdx.x; asm volatile("" : "+v"(tid)); const int lane = tid & 63; (void)lane;
    const int G = gridDim.x, gw = blockIdx.x * 8 + wave, NGW = G * 8;
    unsigned char* ws = args.ws;
    const float* xp = args.in[0]; const float* xs = args.in[1];
    bf16_t* W_in = (bf16_t*)(ws + WS_WIN); bf16_t* W_out = (bf16_t*)(ws + WS_WOUT); bf16_t* W_up = (bf16_t*)(ws + WS_WUP); bf16_t* W_down = (bf16_t*)(ws + WS_WDOWN);
    bf16_t* XN = (bf16_t*)(ws + WS_XN); bf16_t* PROJ = (bf16_t*)(ws + WS_PROJ); bf16_t* OFb = (bf16_t*)(ws + WS_OF); bf16_t* OBb = (bf16_t*)(ws + WS_OB);
    bf16_t* ACT = (bf16_t*)(ws + WS_ACT); bf16_t* X1B = (bf16_t*)(ws + WS_OF);
    unsigned* ctl = (unsigned*)(ws + WS_CTL);
    PG8_LAS unsigned char* ldsl = (PG8_LAS unsigned char*)lds;
    const int lo = args.ph_lo, hi = args.ph_hi;
    volatile LAS unsigned* xst = (volatile LAS unsigned*)(ldsl + LDS_MISC + 64);
    if (threadIdx.x < 2) xst[threadIdx.x] = 0u;
    __syncthreads();
    XcdBarrier xbar; xbar.bar = ctl + 4096; xbar.x = 0; xbar.st = xst;
#ifndef PHMASK
#define PHMASK 0xffff
#endif
#define IN(k) (((PHMASK >> (k)) & 1) && lo <= (k) && (k) < hi)
#define SEAM(k) do { if (IN(k) && IN((k) + 1)) { if ((k) == 0) grid.sync(); else xcd_barrier(xbar); } } while (0)
#ifndef REPEAT_PH
#define REPEAT_PH -1
#endif
#define NREP(k) ((REPEAT_PH == (k)) ? 2 : 1)

    if (IN(0)) {
        PHASE_IDS
        if (blockIdx.x == 0) for (int i = tid; i < 8192; i += 512) ctl[i] = 0u;
        LAS float* scr = (LAS float*)(ldsl + wave * 16384);
        constexpr int I_IN = (DM / 64) * (INW / 32), I_OUT = (DM / 64) * (DM / 32), I_UP = (DM / 64) * (DFF2 / 32), I_DOWN = (DFF / 64) * (DM / 32);
        for (int it = gw; it < I_IN + I_OUT + I_UP + I_DOWN; it += NGW) {
            int r = it;
            if (r < I_IN) { p0_transpose_item(args.in[3], DM, INW, W_in, scr, r, lane); continue; } r -= I_IN;
            if (r < I_OUT) { p0_transpose_item(args.in[14], DM, DM, W_out, scr, r, lane); continue; } r -= I_OUT;
            if (r < I_UP) { p0_transpose_item(args.in[16], DM, DFF2, W_up, scr, r, lane, true); continue; } r -= I_UP;
            p0_transpose_item(args.in[19], DFF, DM, W_down, scr, r, lane);
        }
        for (int m = gw * 2; m < MTOK; m += NGW * 2) rms_row2_to_bf16(xrow_ptr(xp, xs, m), xrow_ptr(xp, xs, m + 1), args.in[2], XN + (size_t)m * DM, XN + (size_t)(m + 1) * DM, lane);
    }
    SEAM(0);
    if (IN(0) && IN(1)) xbar = xcd_barrier_post(ctl + 4096, xst);
    for (int rep = 0; rep < NREP(1); ++rep) { if (rep) grid.sync();
    if (IN(1)) {
        pg8::Gemm g{XN, W_in, MTOK, INW, DM}; pg8::StaticOrder S; S.init(MTOK, INW, G, (int)blockIdx.x);
        EpiInProj E{PROJ, args.in[11], args.in[12], args.in[4], args.in[5], (PG8_LAS float*)(ldsl + 131072)};
        pg8::gemm_phase<EpiInProj, pg8::StaticOrder, true, true>(ldsl, g, S, E);
    } }
    SEAM(1);
    for (int rep = 0; rep < NREP(3); ++rep) { if (rep) grid.sync();
    if (IN(3)) {
        PHASE_IDS
        float lam; int Wh[4];
        { const float a = args.in[6][lane] * args.in[7][lane], b = args.in[8][lane] * args.in[9][lane];
          lam = ex2(wave_sum(a) * LOG2E) - ex2(wave_sum(b) * LOG2E) + 0.2f;
          float mq = fabsf(args.in[4][lane]), mk = fabsf(args.in[5][lane]);
#pragma unroll
          for (int o = 1; o < 64; o <<= 1) { mq = fmaxf(mq, __shfl_xor(mq, o)); mk = fmaxf(mk, __shfl_xor(mk, o)); }
          const float S2 = 8.f * LOG2E * 1.01f * 1.01f * mq * mk;
#pragma unroll
          for (int h = 0; h < 4; ++h) { const float c2h = LOG2E * (h == 0 ? 0.25f : h == 1 ? 0.0625f : h == 2 ? 0.015625f : 0.00390625f);
            const float need = 2.f * S2 + 30.f + lg2(2.f / (1.f - ex2(-c2h)));
            const float wf = need / c2h; Wh[h] = wf >= (float)SEQL ? SEQL : (int)wf + 1; } }
#ifndef NO_REC
#ifndef REC_REPS
#define REC_REPS 1
#endif
        for (int rr2 = 0; rr2 < REC_REPS; ++rr2)
        for (int u = blockIdx.x; u < N_REC_UNITS; u += G) rec::rec_unit(PROJ, OFb, OBb, u, lds);
#endif
        volatile int* misc = (volatile int*)(lds + LDS_MISC);
        int myq = (int)(__builtin_amdgcn_s_getreg((3 << 11) | 20) & 7u);
        constexpr int QN = 320;
        for (int tries = 0; tries < 8;) {
            if (tid == 0) misc[0] = (int)atomicAdd(ctl + 64 + 32 * myq, 1u);
            __syncthreads();
            const int t = __builtin_amdgcn_readfirstlane(misc[0]);
            __syncthreads();
            if (t >= QN) { myq = (myq + 1) & 7; ++tries; continue; }
            int b, hh, qb;
            { int i2 = t, base = 0; hh = 3;
              for (int seg = 0; seg < 4; ++seg) { if (i2 < 64) { b = myq; qb = i2; hh = 3 - seg; base = 1; break; } i2 -= 64; if (i2 < 16) { b = 8 + (i2 >> 3); qb = 8 * myq + (i2 & 7); hh = 3 - seg; base = 1; break; } i2 -= 16; }
              (void)base; }
#ifndef NO_ATT
            att::attn_unit(PROJ, XN, args.in[10], lam, b * 4 + hh, qb, hh == 0 ? Wh[0] : hh == 1 ? Wh[1] : hh == 2 ? Wh[2] : Wh[3], (char*)lds);
#endif
        }
    } }
    SEAM(3);
    for (int rep = 0; rep < NREP(4); ++rep) { if (rep) grid.sync();
    if (IN(4)) {
        PHASE_IDS
        const int h4 = lane >> 4, c8 = (lane & 15) * 8;
        float w8[8];
#pragma unroll
        for (int e = 0; e < 8; ++e) w8[e] = args.in[13][c8 + e];
        for (int m0 = gw * 4; m0 < MTOK; m0 += NGW * 4) {
            u32x4 fa[4], fb[4], fg[4];
#pragma unroll
            for (int u = 0; u < 4; ++u) { const size_t m = m0 + u;
                fa[u] = *(const u32x4*)(OFb + m * 512 + h4 * 128 + c8); fb[u] = *(const u32x4*)(OBb + m * 512 + h4 * 128 + c8); fg[u] = *(const u32x4*)(PROJ + m * INW + 3584 + h4 * 128 + c8); }
#pragma unroll
            for (int u = 0; u < 4; ++u) {
                float v[8]; float sq = 0.f;
#pragma unroll
                for (int e = 0; e < 4; ++e) { v[2 * e] = bf_lo(fa[u][e]) + bf_lo(fb[u][e]); v[2 * e + 1] = bf_hi(fa[u][e]) + bf_hi(fb[u][e]); sq += v[2 * e] * v[2 * e] + v[2 * e + 1] * v[2 * e + 1]; }
                sq += __shfl_xor(sq, 1); sq += __shfl_xor(sq, 2); sq += __shfl_xor(sq, 4); sq += __shfl_xor(sq, 8);
                const float rs = __builtin_amdgcn_rsqf(sq * (1.f / 128.f) + NORM_EPS);
                u32x4 o;
#pragma unroll
                for (int e = 0; e < 4; ++e) o[e] = cvtpk(v[2 * e] * rs * w8[2 * e] * bf_lo(fg[u][e]), v[2 * e + 1] * rs * w8[2 * e + 1] * bf_hi(fg[u][e]));
                *(u32x4*)(XN + (size_t)(m0 + u) * DM + 512 + h4 * 128 + c8) = o;
            }
        }
    }
    }
    SEAM(4);
    for (int rep = 0; rep < NREP(5); ++rep) { if (rep) grid.sync();
    if (IN(5)) {
        pg8::Gemm g{XN, W_out, MTOK, DM, DM}; pg8::StaticOrder S; S.init(MTOK, DM, G, (int)blockIdx.x);
        EpiResidB E{xp, xs, X1B};
        pg8::gemm_phase<EpiResidB, pg8::StaticOrder, true, true>(ldsl, g, S, E);
    }
    }
    SEAM(5);
    for (int rep = 0; rep < NREP(6); ++rep) { if (rep) grid.sync();
    if (IN(6)) {
        PHASE_IDS
        for (int m = gw * 2; m < MTOK; m += NGW * 2) rms_rowb2_to_bf16(X1B + (size_t)m * DM, X1B + (size_t)(m + 1) * DM, args.in[15], XN + (size_t)m * DM, XN + (size_t)(m + 1) * DM, lane);
    }
    }
    SEAM(6);
    for (int rep = 0; rep < NREP(7); ++rep) { if (rep) grid.sync();
    if (IN(7)) {
        pg8::Gemm g{XN, W_up, NSEQ * 33 * 256, DFF2, DM}; pg8::StaticOrder S; S.init(NSEQ * 33 * 256, DFF2, G, (int)blockIdx.x); S.ovl = 1;
        EpiConvAct E{ACT, args.in[17], args.in[18], (PG8_LAS float*)(ldsl + 131072)};
        pg8::gemm_phase<EpiConvAct, pg8::StaticOrder, true, true>(ldsl, g, S, E);
    } }
    SEAM(7);
    if (IN(8)) {
        pg8::Gemm g{ACT, W_down, MTOK, DM, DFF}; pg8::StaticOrder S; S.init(MTOK, DM, G, (int)blockIdx.x);
        EpiFinal E{X1B, args.out};
        pg8::gemm_phase<EpiFinal, pg8::StaticOrder, true, true>(ldsl, g, S, E);
    }
#undef IN
#undef SEAM
}

#ifndef ONE_LAUNCH
#define ONE_LAUNCH 1
#endif
extern "C" void kernel_launch(void* const* d_in, const int* in_sizes, int n_in, void* d_out, int out_size, void* d_ws, size_t ws_size, hipStream_t stream) {
    static int grid = 0;
    if (grid == 0) {
        if (n_in != 20 || out_size != MTOK * DM || ws_size < WS_END) { fprintf(stderr, "kernel_launch: unexpected shapes n_in %d out %d ws %zu (need %zu)\n", n_in, out_size, ws_size, (size_t)WS_END); grid = -1; return; }
        int dev = 0, cus = 0, per_cu = 0;
        (void)hipGetDevice(&dev); (void)hipDeviceGetAttribute(&cus, hipDeviceAttributeMultiprocessorCount, dev);
        if (hipFuncSetAttribute((const void*)fwd_kernel, hipFuncAttributeMaxDynamicSharedMemorySize, LDS_BYTES) != hipSuccess) { fprintf(stderr, "kernel_launch: hipFuncSetAttribute failed\n"); grid = -1; return; }
        (void)hipOccupancyMaxActiveBlocksPerMultiprocessor(&per_cu, (const void*)fwd_kernel, 512, LDS_BYTES);
        if (per_cu < 1) { fprintf(stderr, "kernel_launch: occupancy query says %d\n", per_cu); per_cu = 1; }
        (void)hipGetLastError();
        grid = cus * per_cu;
    }
    if (grid < 0) return;
#if !ONE_LAUNCH
    (void)hipMemsetAsync((char*)d_ws + WS_CTL, 0, 32768, stream);
#endif
    Args a{};
    for (int i = 0; i < 20; ++i) a.in[i] = (const float*)d_in[i];
    a.out = (float*)d_out; a.ws = (unsigned char*)d_ws;
#if ONE_LAUNCH
    a.ph_lo = 0; a.ph_hi = NPH;
    void* kargs[] = {&a};
    hipError_t e = hipLaunchCooperativeKernel((const void*)fwd_kernel, dim3(grid), dim3(512), kargs, LDS_BYTES, stream);
    if (e != hipSuccess) fprintf(stderr, "cooperative launch failed: %s (grid %d)\n", hipGetErrorString(e), grid);
#else
    for (int p = 0; p < NPH; ++p) {
        a.ph_lo = p; a.ph_hi = p + 1;
        hipLaunchKernelGGL(fwd_kernel, dim3(grid), dim3(512), LDS_BYTES, stream, a);
    }
#endif
}
```

```cpp
#include <hip/hip_runtime.h>
#include <hip/hip_cooperative_groups.h>
#include <cstdio>
#include <cstdint>
namespace cg = cooperative_groups;

namespace pg8 {
#define PG8_LAS __attribute__((address_space(3)))
typedef unsigned short bf16_t;
typedef short bf16x8 __attribute__((ext_vector_type(8)));
typedef float f32x4 __attribute__((ext_vector_type(4)));
typedef unsigned u32x4 __attribute__((ext_vector_type(4)));
constexpr int BM = 256, BK = 64, HALF = 128, HTB = HALF * BK * 2  , STAGE_BYTES = 8 * HTB, NXCD = 8, WGM = 8;

__host__ __device__ __forceinline__ int lds_byte(int r, int c) { const int st = (r >> 4) * 2 + (c >> 5), rr = r & 15, cc = c & 31, ob = rr * 64 + cc * 2; return st * 1024 + (ob ^ (((ob >> 9) & 1) << 5)); }
__host__ __device__ __forceinline__ void stage_rc(int b, int& R, int& C) { const int st = b / 1024, sb = b % 1024, swz = sb ^ (((sb >> 9) & 1) << 5); R = (st >> 1) * 16 + swz / 64; C = (st & 1) * 32 + (swz % 64) / 2; }
__host__ __device__ __forceinline__ int perm32(int rho) { const int n = rho >> 4, i = rho & 15; return 8 * (i >> 2) + 4 * n + (i & 3); }

struct Unit { int pm, pn; };
struct Gemm { const bf16_t* A; const bf16_t* Bt; int M, N, K; };

struct StaticOrder {
    int nM, nN, nwg, G, c;
    __host__ __device__ void init(int M, int N, int G_, int c_) { nM = M / BM; nN = N / BM; nwg = nM * nN; G = G_; c = c_; }
    __host__ __device__ bool next(int i, Unit& u) const {
        const long L = (long)i * G + c; if (L >= nwg) return false;
        int wgid = (int)L; { const int q = nwg / NXCD, r = nwg % NXCD, xcd = wgid % NXCD, off = wgid / NXCD; wgid = (xcd < r ? xcd * (q + 1) : r * (q + 1) + (xcd - r) * q) + off; }
        const int nig = WGM * nN, gid = wgid / nig, fm = gid * WGM, gsz = (nM - fm) < WGM ? (nM - fm) : WGM;
        u.pm = fm + ((wgid % nig) % gsz); u.pn = (wgid % nig) / gsz; return true;
    }
    int ovl = 0;
    __device__ __forceinline__ long arow(const Unit& u) const { return ovl ? (long)(u.pm / 33) * 8192 + 254 * (u.pm % 33) - 1 : (long)u.pm * BM; }
    __device__ __forceinline__ void a_ready(const Unit&) const {}
    __device__ __forceinline__ void done(const Unit&) const {}
};

__device__ __forceinline__ unsigned cvt_pk_bf16(float lo, float hi) { unsigned r; asm volatile("v_cvt_pk_bf16_f32 %0, %1, %2" : "=v"(r) : "v"(lo), "v"(hi)); return r; }
typedef float f32x2 __attribute__((ext_vector_type(2)));
template <class Epi, class Sched, bool ALIGN_EPI = false, bool SP2 = false>
__device__ __forceinline__ void gemm_phase(PG8_LAS unsigned char* lds, const Gemm g, const Sched& S, const Epi& E) {
    int tid = threadIdx.x; asm volatile("" : "+v"(tid));
    const int wid = __builtin_amdgcn_readfirstlane(tid >> 6), lane = tid & 63, wr = wid >> 2, wc = wid & 3, fr = lane & 15, fq = lane >> 4;
    const int K = g.K, nt = K / BK;
    unsigned voffA[2], voffB[2];
#pragma unroll
    for (int i = 0; i < 2; ++i) { int R, C; stage_rc(tid * 16 + i * 8192, R, C); const int Rb = Epi::PERM ? ((R & ~31) + perm32(R & 31)) : R;
        const int Ra = S.ovl ? ((R & ~63) + 4 * (R & 15) + ((R >> 4) & 3)) : R;
        voffA[i] = (unsigned)(Ra * K + C) * 2u; voffB[i] = (unsigned)(Rb * K + C) * 2u; }
    const size_t kstep = (size_t)(BK * 2);
    const size_t hstep = (size_t)HALF * K * 2;
    const size_t tstep = 2 * hstep;
    const unsigned ldsw = (unsigned)wid * 1024u;
    const int aoff = lds_byte(wr * 64 + fr, fq * 8), boff = lds_byte(wc * 32 + fr, fq * 8);
#define PG8_SA(b, h) (((b) * 2 + (h)) * HTB)
#define PG8_SB(b, h) ((4 + (b) * 2 + (h)) * HTB)
#define PG8_STAGE(bufoff, gbase, voff) do { _Pragma("unroll") for (int _i = 0; _i < 2; ++_i) \
        __builtin_amdgcn_global_load_lds((const unsigned*)((const char*)(gbase) + (voff)[_i]), (PG8_LAS unsigned*)(lds + (bufoff) + ldsw + _i * 8192), 16, 0, 0); } while (0)
#define PG8_LDA(dst, b, h) do { _Pragma("unroll") for (int m = 0; m < 4; ++m) _Pragma("unroll") for (int k = 0; k < 2; ++k) dst[m][k] = *(const PG8_LAS bf16x8*)(lds + PG8_SA(b, h) + aoff + m * 2048 + k * 1024); } while (0)
#define PG8_LDB(dst, b, h) do { _Pragma("unroll") for (int n = 0; n < 2; ++n) _Pragma("unroll") for (int k = 0; k < 2; ++k) dst[n][k] = *(const PG8_LAS bf16x8*)(lds + PG8_SB(b, h) + boff + n * 2048 + k * 1024); } while (0)
#define PG8_MMA(ai, bj, At, Bt) do { __builtin_amdgcn_s_setprio(1); _Pragma("unroll") for (int m = 0; m < 4; ++m) _Pragma("unroll") for (int n = 0; n < 2; ++n) _Pragma("unroll") for (int k = 0; k < 2; ++k) \
        acc[ai][bj][m][n] = __builtin_amdgcn_mfma_f32_16x16x32_bf16(Bt[n][k], At[m][k], acc[ai][bj][m][n], 0, 0, 0); __builtin_amdgcn_s_setprio(0); } while (0)
#define PG8_WAIT_V(n) asm volatile("s_waitcnt vmcnt(" #n ")" ::: "memory")
#define PG8_WAIT_L(n) asm volatile("s_waitcnt lgkmcnt(" #n ")" ::: "memory")
#define PG8_BAR __builtin_amdgcn_s_barrier()
#define PG8_SCHED __builtin_amdgcn_sched_barrier(0)
    Unit cur, nxt; int ui = 0;
    if (!S.next(0, cur)) return;
    f32x4 acc[2][2][4][2];
#pragma unroll
    for (int a = 0; a < 2; ++a)
#pragma unroll
        for (int b = 0; b < 2; ++b)
#pragma unroll
            for (int m = 0; m < 4; ++m)
#pragma unroll
                for (int n = 0; n < 2; ++n) acc[a][b][m][n] = (f32x4){0.f, 0.f, 0.f, 0.f};
    bf16x8 At[4][2], B0[2][2], B1[2][2];
    const long rowb = (long)K * 2;
    const char* cA = (const char*)g.A + S.arow(cur) * rowb; const char* cB = (const char*)g.Bt + (size_t)cur.pn * tstep;
    S.a_ready(cur);
    if constexpr (SP2) {
        PG8_STAGE(PG8_SB(0, 0), cB, voffB); PG8_STAGE(PG8_SB(0, 1), cB + hstep, voffB); PG8_STAGE(PG8_SA(0, 0), cA, voffA); PG8_STAGE(PG8_SA(0, 1), cA + hstep, voffA);
        if (wr == 1) PG8_BAR;
        PG8_WAIT_V(2); PG8_BAR;
        PG8_STAGE(PG8_SB(1, 0), cB + kstep, voffB); PG8_STAGE(PG8_SA(1, 0), cA + kstep, voffA); PG8_STAGE(PG8_SB(1, 1), cB + hstep + kstep, voffB);
        PG8_WAIT_V(6); PG8_BAR;
    } else {
        PG8_STAGE(PG8_SB(0, 0), cB, voffB); PG8_STAGE(PG8_SA(0, 0), cA, voffA); PG8_STAGE(PG8_SB(0, 1), cB + hstep, voffB); PG8_STAGE(PG8_SA(0, 1), cA + hstep, voffA);
        if (wr == 1) PG8_BAR;
        PG8_WAIT_V(4); PG8_BAR;
        PG8_STAGE(PG8_SB(1, 0), cB + kstep, voffB); PG8_STAGE(PG8_SA(1, 0), cA + kstep, voffA); PG8_STAGE(PG8_SB(1, 1), cB + hstep + kstep, voffB);
        PG8_WAIT_V(6); PG8_BAR;
    }
    for (;;) {
        const bool has_next = S.next(ui + 1, nxt);
        const char* nA = has_next ? (const char*)g.A + S.arow(nxt) * rowb : cA; const char* nB = has_next ? (const char*)g.Bt + (size_t)nxt.pn * tstep : cB;
        for (int t = 0; t < nt; t += 2) {
            const bool last = (t == nt - 2);
            const char* a1 = cA + (size_t)(t + 1) * kstep;
            const char* a2 = last ? nA : cA + (size_t)(t + 2) * kstep; const char* b2 = last ? nB : cB + (size_t)(t + 2) * kstep;
            const char* a3 = a2 + kstep; const char* b3 = b2 + kstep;
            if (last && has_next) S.a_ready(nxt);
            if constexpr (SP2) {
            PG8_LDB(B0, 0, 0); PG8_LDB(B1, 0, 1); PG8_SCHED; PG8_LDA(At, 0, 0); PG8_STAGE(PG8_SA(1, 1), a1 + hstep, voffA);
            PG8_WAIT_V(8); PG8_WAIT_L(0); PG8_BAR; PG8_MMA(0, 0, At, B0); PG8_MMA(0, 1, At, B1); PG8_BAR; PG8_SCHED;
            PG8_LDA(At, 0, 1); PG8_STAGE(PG8_SB(0, 0), b2, voffB); PG8_STAGE(PG8_SB(0, 1), b2 + hstep, voffB); PG8_STAGE(PG8_SA(0, 0), a2, voffA);
            PG8_WAIT_V(8); PG8_WAIT_L(0); PG8_BAR; PG8_MMA(1, 0, At, B0); PG8_MMA(1, 1, At, B1); PG8_BAR; PG8_SCHED;
            PG8_LDB(B0, 1, 0); PG8_LDB(B1, 1, 1); PG8_SCHED; PG8_LDA(At, 1, 0); PG8_STAGE(PG8_SA(0, 1), a2 + hstep, voffA);
            PG8_WAIT_V(8); PG8_WAIT_L(0); PG8_BAR; PG8_MMA(0, 0, At, B0); PG8_MMA(0, 1, At, B1); PG8_BAR; PG8_SCHED;
            PG8_LDA(At, 1, 1); PG8_STAGE(PG8_SB(1, 0), b3, voffB); PG8_STAGE(PG8_SB(1, 1), b3 + hstep, voffB); PG8_STAGE(PG8_SA(1, 0), a3, voffA);
            PG8_WAIT_V(8); PG8_WAIT_L(0); PG8_BAR; PG8_MMA(1, 0, At, B0); PG8_MMA(1, 1, At, B1); PG8_BAR; PG8_SCHED;
            } else {
            PG8_LDB(B0, 0, 0); PG8_SCHED; PG8_LDA(At, 0, 0); PG8_STAGE(PG8_SA(1, 1), a1 + hstep, voffA);
            PG8_WAIT_L(8); PG8_BAR; PG8_WAIT_L(0); PG8_MMA(0, 0, At, B0); PG8_BAR; PG8_SCHED;
            PG8_LDB(B1, 0, 1); PG8_STAGE(PG8_SB(0, 0), b2, voffB);
            PG8_BAR; PG8_WAIT_L(0); PG8_MMA(0, 1, At, B1); PG8_BAR;
            PG8_LDA(At, 0, 1); PG8_STAGE(PG8_SA(0, 0), a2, voffA);
            PG8_BAR; PG8_WAIT_L(0); PG8_MMA(1, 0, At, B0); PG8_BAR; PG8_SCHED;
            PG8_STAGE(PG8_SB(0, 1), b2 + hstep, voffB);
            PG8_WAIT_V(6); PG8_BAR; PG8_MMA(1, 1, At, B1); PG8_BAR;
            PG8_LDB(B0, 1, 0); PG8_SCHED; PG8_LDA(At, 1, 0); PG8_STAGE(PG8_SA(0, 1), a2 + hstep, voffA);
            PG8_WAIT_L(8); PG8_BAR; PG8_WAIT_L(0); PG8_MMA(0, 0, At, B0); PG8_BAR; PG8_SCHED;
            PG8_LDB(B1, 1, 1); PG8_STAGE(PG8_SB(1, 0), b3, voffB);
            PG8_BAR; PG8_WAIT_L(0); PG8_MMA(0, 1, At, B1); PG8_BAR;
            PG8_LDA(At, 1, 1); PG8_STAGE(PG8_SA(1, 0), a3, voffA);
            PG8_BAR; PG8_WAIT_L(0); PG8_MMA(1, 0, At, B0); PG8_BAR; PG8_SCHED;
            PG8_STAGE(PG8_SB(1, 1), b3 + hstep, voffB);
            PG8_WAIT_V(6); PG8_BAR; PG8_MMA(1, 1, At, B1); PG8_BAR;
            }
        }
        if constexpr (ALIGN_EPI) { if (wr == 0) PG8_BAR; }
        if constexpr (!Epi::AFTER_DRAIN) { E(acc, cur, wr, wc, fr, fq); S.done(cur); }
        if (!has_next) break;
#pragma unroll
        for (int a = 0; a < 2; ++a)
#pragma unroll
            for (int b = 0; b < 2; ++b)
#pragma unroll
                for (int m = 0; m < 4; ++m)
#pragma unroll
                    for (int n = 0; n < 2; ++n) acc[a][b][m][n] = (f32x4){0.f, 0.f, 0.f, 0.f};
        cur = nxt; cA = nA; cB = nB; ++ui;
        if constexpr (ALIGN_EPI) { if (wr == 1) PG8_BAR; }
    }
    PG8_WAIT_V(0);
    if constexpr (!ALIGN_EPI) { if (wr == 0) PG8_BAR; }
    PG8_BAR;
    if constexpr (Epi::AFTER_DRAIN) { E.fused(acc, cur, wr, wc, fr, fq, lds, wid, lane); S.done(cur); }
#undef PG8_SA
#undef PG8_SB
#undef PG8_STAGE
#undef PG8_LDA
#undef PG8_LDB
#undef PG8_MMA
#undef PG8_WAIT_V
#undef PG8_WAIT_L
#undef PG8_BAR
#undef PG8_SCHED
}
}

constexpr int DM = 1024, SEQL = 8192, NSEQ = 10, MTOK = NSEQ * SEQL, INW = 4096, DFF = 2816, DFF2 = 5632, NHEAD = 4;
constexpr int MPROMPT = 2 * SEQL;
constexpr float NORM_EPS = 1e-6f;
constexpr float LOG2E = 1.4426950408889634f;
typedef unsigned short bf16_t;
typedef short bf16x8 __attribute__((ext_vector_type(8)));
typedef short s16x4 __attribute__((ext_vector_type(4)));
typedef float f32x4 __attribute__((ext_vector_type(4)));
typedef float f32x16 __attribute__((ext_vector_type(16)));
typedef unsigned u32x4 __attribute__((ext_vector_type(4)));
typedef unsigned u32x2 __attribute__((ext_vector_type(2)));
typedef float f32x2 __attribute__((ext_vector_type(2)));
#define LAS __attribute__((address_space(3)))

constexpr size_t MiB = 1u << 20;
constexpr size_t WS_CTL = 0;
constexpr size_t WS_WIN = 1 * MiB;
constexpr size_t WS_WOUT = 9 * MiB;
constexpr size_t WS_WUP = 11 * MiB;
constexpr size_t WS_WDOWN = 22 * MiB;
constexpr size_t WS_XN = 32 * MiB;
constexpr size_t WS_PROJ = 192 * MiB;
constexpr size_t WS_OF = 832 * MiB;
constexpr size_t WS_OB = 912 * MiB;
constexpr size_t WS_U = 192 * MiB;
constexpr size_t WS_ACT = 192 * MiB;
constexpr size_t WS_END = 992 * MiB;
constexpr int NSLAB = 2, SLABROWS = MTOK / NSLAB;

constexpr int LDS_BYTES = 143360;
constexpr int LDS_MISC = 131072 + 8192;

__device__ __forceinline__ unsigned cvtpk(float lo, float hi) { unsigned r; asm("v_cvt_pk_bf16_f32 %0, %1, %2" : "=v"(r) : "v"(lo), "v"(hi)); return r; }
__device__ __forceinline__ float bf_lo(unsigned u) { return __uint_as_float(u << 16); }
__device__ __forceinline__ float bf_hi(unsigned u) { return __uint_as_float(u & 0xffff0000u); }
__device__ __forceinline__ float ex2(float x) { return __builtin_amdgcn_exp2f(x); }
__device__ __forceinline__ float lg2(float x) { return __builtin_amdgcn_logf(x); }
__device__ __forceinline__ float rcpf(float x) { return __builtin_amdgcn_rcpf(x); }
__device__ __forceinline__ float siluf(float x) { return x * rcpf(1.f + ex2(-x * LOG2E)); }
__device__ __forceinline__ float wave_sum(float v) {
#pragma unroll
    for (int o = 1; o < 64; o <<= 1) v += __shfl_xor(v, o);
    return v;
}
__device__ __forceinline__ const float* xrow_ptr(const float* xp, const float* xs, int row) {
    return row < MPROMPT ? xp + (size_t)row * DM : xs + (size_t)(row - MPROMPT) * DM;
}

struct EpiInProj {
    static constexpr bool PERM = true, AFTER_DRAIN = false;
    bf16_t* P; const float* lbf; const float* lbb; const float* qnw; const float* knw; PG8_LAS float* ex;
    __device__ __forceinline__ void operator()(const pg8::f32x4 (&acc)[2][2][4][2], const pg8::Unit& u, int wr, int wc, int fr, int fq) const {
        const int sec = u.pn >> 1;
        int row0 = u.pm * 256 + wr * 64 + fr, col0 = u.pn * 256 + wc * 32 + 8 * fq;
        asm volatile("" : "+v"(row0), "+v"(col0));
        if (sec < 2) {
            float ps[2][4][2];
#pragma unroll
            for (int ai = 0; ai < 2; ++ai)
#pragma unroll
                for (int m = 0; m < 4; ++m)
#pragma unroll
                    for (int bj = 0; bj < 2; ++bj) { float q = 0.f;
#pragma unroll
                        for (int n = 0; n < 2; ++n)
#pragma unroll
                            for (int e = 0; e < 4; ++e) q += acc[ai][bj][m][n][e] * acc[ai][bj][m][n][e];
                        q += __shfl_xor(q, 16); q += __shfl_xor(q, 32); ps[ai][m][bj] = q; }
            const int wid = wr * 4 + wc;
            if (fq == 0) {
#pragma unroll
                for (int ai = 0; ai < 2; ++ai)
#pragma unroll
                    for (int m = 0; m < 4; ++m)
#pragma unroll
                        for (int bj = 0; bj < 2; ++bj) ex[(wid * 16 + (ai * 8 + m * 2 + bj)) * 16 + fr] = ps[ai][m][bj];
            }
            asm volatile("s_waitcnt lgkmcnt(0)" ::: "memory"); __builtin_amdgcn_s_barrier();
            const float* nw = (sec == 0) ? qnw : knw; const float sc = (sec == 0) ? 0.125f * LOG2E : 1.f;
            float w8[8];
#pragma unroll
            for (int e = 0; e < 8; ++e) w8[e] = nw[32 * (wc & 1) + 8 * fq + e] * sc;
#pragma unroll
            for (int ai = 0; ai < 2; ++ai)
#pragma unroll
                for (int m = 0; m < 4; ++m) {
                    bf16_t* rowp = P + (size_t)(row0 + ai * 128 + m * 16) * INW + col0;
#pragma unroll
                    for (int bj = 0; bj < 2; ++bj) {
                        const float tot = ps[ai][m][bj] + ex[((wid ^ 1) * 16 + (ai * 8 + m * 2 + bj)) * 16 + fr];
                        const float rs = __builtin_amdgcn_rsqf(tot * (1.f / 64.f) + NORM_EPS);
                        const pg8::f32x4 v0 = acc[ai][bj][m][0], v1 = acc[ai][bj][m][1];
                        u32x4 w; w.x = cvtpk(v0[0] * rs * w8[0], v0[1] * rs * w8[1]); w.y = cvtpk(v0[2] * rs * w8[2], v0[3] * rs * w8[3]);
                        w.z = cvtpk(v1[0] * rs * w8[4], v1[1] * rs * w8[5]); w.w = cvtpk(v1[2] * rs * w8[6], v1[3] * rs * w8[7]);
                        __builtin_nontemporal_store(w, (u32x4*)(rowp + bj * 128));
                    }
                }
            return;
        }
        float lbv[2][8];
        if (sec == 4 || sec == 5) {
            const float* t = (sec == 4) ? lbf : lbb; const int cs = col0 - sec * 512;
#pragma unroll
            for (int bj = 0; bj < 2; ++bj)
#pragma unroll
                for (int e = 0; e < 8; ++e) { const int c = cs + bj * 128 + e; lbv[bj][e] = rcpf(1.f + ex2((t[512 + c] - t[c]) * LOG2E)); }
        }
#pragma unroll
        for (int ai = 0; ai < 2; ++ai)
#pragma unroll
            for (int m = 0; m < 4; ++m) {
                bf16_t* rowp = P + (size_t)(row0 + ai * 128 + m * 16) * INW + col0;
#pragma unroll
                for (int bj = 0; bj < 2; ++bj) {
                    float v[8];
#pragma unroll
                    for (int e = 0; e < 4; ++e) { v[e] = acc[ai][bj][m][0][e]; v[4 + e] = acc[ai][bj][m][1][e]; }
                    if (sec == 3 || sec == 7) {
#pragma unroll
                        for (int e = 0; e < 8; ++e) v[e] = siluf(v[e]);
                    } else if (sec == 4 || sec == 5) {
#pragma unroll
                        for (int e = 0; e < 8; ++e) { const float sg = rcpf(1.f + ex2(-v[e] * LOG2E)); const float lb = lbv[bj][e]; v[e] = lg2(lb + (1.f - lb) * sg); }
                    }
                    u32x4 w; w.x = cvtpk(v[0], v[1]); w.y = cvtpk(v[2], v[3]); w.z = cvtpk(v[4], v[5]); w.w = cvtpk(v[6], v[7]);
                    __builtin_nontemporal_store(w, (u32x4*)(rowp + bj * 128));
                }
            }
    }
};
struct EpiBf16Plain {
    static constexpr bool PERM = true, AFTER_DRAIN = false;
    bf16_t* O; int ldc;
    __device__ __forceinline__ void operator()(const pg8::f32x4 (&acc)[2][2][4][2], const pg8::Unit& u, int wr, int wc, int fr, int fq) const {
        int row0 = u.pm * 256 + wr * 64 + fr, col0 = u.pn * 256 + wc * 32 + 8 * fq;
        asm volatile("" : "+v"(row0), "+v"(col0));
#pragma unroll
        for (int ai = 0; ai < 2; ++ai)
#pragma unroll
            for (int m = 0; m < 4; ++m) {
                bf16_t* rowp = O + (size_t)(row0 + ai * 128 + m * 16) * ldc + col0;
#pragma unroll
                for (int bj = 0; bj < 2; ++bj) {
                    const pg8::f32x4 v0 = acc[ai][bj][m][0], v1 = acc[ai][bj][m][1];
                    u32x4 w; w.x = cvtpk(v0[0], v0[1]); w.y = cvtpk(v0[2], v0[3]); w.z = cvtpk(v1[0], v1[1]); w.w = cvtpk(v1[2], v1[3]);
                    *(u32x4*)(rowp + bj * 128) = w;
                }
            }
    }
};
struct EpiResid {
    static constexpr bool PERM = true, AFTER_DRAIN = false;
    const float* xp; const float* xs; float* out; int row_off; int self;
    __device__ __forceinline__ void operator()(const pg8::f32x4 (&acc)[2][2][4][2], const pg8::Unit& u, int wr, int wc, int fr, int fq) const {
        const int rowt = row_off + u.pm * 256;
        const float* rb = self ? (const float*)out + (size_t)rowt * DM : xrow_ptr(xp, xs, rowt);
        float* ob = out + (size_t)rowt * DM;
        int r0 = wr * 64 + fr, col0 = u.pn * 256 + wc * 32 + 8 * fq;
        asm volatile("" : "+v"(r0), "+v"(col0));
#pragma unroll
        for (int ai = 0; ai < 2; ++ai)
#pragma unroll
            for (int m = 0; m < 4; ++m) {
                const size_t ro = (size_t)(r0 + ai * 128 + m * 16) * DM + col0;
#pragma unroll
                for (int bj = 0; bj < 2; ++bj)
#pragma unroll
                    for (int n = 0; n < 2; ++n) {
                        const f32x4 r = *(const f32x4*)(rb + ro + bj * 128 + 4 * n);
                        const pg8::f32x4 a = acc[ai][bj][m][n];
                        f32x4 o; o[0] = r[0] + a[0]; o[1] = r[1] + a[1]; o[2] = r[2] + a[2]; o[3] = r[3] + a[3];
                        *(f32x4*)(ob + ro + bj * 128 + 4 * n) = o;
                    }
            }
    }
};

struct EpiResidB {
    static constexpr bool PERM = true, AFTER_DRAIN = false;
    const float* xp; const float* xs; bf16_t* X1B;
    __device__ __forceinline__ void operator()(const pg8::f32x4 (&acc)[2][2][4][2], const pg8::Unit& u, int wr, int wc, int fr, int fq) const {
        const int rowt = u.pm * 256;
        const float* rb = xrow_ptr(xp, xs, rowt);
        bf16_t* ob = X1B + (size_t)rowt * DM;
        int r0 = wr * 64 + fr, col0 = u.pn * 256 + wc * 32 + 8 * fq;
        asm volatile("" : "+v"(r0), "+v"(col0));
#pragma unroll
        for (int ai = 0; ai < 2; ++ai)
#pragma unroll
            for (int m = 0; m < 4; ++m) {
                const size_t ro = (size_t)(r0 + ai * 128 + m * 16) * DM + col0;
#pragma unroll
                for (int bj = 0; bj < 2; ++bj) {
                    const f32x4 ra = *(const f32x4*)(rb + ro + bj * 128), rc = *(const f32x4*)(rb + ro + bj * 128 + 4);
                    const pg8::f32x4 a = acc[ai][bj][m][0], c = acc[ai][bj][m][1];
                    u32x4 w; w.x = cvtpk(ra[0] + a[0], ra[1] + a[1]); w.y = cvtpk(ra[2] + a[2], ra[3] + a[3]); w.z = cvtpk(rc[0] + c[0], rc[1] + c[1]); w.w = cvtpk(rc[2] + c[2], rc[3] + c[3]);
                    *(u32x4*)(ob + ro + bj * 128) = w;
                }
            }
    }
};
struct EpiFinal {
    static constexpr bool PERM = true, AFTER_DRAIN = false;
    const bf16_t* X1B; float* out;
    __device__ __forceinline__ void operator()(const pg8::f32x4 (&acc)[2][2][4][2], const pg8::Unit& u, int wr, int wc, int fr, int fq) const {
        const int rowt = u.pm * 256;
        const bf16_t* rb = X1B + (size_t)rowt * DM;
        float* ob = out + (size_t)rowt * DM;
        int r0 = wr * 64 + fr, col0 = u.pn * 256 + wc * 32 + 8 * fq;
        asm volatile("" : "+v"(r0), "+v"(col0));
#pragma unroll
        for (int ai = 0; ai < 2; ++ai)
#pragma unroll
            for (int m = 0; m < 4; ++m) {
                const size_t ro = (size_t)(r0 + ai * 128 + m * 16) * DM + col0;
#pragma unroll
                for (int bj = 0; bj < 2; ++bj) {
                    const u32x4 r = *(const u32x4*)(rb + ro + bj * 128);
                    const pg8::f32x4 a = acc[ai][bj][m][0], c = acc[ai][bj][m][1];
                    f32x4 o0, o1;
                    o0[0] = bf_lo(r.x) + a[0]; o0[1] = bf_hi(r.x) + a[1]; o0[2] = bf_lo(r.y) + a[2]; o0[3] = bf_hi(r.y) + a[3];
                    o1[0] = bf_lo(r.z) + c[0]; o1[1] = bf_hi(r.z) + c[1]; o1[2] = bf_lo(r.w) + c[2]; o1[3] = bf_hi(r.w) + c[3];
                    *(f32x4*)(ob + ro + bj * 128) = o0; *(f32x4*)(ob + ro + bj * 128 + 4) = o1;
                }
            }
    }
};

#define DPP_SHR1 0x111
#define DPP_SHL1 0x101
#define DPP_ROR1 0x121
#define DPP_ROR15 0x12F
__device__ __forceinline__ float dppf(float old, float src, const int ctrl_sel) {
    int r;
    if (ctrl_sel == 0) r = __builtin_amdgcn_update_dpp(__float_as_int(old), __float_as_int(src), DPP_SHR1, 0xf, 0xf, false);
    else if (ctrl_sel == 1) r = __builtin_amdgcn_update_dpp(__float_as_int(old), __float_as_int(src), DPP_SHL1, 0xf, 0xf, false);
    else if (ctrl_sel == 2) r = __builtin_amdgcn_update_dpp(__float_as_int(old), __float_as_int(src), DPP_ROR1, 0xf, 0xf, false);
    else r = __builtin_amdgcn_update_dpp(__float_as_int(old), __float_as_int(src), DPP_ROR15, 0xf, 0xf, false);
    return __int_as_float(r);
}
struct EpiConvAct {
    static constexpr bool PERM = true, AFTER_DRAIN = false;
    bf16_t* ACT; const float* cw; const float* cb; PG8_LAS float* ex;
    __device__ __forceinline__ void operator()(const pg8::f32x4 (&acc)[2][2][4][2], const pg8::Unit& u, int wr, int wc, int fr, int fq) const {
        int seq = u.pm / 33, pt = u.pm % 33;
        asm volatile("" : "+s"(seq), "+s"(pt));
        const int t0 = 254 * pt - 1;
        int cl = wc * 32 + 8 * fq;
        asm volatile("" : "+v"(cl));
#pragma unroll
        for (int ai = 0; ai < 2; ++ai) { const int g = ai * 2 + wr;
            if (fr == 0) {
#pragma unroll
                for (int bj = 0; bj < 2; ++bj)
#pragma unroll
                    for (int n = 0; n < 2; ++n) *(PG8_LAS pg8::f32x4*)(ex + ((g * 2 + 0) * 2 + bj) * 128 + cl + 4 * n) = acc[ai][bj][0][n]; }
            if (fr == 15) {
#pragma unroll
                for (int bj = 0; bj < 2; ++bj)
#pragma unroll
                    for (int n = 0; n < 2; ++n) *(PG8_LAS pg8::f32x4*)(ex + ((g * 2 + 1) * 2 + bj) * 128 + cl + 4 * n) = acc[ai][bj][3][n]; }
        }
        asm volatile("s_waitcnt lgkmcnt(0)" ::: "memory"); __builtin_amdgcn_s_barrier();
        const int chb = u.pn * 128 + cl;
#pragma unroll
        for (int n = 0; n < 2; ++n) {
            const int ch = chb + 4 * n;
            const f32x4 bg = *(const f32x4*)(cb + ch), bu = *(const f32x4*)(cb + DFF + ch);
            const f32x4 g0 = *(const f32x4*)(cw + ch), g1 = *(const f32x4*)(cw + DFF2 + ch), g2 = *(const f32x4*)(cw + 2 * DFF2 + ch);
            const f32x4 u0 = *(const f32x4*)(cw + DFF + ch), u1 = *(const f32x4*)(cw + DFF2 + DFF + ch), u2 = *(const f32x4*)(cw + 2 * DFF2 + DFF + ch);
#pragma unroll
            for (int ai = 0; ai < 2; ++ai) { const int g = ai * 2 + wr;
#pragma unroll
                for (int m = 0; m < 4; ++m) {
                    const int row = 64 * g + 4 * fr + m, t = t0 + row;
                    pg8::f32x4 pb[2], nb[2];
                    if (m == 0) {
#pragma unroll
                        for (int bj = 0; bj < 2; ++bj) pb[bj] = *(const PG8_LAS pg8::f32x4*)(ex + ((((g + 3) & 3) * 2 + 1) * 2 + bj) * 128 + cl + 4 * n);
                    }
                    if (m == 3) {
#pragma unroll
                        for (int bj = 0; bj < 2; ++bj) nb[bj] = *(const PG8_LAS pg8::f32x4*)(ex + ((((g + 1) & 3) * 2 + 0) * 2 + bj) * 128 + cl + 4 * n);
                    }
                    const bool keep = (row >= 1) && (row <= 254) && (t < SEQL);
                    float o4[4];
#pragma unroll
                    for (int e = 0; e < 4; ++e) {
                        float cv[2];
#pragma unroll
                        for (int bj = 0; bj < 2; ++bj) {
                            const float X = acc[ai][bj][m][n][e];
                            float pv = (m > 0) ? acc[ai][bj][m > 0 ? m - 1 : 0][n][e] : dppf(pb[bj][e], acc[ai][bj][3][n][e], 0);
                            float nv = (m < 3) ? acc[ai][bj][m < 3 ? m + 1 : 3][n][e] : dppf(nb[bj][e], acc[ai][bj][0][n][e], 1);
                            pv = (t == 0) ? 0.f : pv; nv = (t == SEQL - 1) ? 0.f : nv;
                            cv[bj] = bj == 0 ? bg[e] + g0[e] * pv + g1[e] * X + g2[e] * nv : bu[e] + u0[e] * pv + u1[e] * X + u2[e] * nv;
                        }
                        o4[e] = siluf(cv[0]) * cv[1];
                    }
                    if (keep) { u32x2 w; w.x = cvtpk(o4[0], o4[1]); w.y = cvtpk(o4[2], o4[3]); *(u32x2*)(ACT + ((size_t)seq * SEQL + t) * DFF + ch) = w; }
                }
            }
        }
    }
};

__device__ __forceinline__ void p0_transpose_item(const float* W, int K, int N, bf16_t* WT, LAS float* scr, int item, int lane, bool perm_up = false) {
    const int nblk = N / 32, kb = item / nblk, nb = item % nblk, k0 = 64 * kb, n0 = 32 * nb;
#pragma unroll 8
    for (int i = 0; i < 32; ++i) { const int kk = 2 * i + (lane >> 5); scr[kk * 33 + (lane & 31)] = W[(size_t)(k0 + kk) * N + n0 + (lane & 31)]; }
    asm volatile("s_waitcnt lgkmcnt(0)" ::: "memory");
    const int c = lane & 7;
#pragma unroll
    for (int j = 0; j < 4; ++j) { const int n = (lane >> 3) + 8 * j; const LAS float* s = scr + (8 * c) * 33 + n;
        u32x4 o; o.x = cvtpk(s[0 * 33], s[1 * 33]); o.y = cvtpk(s[2 * 33], s[3 * 33]); o.z = cvtpk(s[4 * 33], s[5 * 33]); o.w = cvtpk(s[6 * 33], s[7 * 33]);
        int nd = n0 + n; if (perm_up) { const int hf = nd / DFF, rr = nd - hf * DFF; nd = (rr >> 7) * 256 + hf * 128 + (rr & 127); }
        *(u32x4*)(WT + (size_t)nd * K + k0 + 8 * c) = o; }
    asm volatile("s_waitcnt lgkmcnt(0)" ::: "memory");
}
__device__ __forceinline__ void rms_row2_to_bf16(const float* xrow0, const float* xrow1, const float* w, bf16_t* orow0, bf16_t* orow1, int lane) {
    const f32x4* xr0 = (const f32x4*)xrow0 + lane; const f32x4* xr1 = (const f32x4*)xrow1 + lane; const f32x4* wr = (const f32x4*)w + lane;
    f32x4 v0[4], v1[4]; float s0 = 0.f, s1 = 0.f;
#pragma unroll
    for (int j = 0; j < 4; ++j) { v0[j] = xr0[64 * j]; v1[j] = xr1[64 * j]; }
#pragma unroll
    for (int j = 0; j < 4; ++j) { s0 += (v0[j][0] * v0[j][0] + v0[j][1] * v0[j][1]) + (v0[j][2] * v0[j][2] + v0[j][3] * v0[j][3]); s1 += (v1[j][0] * v1[j][0] + v1[j][1] * v1[j][1]) + (v1[j][2] * v1[j][2] + v1[j][3] * v1[j][3]); }
    const float r0 = __builtin_amdgcn_rsqf(wave_sum(s0) * (1.f / DM) + NORM_EPS), r1 = __builtin_amdgcn_rsqf(wave_sum(s1) * (1.f / DM) + NORM_EPS);
    u32x2* o0 = (u32x2*)orow0 + lane; u32x2* o1 = (u32x2*)orow1 + lane;
#pragma unroll
    for (int j = 0; j < 4; ++j) { const f32x4 ww = wr[64 * j]; u32x2 o;
        o.x = cvtpk(v0[j][0] * r0 * ww[0], v0[j][1] * r0 * ww[1]); o.y = cvtpk(v0[j][2] * r0 * ww[2], v0[j][3] * r0 * ww[3]); o0[64 * j] = o;
        o.x = cvtpk(v1[j][0] * r1 * ww[0], v1[j][1] * r1 * ww[1]); o.y = cvtpk(v1[j][2] * r1 * ww[2], v1[j][3] * r1 * ww[3]); o1[64 * j] = o; }
}
__device__ __forceinline__ void rms_rowb2_to_bf16(const bf16_t* xrow0, const bf16_t* xrow1, const float* w, bf16_t* orow0, bf16_t* orow1, int lane) {
    const u32x4 a0 = *((const u32x4*)xrow0 + lane), a1 = *((const u32x4*)xrow0 + 64 + lane), b0 = *((const u32x4*)xrow1 + lane), b1 = *((const u32x4*)xrow1 + 64 + lane);
    float va[16], vb[16]; float s0 = 0.f, s1 = 0.f;
#pragma unroll
    for (int e = 0; e < 4; ++e) { va[2 * e] = bf_lo(a0[e]); va[2 * e + 1] = bf_hi(a0[e]); va[8 + 2 * e] = bf_lo(a1[e]); va[8 + 2 * e + 1] = bf_hi(a1[e]);
        vb[2 * e] = bf_lo(b0[e]); vb[2 * e + 1] = bf_hi(b0[e]); vb[8 + 2 * e] = bf_lo(b1[e]); vb[8 + 2 * e + 1] = bf_hi(b1[e]); }
#pragma unroll
    for (int e = 0; e < 16; ++e) { s0 += va[e] * va[e]; s1 += vb[e] * vb[e]; }
    const float r0 = __builtin_amdgcn_rsqf(wave_sum(s0) * (1.f / DM) + NORM_EPS), r1 = __builtin_amdgcn_rsqf(wave_sum(s1) * (1.f / DM) + NORM_EPS);
    const f32x4 w0 = *((const f32x4*)w + 2 * lane), w1 = *((const f32x4*)w + 2 * lane + 1), w2 = *((const f32x4*)w + 128 + 2 * lane), w3 = *((const f32x4*)w + 128 + 2 * lane + 1);
    u32x4 o;
    o.x = cvtpk(va[0] * r0 * w0[0], va[1] * r0 * w0[1]); o.y = cvtpk(va[2] * r0 * w0[2], va[3] * r0 * w0[3]); o.z = cvtpk(va[4] * r0 * w1[0], va[5] * r0 * w1[1]); o.w = cvtpk(va[6] * r0 * w1[2], va[7] * r0 * w1[3]);
    *((u32x4*)orow0 + lane) = o;
    o.x = cvtpk(va[8] * r0 * w2[0], va[9] * r0 * w2[1]); o.y = cvtpk(va[10] * r0 * w2[2], va[11] * r0 * w2[3]); o.z = cvtpk(va[12] * r0 * w3[0], va[13] * r0 * w3[1]); o.w = cvtpk(va[14] * r0 * w3[2], va[15] * r0 * w3[3]);
    *((u32x4*)orow0 + 64 + lane) = o;
    o.x = cvtpk(vb[0] * r1 * w0[0], vb[1] * r1 * w0[1]); o.y = cvtpk(vb[2] * r1 * w0[2], vb[3] * r1 * w0[3]); o.z = cvtpk(vb[4] * r1 * w1[0], vb[5] * r1 * w1[1]); o.w = cvtpk(vb[6] * r1 * w1[2], vb[7] * r1 * w1[3]);
    *((u32x4*)orow1 + lane) = o;
    o.x = cvtpk(vb[8] * r1 * w2[0], vb[9] * r1 * w2[1]); o.y = cvtpk(vb[10] * r1 * w2[2], vb[11] * r1 * w2[3]); o.z = cvtpk(vb[12] * r1 * w3[0], vb[13] * r1 * w3[1]); o.w = cvtpk(vb[14] * r1 * w3[2], vb[15] * r1 * w3[3]);
    *((u32x4*)orow1 + 64 + lane) = o;
}

namespace att {
constexpr int KVBLK = 64, LDK = INW;
constexpr int SHM_V = KVBLK * 128 * 2, SHM_K = KVBLK * 128 * 2;
constexpr float THR2 = 11.5f;
#ifndef ATT_SDEPTH
#define ATT_SDEPTH 2
#endif
constexpr int SDEPTH = ATT_SDEPTH;
#define KSWZ(row, colB) ((row) * 256 + ((colB) ^ (((row) & 7) << 4)))
#define SBAR() __builtin_amdgcn_sched_barrier(0)
__device__ __forceinline__ int crow(int r, int hi) { return (r & 3) + 8 * (r >> 2) + 4 * hi; }
__device__ __forceinline__ unsigned cvtpkv(float lo, float hi) { unsigned r; asm volatile("v_cvt_pk_bf16_f32 %0, %1, %2" : "=v"(r) : "v"(lo), "v"(hi)); return r; }

__device__ __forceinline__ void partialSM(f32x16& p0, f32x16& p1, float dq, float c2) {
#pragma unroll
  for (int r = 0; r < 16; ++r) { p0[r] = fmaf(-c2, fabsf(dq - (float)((r & 3) + 8 * (r >> 2))), p0[r]); p1[r] = fmaf(-c2, fabsf(dq - (float)(32 + (r & 3) + 8 * (r >> 2))), p1[r]); }
#pragma unroll
  for (int r = 0; r < 16; ++r) p0[r] = __builtin_amdgcn_exp2f(p0[r]);
}
__device__ __forceinline__ void finishSM(f32x16& p0, f32x16& p1, float& l_reg, bf16x8& pa0, bf16x8& pa1, bf16x8& pa2, bf16x8& pa3) {
#pragma unroll
  for (int r = 0; r < 16; ++r) p1[r] = __builtin_amdgcn_exp2f(p1[r]);
  float ps = 0;
#pragma unroll
  for (int r = 0; r < 16; ++r) ps += p0[r];
#pragma unroll
  for (int r = 0; r < 16; ++r) ps += p1[r];
  { auto rr = __builtin_amdgcn_permlane32_swap(__float_as_uint(ps), __float_as_uint(ps), false, false);
    ps = __uint_as_float(rr[0]) + __uint_as_float(rr[1]); }
  l_reg += ps;
#define PK4(P, BASE, OUT) do { unsigned a0 = cvtpkv(P[BASE + 0], P[BASE + 1]), a1 = cvtpkv(P[BASE + 2], P[BASE + 3]);   \
    unsigned b0 = cvtpkv(P[BASE + 4], P[BASE + 5]), b1 = cvtpkv(P[BASE + 6], P[BASE + 7]);                              \
    auto r0 = __builtin_amdgcn_permlane32_swap(a0, b0, false, false); auto r1 = __builtin_amdgcn_permlane32_swap(a1, b1, false, false); \
    u32x4 w = {r0[0], r1[0], r0[1], r1[1]}; OUT = *reinterpret_cast<bf16x8*>(&w); } while (0)
  PK4(p0, 0, pa0); PK4(p0, 8, pa1); PK4(p1, 0, pa2); PK4(p1, 8, pa3);
#undef PK4
}
__device__ __forceinline__ void qkt(f32x16& p0, f32x16& p1, const char* Ks, const bf16x8* qr, int r32, int hi, int map) {
  p0 = f32x16{}; p1 = f32x16{};
#pragma unroll
  for (int d0 = 0; d0 < 4; ++d0) { const int cb = (map * 64 + d0 * 16 + hi * 8) * 2;
    bf16x8 b0 = *reinterpret_cast<const bf16x8*>(Ks + KSWZ(r32, cb));
    bf16x8 b1 = *reinterpret_cast<const bf16x8*>(Ks + KSWZ(32 + r32, cb));
    p0 = __builtin_amdgcn_mfma_f32_32x32x16_bf16(b0, qr[d0], p0, 0, 0, 0);
    p1 = __builtin_amdgcn_mfma_f32_32x32x16_bf16(b1, qr[d0], p1, 0, 0, 0); }
}
__device__ __forceinline__ int v_st(int k, int c) { const int kk = (k & ~0xC) | ((k & 4) << 1) | ((k & 8) >> 1); return ((kk >> 3) * 4 + (c >> 5)) * 512 + ((kk & 7) * 32 + (c & 31)) * 2; }
__device__ __forceinline__ int v_rd_base(int lane) { return ((lane & 3) << 3) | (((lane >> 2) & 3) << 6) | (((lane >> 4) & 1) << 5) | (((lane >> 5) & 1) << 8); }
constexpr int v_rd_off(int d0, int ks, int half) { return d0 * 512 + ks * 4096 + half * 2048; }
template <int OFF> __device__ __forceinline__ s16x4 tr_read(int vb) {
  s16x4 r; asm volatile("ds_read_b64_tr_b16 %0, %1 offset:%2" : "=&v"(r) : "v"(vb), "i"(OFF) : "memory"); return r;
}
template <int D0> __device__ __forceinline__ void pv_one(f32x16& od, int vb, bf16x8 pa0, bf16x8 pa1, bf16x8 pa2, bf16x8 pa3) {
#define PK(L, H) (bf16x8){L[0], L[1], L[2], L[3], H[0], H[1], H[2], H[3]}
  { const s16x4 l0 = tr_read<v_rd_off(D0, 0, 0)>(vb), h0 = tr_read<v_rd_off(D0, 0, 1)>(vb), l1 = tr_read<v_rd_off(D0, 1, 0)>(vb), h1 = tr_read<v_rd_off(D0, 1, 1)>(vb);
    asm volatile("s_waitcnt lgkmcnt(0)" ::: "memory"); SBAR();
    od = __builtin_amdgcn_mfma_f32_32x32x16_bf16(pa0, PK(l0, h0), od, 0, 0, 0);
    od = __builtin_amdgcn_mfma_f32_32x32x16_bf16(pa1, PK(l1, h1), od, 0, 0, 0); }
  { const s16x4 l2 = tr_read<v_rd_off(D0, 2, 0)>(vb), h2 = tr_read<v_rd_off(D0, 2, 1)>(vb), l3 = tr_read<v_rd_off(D0, 3, 0)>(vb), h3 = tr_read<v_rd_off(D0, 3, 1)>(vb);
    asm volatile("s_waitcnt lgkmcnt(0)" ::: "memory"); SBAR();
    od = __builtin_amdgcn_mfma_f32_32x32x16_bf16(pa2, PK(l2, h2), od, 0, 0, 0);
    od = __builtin_amdgcn_mfma_f32_32x32x16_bf16(pa3, PK(l3, h3), od, 0, 0, 0); }
#undef PK
}
__device__ __forceinline__ void pv_d0(f32x16* o, int vb, bf16x8 pa0, bf16x8 pa1, bf16x8 pa2, bf16x8 pa3) {
  pv_one<0>(o[0], vb, pa0, pa1, pa2, pa3); pv_one<1>(o[1], vb, pa0, pa1, pa2, pa3); pv_one<2>(o[2], vb, pa0, pa1, pa2, pa3); pv_one<3>(o[3], vb, pa0, pa1, pa2, pa3);
}

#define SM_CHUNK(c) do { _Pragma("unroll") for (int r = 2 * (c); r < 2 * (c) + 2; ++r) { \
    p0[r] = __builtin_amdgcn_exp2f(fmaf(-c2, fabsf(dq - (float)((r & 3) + 8 * (r >> 2))), p0[r])); p1[r] = fmaf(-c2, fabsf(dq - (float)(32 + (r & 3) + 8 * (r >> 2))), p1[r]); } } while (0)
#define RD4(X, D0, HF) do { X##0 = tr_read<v_rd_off(D0, 2 * (HF), 0)>(vb); X##1 = tr_read<v_rd_off(D0, 2 * (HF), 1)>(vb); X##2 = tr_read<v_rd_off(D0, 2 * (HF) + 1, 0)>(vb); X##3 = tr_read<v_rd_off(D0, 2 * (HF) + 1, 1)>(vb); } while (0)
#define PKV(L, H) (bf16x8){L[0], L[1], L[2], L[3], H[0], H[1], H[2], H[3]}
#define MM2(OD, X, PA, PB) do { OD = __builtin_amdgcn_mfma_f32_32x32x16_bf16(PA, PKV(X##0, X##1), OD, 0, 0, 0); OD = __builtin_amdgcn_mfma_f32_32x32x16_bf16(PB, PKV(X##2, X##3), OD, 0, 0, 0); } while (0)
#define WL4() asm volatile("s_waitcnt lgkmcnt(4)" ::: "memory")
__device__ __forceinline__ void pv_sm(f32x16* o, int vb, bf16x8 pa0, bf16x8 pa1, bf16x8 pa2, bf16x8 pa3, f32x16& p0, f32x16& p1, float dq, float c2) {
  s16x4 A0, A1, A2, A3, B0, B1, B2, B3;
  RD4(A, 0, 0);
  RD4(B, 1, 0); WL4(); SBAR(); MM2(o[0], A, pa0, pa1); SM_CHUNK(0); SBAR();
  RD4(A, 2, 0); WL4(); SBAR(); MM2(o[1], B, pa0, pa1); SM_CHUNK(1); SBAR();
  RD4(B, 3, 0); WL4(); SBAR(); MM2(o[2], A, pa0, pa1); SM_CHUNK(2); SBAR();
  RD4(A, 0, 1); WL4(); SBAR(); MM2(o[3], B, pa0, pa1); SM_CHUNK(3); SBAR();
  RD4(B, 1, 1); WL4(); SBAR(); MM2(o[0], A, pa2, pa3); SM_CHUNK(4); SBAR();
  RD4(A, 2, 1); WL4(); SBAR(); MM2(o[1], B, pa2, pa3); SM_CHUNK(5); SBAR();
  RD4(B, 3, 1); WL4(); SBAR(); MM2(o[2], A, pa2, pa3); SM_CHUNK(6); SBAR();
  asm volatile("s_waitcnt lgkmcnt(0)" ::: "memory"); SBAR(); MM2(o[3], B, pa2, pa3); SM_CHUNK(7); SBAR();
}
#undef SM_CHUNK
#undef RD4
#undef MM2
#undef WL4
#undef PKV

__device__ __forceinline__ void attn_unit(const bf16_t* __restrict__ P, bf16_t* __restrict__ MIX, const float* __restrict__ onw, float lam, int bh, int qb, int W, char* lds) {
  const int tid = threadIdx.x, wid = tid >> 6, lane = tid & 63, r32 = lane & 31, hi = lane >> 5;
  const int qg = wid & 3, map = wid >> 2, b = bh >> 2, h = bh & 3;
  const size_t tok0 = (size_t)b * SEQL; const int q0 = qb * 128;
  char* K_lds = lds; char* V_lds = lds + 3 * SHM_K;
  float* ws = (float*)(lds + 3 * SHM_V + 3 * SHM_K) + wid * 64; float* li_l = ws; float* al_l = ws + 32;
  const float c2 = LOG2E * (h == 0 ? 0.25f : h == 1 ? 0.0625f : h == 2 ? 0.015625f : 0.00390625f);
  const int qpos = q0 + qg * 32 + r32;
  float l_reg = 0; f32x16 o[4] = {}; bf16x8 qr[4];
  const int qbase = __builtin_amdgcn_readfirstlane(q0 + qg * 32);
  const bf16_t* Qw = P + (tok0 + qpos) * INW + h * 128 + map * 64 + hi * 8;
#pragma unroll
  for (int d0 = 0; d0 < 4; ++d0) qr[d0] = *reinterpret_cast<const bf16x8*>(Qw + d0 * 16);
  const bf16_t* Kh = P + tok0 * INW + 512 + h * 128; const bf16_t* Vh = P + tok0 * INW + 1024 + h * 128;
  const int sr = tid >> 4, sc = (tid & 15) * 8, vst0 = v_st(sr, sc), vst1 = v_st(32 + sr, sc);
  const int vb0 = (int)(uintptr_t)V_lds + v_rd_base(lane);
  struct { bf16x8 vs0, vs1, ks0, ks1; } sr_;
#define SLOAD(k0) do { sr_.vs0 = *(const bf16x8*)(&Vh[(size_t)((k0) + sr) * LDK + sc]); sr_.vs1 = *(const bf16x8*)(&Vh[(size_t)((k0) + 32 + sr) * LDK + sc]); \
    sr_.ks0 = *(const bf16x8*)(&Kh[(size_t)((k0) + sr) * LDK + sc]); sr_.ks1 = *(const bf16x8*)(&Kh[(size_t)((k0) + 32 + sr) * LDK + sc]); } while (0)
#define SWRITE(slot) do { *(bf16x8*)(V_lds + (slot) * SHM_V + vst0) = sr_.vs0;          \
    *(bf16x8*)(V_lds + (slot) * SHM_V + vst1) = sr_.vs1; const int kc = sc * 2;               \
    *(bf16x8*)(K_lds + (slot) * SHM_K + KSWZ(sr, kc)) = sr_.ks0;                       \
    *(bf16x8*)(K_lds + (slot) * SHM_K + KSWZ(32 + sr, kc)) = sr_.ks1; } while (0)
#define DQ(j) ((float)(qpos - (j) * KVBLK - 4 * hi))
  f32x16 pA0, pA1, pB0, pB1; bf16x8 pa0, pa1, pa2, pa3;
  int jlo = (q0 - W) / KVBLK; if (q0 - W < 0) jlo = 0;
  int jhi = (q0 + 127 + W) / KVBLK + 1; if (jhi > SEQL / KVBLK) jhi = SEQL / KVBLK;
  if ((jhi - jlo) & 1) { if (jhi < SEQL / KVBLK) ++jhi; else --jlo; }
  const int NT = jhi - jlo;
#define TK(i) ((jlo + (i)) * KVBLK)
  if (map == 1) __builtin_amdgcn_s_setprio(1);
  SLOAD(TK(0)); asm volatile("s_waitcnt vmcnt(0)" ::: "memory"); SWRITE(0);
  SLOAD(TK(1)); asm volatile("s_waitcnt vmcnt(0)" ::: "memory"); SWRITE(1);
  if (2 < NT) SLOAD(TK(2));
  __syncthreads();
  qkt(pA0, pA1, K_lds, qr, r32, hi, map); partialSM(pA0, pA1, DQ(jlo), c2);
  int sk = 1, sv = 0, sw = 2;
#define STEP(pC0, pC1, pP0, pP1, ii, more) do { \
    SBAR(); qkt(pC0, pC1, K_lds + sk * SHM_K, qr, r32, hi, map); \
    finishSM(pP0, pP1, l_reg, pa0, pa1, pa2, pa3); SBAR(); \
    asm volatile("s_waitcnt vmcnt(0)" ::: "memory"); SWRITE(sw); if (more) SLOAD(TK((ii) + 2)); SBAR(); \
    pv_sm(o, vb0 + sv * SHM_V, pa0, pa1, pa2, pa3, pC0, pC1, DQ(jlo + (ii)), c2); \
    __syncthreads(); \
    sv = sk; sk = sw; sw = (sw == 2) ? 0 : sw + 1; } while (0)
  for (int i = 1; i + 1 < NT; i += 2) {
    STEP(pB0, pB1, pA0, pA1, i, true);
    STEP(pA0, pA1, pB0, pB1, i + 1, (i + 3 < NT));
  }
  SBAR(); qkt(pB0, pB1, K_lds + sk * SHM_K, qr, r32, hi, map);
  finishSM(pA0, pA1, l_reg, pa0, pa1, pa2, pa3); SBAR();
  pv_sm(o, vb0 + sv * SHM_V, pa0, pa1, pa2, pa3, pB0, pB1, DQ(jlo + NT - 1), c2);
  finishSM(pB0, pB1, l_reg, pa0, pa1, pa2, pa3); SBAR();
  pv_d0(o, vb0 + sk * SHM_V, pa0, pa1, pa2, pa3);
#undef STEP
#undef TK
  __builtin_amdgcn_s_setprio(0);
  if (hi == 0) li_l[r32] = l_reg; asm volatile("s_waitcnt lgkmcnt(0)" ::: "memory");
  float rli[16];
#pragma unroll
  for (int r = 0; r < 16; ++r) rli[r] = __builtin_amdgcn_rcpf(li_l[crow(r, hi)]);
  __syncthreads();
  float* X = (float*)lds + qg * 4096;
  if (map == 1) {
#pragma unroll
    for (int r = 0; r < 16; ++r) { const float s = rli[r] * lam;
#pragma unroll
      for (int d0 = 0; d0 < 4; ++d0) X[crow(r, hi) * 128 + d0 * 32 + r32] = o[d0][r] * s; }
  }
  __syncthreads();
  if (map == 0) {
#pragma unroll
    for (int r = 0; r < 16; ++r) { float ss = 0.f;
#pragma unroll
      for (int d0 = 0; d0 < 4; ++d0) { const int ix = crow(r, hi) * 128 + d0 * 32 + r32; const float v = o[d0][r] * rli[r] - X[ix]; X[ix] = v; ss += v * v; }
#pragma unroll
      for (int of = 1; of < 32; of <<= 1) ss += __shfl_xor(ss, of);
      if (r32 == 0) al_l[crow(r, hi)] = __builtin_amdgcn_rsqf(ss * (1.f / 128.f) + NORM_EPS) * 0.8f;
    }
    asm volatile("s_waitcnt lgkmcnt(0)" ::: "memory");
    const int cc = lane & 15;
    float wv[8];
#pragma unroll
    for (int e = 0; e < 8; ++e) wv[e] = onw[cc * 8 + e];
    bf16_t* Ob = MIX + (tok0 + q0 + qg * 32 + (lane >> 4)) * DM + h * 128 + cc * 8;
    const float* Xr = X + (lane >> 4) * 128 + cc * 8;
#pragma unroll
    for (int it = 0; it < 8; ++it) {
      const f32x4 x0 = *(const f32x4*)(Xr + it * 512), x1 = *(const f32x4*)(Xr + it * 512 + 4); const float rs = al_l[it * 4 + (lane >> 4)];
      u32x4 w; w.x = cvtpk(x0[0] * rs * wv[0], x0[1] * rs * wv[1]); w.y = cvtpk(x0[2] * rs * wv[2], x0[3] * rs * wv[3]);
      w.z = cvtpk(x1[0] * rs * wv[4], x1[1] * rs * wv[5]); w.w = cvtpk(x1[2] * rs * wv[6], x1[3] * rs * wv[7]);
      *(u32x4*)(Ob + (size_t)it * 4 * DM) = w;
    }
  }
  __syncthreads();
#undef SLOAD
#undef SWRITE
#undef DQ
#undef REL
}
}

namespace rec {
constexpr int CH = 32, NCH = SEQL / CH, QP = 136, SP = 40;
constexpr int OFF_QT = 0, OFF_KH = CH * QP * 2, OFF_KT = 2 * CH * QP * 2, OFF_VT = OFF_KT + 128 * SP * 2, OFF_DD = OFF_VT + 128 * SP * 2, OFF_TOT = OFF_DD + 512, DIRB = OFF_TOT + 2048;
static_assert(DIRB % 16 == 0 && 2 * DIRB <= 131072, "rec LDS map");
__device__ __forceinline__ int crow(int r, int hi) { return (r & 3) + 8 * (r >> 2) + 4 * hi; }
__device__ __forceinline__ bf16x8 pack8(float a0, float a1, float a2, float a3, float a4, float a5, float a6, float a7) {
  u32x4 w = {cvtpk(a0, a1), cvtpk(a2, a3), cvtpk(a4, a5), cvtpk(a6, a7)}; return *reinterpret_cast<bf16x8*>(&w);
}
__device__ __forceinline__ void rec_unit(const bf16_t* __restrict__ P, bf16_t* __restrict__ OF, bf16_t* __restrict__ OB, int bh, unsigned char* ldsg) {
  const int tid = threadIdx.x, wid = __builtin_amdgcn_readfirstlane(tid >> 6), lane = tid & 63, r32 = lane & 31, hi = lane >> 5;
  const int dir = wid >> 2, wv = wid & 3, b = bh >> 2, h = bh & 3;
  unsigned char* lb = ldsg + dir * DIRB;
  bf16_t* Qt = (bf16_t*)(lb + OFF_QT); bf16_t* Kh = (bf16_t*)(lb + OFF_KH); bf16_t* KtT = (bf16_t*)(lb + OFF_KT); bf16_t* VT = (bf16_t*)(lb + OFF_VT);
  float* dd = (float*)(lb + OFF_DD); float* tot = (float*)(lb + OFF_TOT);
  const bf16_t* base = P + (size_t)b * SEQL * INW;
  const int cq = 1536 + h * 128 + 2 * lane, cgt = (dir ? 2560 : 2048) + h * 128 + 2 * lane, cv = 3072 + h * 128 + 2 * lane;
  bf16_t* O = (dir ? OB : OF) + (size_t)b * SEQL * 512 + h * 128 + wv * 32 + r32;
  f32x16 S[4];
#pragma unroll
  for (int k = 0; k < 4; ++k) S[k] = f32x16{};
  unsigned pq[8], pg[8], pv[8];
#define TOKOF(s) (dir ? (SEQL - 1 - (s)) : (s))
#define LOADCHUNK(c) do { _Pragma("unroll") for (int i = 0; i < 8; ++i) { const bf16_t* rp = base + (size_t)TOKOF((c) * CH + wv * 8 + i) * INW; \
    pq[i] = *(const unsigned*)(rp + cq); pg[i] = *(const unsigned*)(rp + cgt); pv[i] = *(const unsigned*)(rp + cv); } } while (0)
  LOADCHUNK(0);
#define RBAR() asm volatile("s_waitcnt lgkmcnt(0)\n\ts_barrier" ::: "memory")
  if (dir == 1) { RBAR(); RBAR(); }
  for (int c = 0; c < NCH; ++c) {
    float gl0[8], gl1[8]; float G0 = 0.f, G1 = 0.f;
#pragma unroll
    for (int i = 0; i < 8; ++i) { G0 += bf_lo(pg[i]); G1 += bf_hi(pg[i]); gl0[i] = G0; gl1[i] = G1; }
    *(f32x2*)&tot[wv * 128 + 2 * lane] = (f32x2){G0, G1};
    RBAR();
    float P0 = 0.f, P1 = 0.f, C0 = 0.f, C1 = 0.f;
#pragma unroll
    for (int w = 0; w < 4; ++w) { const f32x2 t = *(const f32x2*)&tot[w * 128 + 2 * lane]; if (w < wv) { P0 += t[0]; P1 += t[1]; } C0 += t[0]; C1 += t[1]; }
    float kta[8], ktb[8];
#pragma unroll
    for (int i = 0; i < 8; ++i) {
      const float Ga = P0 + gl0[i], Gb = P1 + gl1[i];
      const float kfa = 1.f - ex2(bf_lo(pg[i])), kfb = 1.f - ex2(bf_hi(pg[i]));
      *(unsigned*)&Qt[(wv * 8 + i) * QP + 2 * lane] = cvtpk(bf_lo(pq[i]) * ex2(Ga), bf_hi(pq[i]) * ex2(Gb));
      *(unsigned*)&Kh[(wv * 8 + i) * QP + 2 * lane] = cvtpk(kfa * ex2(fminf(-Ga, 100.f)), kfb * ex2(fminf(-Gb, 100.f)));
      kta[i] = kfa * ex2(C0 - Ga); ktb[i] = kfb * ex2(C1 - Gb);
    }
    *(bf16x8*)&KtT[(2 * lane) * SP + wv * 8] = pack8(kta[0], kta[1], kta[2], kta[3], kta[4], kta[5], kta[6], kta[7]);
    *(bf16x8*)&KtT[(2 * lane + 1) * SP + wv * 8] = pack8(ktb[0], ktb[1], ktb[2], ktb[3], ktb[4], ktb[5], ktb[6], ktb[7]);
    { u32x4 a, bb;
      a.x = (pv[0] & 0xffffu) | (pv[1] << 16); a.y = (pv[2] & 0xffffu) | (pv[3] << 16); a.z = (pv[4] & 0xffffu) | (pv[5] << 16); a.w = (pv[6] & 0xffffu) | (pv[7] << 16);
      bb.x = (pv[0] >> 16) | (pv[1] & 0xffff0000u); bb.y = (pv[2] >> 16) | (pv[3] & 0xffff0000u); bb.z = (pv[4] >> 16) | (pv[5] & 0xffff0000u); bb.w = (pv[6] >> 16) | (pv[7] & 0xffff0000u);
      *(u32x4*)&VT[(2 * lane) * SP + wv * 8] = a; *(u32x4*)&VT[(2 * lane + 1) * SP + wv * 8] = bb; }
    if (wv == 0) *(f32x2*)&dd[2 * lane] = (f32x2){ex2(C0), ex2(C1)};
    if (c + 1 < NCH) LOADCHUNK(c + 1);
    RBAR();
    f32x16 aT = f32x16{};
#pragma unroll
    for (int ks = 0; ks < 8; ++ks) { const bf16x8 a = *(const bf16x8*)&Kh[r32 * QP + ks * 16 + hi * 8]; const bf16x8 bq = *(const bf16x8*)&Qt[r32 * QP + ks * 16 + hi * 8];
      aT = __builtin_amdgcn_mfma_f32_32x32x16_bf16(a, bq, aT, 0, 0, 0); }
#pragma unroll
    for (int r = 0; r < 16; ++r) if (crow(r, hi) > r32) aT[r] = 0.f;
    f32x16 o = f32x16{};
#pragma unroll
    for (int kt = 0; kt < 4; ++kt)
#pragma unroll
      for (int hh = 0; hh < 2; ++hh) {
        const s16x4 lo4 = *(const s16x4*)&Qt[r32 * QP + kt * 32 + hh * 16 + hi * 4], hi4 = *(const s16x4*)&Qt[r32 * QP + kt * 32 + hh * 16 + 8 + hi * 4];
        const bf16x8 a = {lo4[0], lo4[1], lo4[2], lo4[3], hi4[0], hi4[1], hi4[2], hi4[3]};
        const bf16x8 bs = pack8(S[kt][hh * 8 + 0], S[kt][hh * 8 + 1], S[kt][hh * 8 + 2], S[kt][hh * 8 + 3], S[kt][hh * 8 + 4], S[kt][hh * 8 + 5], S[kt][hh * 8 + 6], S[kt][hh * 8 + 7]);
        o = __builtin_amdgcn_mfma_f32_32x32x16_bf16(a, bs, o, 0, 0, 0);
      }
#pragma unroll
    for (int hh = 0; hh < 2; ++hh) {
      const bf16x8 a = pack8(aT[hh * 8 + 0], aT[hh * 8 + 1], aT[hh * 8 + 2], aT[hh * 8 + 3], aT[hh * 8 + 4], aT[hh * 8 + 5], aT[hh * 8 + 6], aT[hh * 8 + 7]);
      const s16x4 lo4 = *(const s16x4*)&VT[(wv * 32 + r32) * SP + hh * 16 + hi * 4], hi4 = *(const s16x4*)&VT[(wv * 32 + r32) * SP + hh * 16 + 8 + hi * 4];
      const bf16x8 bv = {lo4[0], lo4[1], lo4[2], lo4[3], hi4[0], hi4[1], hi4[2], hi4[3]};
      o = __builtin_amdgcn_mfma_f32_32x32x16_bf16(a, bv, o, 0, 0, 0);
    }
    RBAR();
#pragma unroll
    for (int kt = 0; kt < 4; ++kt) {
#pragma unroll
      for (int q4 = 0; q4 < 4; ++q4) { const f32x4 d4 = *(const f32x4*)&dd[kt * 32 + q4 * 8 + hi * 4];
#pragma unroll
        for (int j = 0; j < 4; ++j) S[kt][q4 * 4 + j] *= d4[j]; }
#pragma unroll
      for (int ks = 0; ks < 2; ++ks) { const bf16x8 a = *(const bf16x8*)&KtT[(kt * 32 + r32) * SP + ks * 16 + hi * 8]; const bf16x8 bv = *(const bf16x8*)&VT[(wv * 32 + r32) * SP + ks * 16 + hi * 8];
        S[kt] = __builtin_amdgcn_mfma_f32_32x32x16_bf16(a, bv, S[kt], 0, 0, 0); }
    }
#pragma unroll
    for (int r = 0; r < 16; ++r) { const int tk = TOKOF(c * CH + crow(r, hi)); O[(size_t)tk * 512] = (bf16_t)(cvtpk(o[r], 0.f) & 0xffffu); }
    RBAR();
  }
  if (dir == 0) { RBAR(); RBAR(); }
  __syncthreads();
#undef RBAR
#undef TOKOF
#undef LOADCHUNK
}
}

#define XB_TMO      128
#define XB_XCNT(j)  (256  + 64 * (j))
#define XB_XSUB(j)  (1280 + 64 * (j))
#define XB_XGEN(j)  (2304 + 64 * (j))
#define XB_TOP      3328
#define XB_TOPGEN   3392
#define XCD_BAR_WORDS 3456
#define XB_SPIN_CAP (1u << 18)

__device__ __forceinline__ unsigned xb_ld(unsigned* p)              { return __hip_atomic_load(p, __ATOMIC_RELAXED, __HIP_MEMORY_SCOPE_AGENT); }
__device__ __forceinline__ unsigned xb_add(unsigned* p, unsigned v) { return __hip_atomic_fetch_add(p, v, __ATOMIC_RELAXED, __HIP_MEMORY_SCOPE_AGENT); }
__device__ __forceinline__ unsigned xb_xcc_id() { return (unsigned)__builtin_amdgcn_s_getreg((3 << 11) | 20) & 0xFu; }
#define XB_SPIN(cond, bar) do { unsigned _sp = 0; while (cond) { __builtin_amdgcn_s_sleep(1); \
    if ((++_sp & 255u) == 0u) { if (xb_ld(&(bar)[XB_TMO])) break; if (_sp > XB_SPIN_CAP) { atomicAdd(&(bar)[XB_TMO], 1u); break; } } } } while (0)

struct XcdBarrier {
    unsigned* bar; unsigned x;
    volatile LAS unsigned* st;
};

__device__ __forceinline__ XcdBarrier xcd_barrier_post(unsigned* bar, volatile LAS unsigned* st) {
    XcdBarrier b; b.bar = bar; b.x = xb_xcc_id(); b.st = st;
    if (threadIdx.x == 0) (void)xb_add(&bar[XB_XCNT(b.x)], 1u);
    return b;
}
__device__ __forceinline__ void xcd_barrier_complete(unsigned* bar, unsigned x, unsigned& nloc, unsigned& nx) {
    const unsigned G = gridDim.x * gridDim.y * gridDim.z;
    unsigned sum, cnt, mine, sp = 0u;
    for (;;) {
        sum = 0u; cnt = 0u; mine = 0u;
#pragma unroll
        for (unsigned j = 0; j < 16; ++j) { const unsigned c = xb_ld(&bar[XB_XCNT(j)]); sum += c; cnt += (c > 0u) ? 1u : 0u; mine = (j == x) ? c : mine; }
        if (sum == G) break;
        __builtin_amdgcn_s_sleep(1);
        if ((++sp & 255u) == 0u) { if (xb_ld(&bar[XB_TMO])) break; if (sp > XB_SPIN_CAP) { atomicAdd(&bar[XB_TMO], 1u); break; } }
    }
    nloc = mine > 0u ? mine : 1u; nx = cnt > 0u ? cnt : 1u;
}

__device__ __forceinline__ void xcd_barrier(const XcdBarrier& b) {
    asm volatile("s_waitcnt vmcnt(0)" ::: "memory");
    __syncthreads();
    if (threadIdx.x == 0) {
        unsigned* bar = b.bar;
        __builtin_amdgcn_s_waitcnt(0);
        unsigned nloc = b.st[0], nx = b.st[1];
        if (nloc == 0u) { xcd_barrier_complete(bar, b.x, nloc, nx); b.st[0] = nloc; b.st[1] = nx; }
        const unsigned old = xb_add(&bar[XB_XSUB(b.x)], 1u);
        const unsigned gen = old / nloc;
        if (old + 1u == (gen + 1u) * nloc) {
            __builtin_amdgcn_fence(__ATOMIC_RELEASE, "agent");
            asm volatile("s_waitcnt vmcnt(0)" ::: "memory");
            const unsigned og = xb_add(&bar[XB_TOP], 1u);
            const unsigned tg = og / nx;
            if (og + 1u == (tg + 1u) * nx) xb_add(&bar[XB_TOPGEN], 1u);
            else XB_SPIN(xb_ld(&bar[XB_TOPGEN]) == tg, bar);
            __builtin_amdgcn_fence(__ATOMIC_ACQUIRE, "agent");
            xb_add(&bar[XB_XGEN(b.x)], 1u);
            asm volatile("s_waitcnt vmcnt(0)" ::: "memory");
        } else {
            XB_SPIN(xb_ld(&bar[XB_XGEN(b.x)]) == gen, bar);
            __builtin_amdgcn_fence(__ATOMIC_ACQUIRE, "agent");
            asm volatile("s_waitcnt vmcnt(0)" ::: "memory");
        }
    }
    __syncthreads();
}

struct Args { const float* in[20]; float* out; unsigned char* ws; int ph_lo, ph_hi; };
constexpr int NPH = 9;
constexpr int N_ATT_UNITS = NSEQ * NHEAD * (SEQL / 128), N_REC_UNITS = NSEQ * NHEAD;

__global__ void __launch_bounds__(512, 2) fwd_kernel(Args args) {
    extern __shared__ __attribute__((aligned(16))) unsigned char lds[];
    cg::grid_group grid = cg::this_grid();
    const int wave = __builtin_amdgcn_readfirstlane((int)threadIdx.x >> 6);
#define PHASE_IDS int tid = threadIdx.x; asm volatile("" : "+v"(tid)); const int lane = tid & 63; (void)lane;
    const int G = gridDim.x, gw = blockIdx.x * 8 + wave, NGW = G * 8;
    unsigned char* ws = args.ws;
    const float* xp = args.in[0]; const float* xs = args.in[1];
    bf16_t* W_in = (bf16_t*)(ws + WS_WIN); bf16_t* W_out = (bf16_t*)(ws + WS_WOUT); bf16_t* W_up = (bf16_t*)(ws + WS_WUP); bf16_t* W_down = (bf16_t*)(ws + WS_WDOWN);
    bf16_t* XN = (bf16_t*)(ws + WS_XN); bf16_t* PROJ = (bf16_t*)(ws + WS_PROJ); bf16_t* OFb = (bf16_t*)(ws + WS_OF); bf16_t* OBb = (bf16_t*)(ws + WS_OB);
    bf16_t* ACT = (bf16_t*)(ws + WS_ACT); bf16_t* X1B = (bf16_t*)(ws + WS_OF);
    unsigned* ctl = (unsigned*)(ws + WS_CTL);
    PG8_LAS unsigned char* ldsl = (PG8_LAS unsigned char*)lds;
    const int lo = args.ph_lo, hi = args.ph_hi;
    volatile LAS unsigned* xst = (volatile LAS unsigned*)(ldsl + LDS_MISC + 64);
    if (threadIdx.x < 2) xst[threadIdx.x] = 0u;
    __syncthreads();
    XcdBarrier xbar; xbar.bar = ctl + 4096; xbar.x = 0; xbar.st = xst;
#ifndef PHMASK
#define PHMASK 0xffff
#endif
#define IN(k) (((PHMASK >> (k)) & 1) && lo <= (k) && (k) < hi)
#define SEAM(k) do { if (IN(k) && IN((k) + 1)) { if ((k) == 0) grid.sync(); else xcd_barrier(xbar); } } while (0)
#ifndef REPEAT_PH
#define REPEAT_PH -1
#endif
#define NREP(k) ((REPEAT_PH == (k)) ? 2 : 1)

    if (IN(0)) {
        PHASE_IDS
        if (blockIdx.x == 0) for (int i = tid; i < 8192; i += 512) ctl[i] = 0u;
        LAS float* scr = (LAS float*)(ldsl + wave * 16384);
        constexpr int I_IN = (DM / 64) * (INW / 32), I_OUT = (DM / 64) * (DM / 32), I_UP = (DM / 64) * (DFF2 / 32), I_DOWN = (DFF / 64) * (DM / 32);
        for (int it = gw; it < I_IN + I_OUT + I_UP + I_DOWN; it += NGW) {
            int r = it;
            if (r < I_IN) { p0_transpose_item(args.in[3], DM, INW, W_in, scr, r, lane); continue; } r -= I_IN;
            if (r < I_OUT) { p0_transpose_item(args.in[14], DM, DM, W_out, scr, r, lane); continue; } r -= I_OUT;
            if (r < I_UP) { p0_transpose_item(args.in[16], DM, DFF2, W_up, scr, r, lane, true); continue; } r -= I_UP;
            p0_transpose_item(args.in[19], DFF, DM, W_down, scr, r, lane);
        }
        for (int m = gw * 2; m < MTOK; m += NGW * 2) rms_row2_to_bf16(xrow_ptr(xp, xs, m), xrow_ptr(xp, xs, m + 1), args.in[2], XN + (size_t)m * DM, XN + (size_t)(m + 1) * DM, lane);
    }
    SEAM(0);
    if (IN(0) && IN(1)) xbar = xcd_barrier_post(ctl + 4096, xst);
    for (int rep = 0; rep < NREP(1); ++rep) { if (rep) grid.sync();
    if (IN(1)) {
        pg8::Gemm g{XN, W_in, MTOK, INW, DM}; pg8::StaticOrder S; S.init(MTOK, INW, G, (int)blockIdx.x);
        EpiInProj E{PROJ, args.in[11], args.in[12], args.in[4], args.in[5], (PG8_LAS float*)(ldsl + 131072)};
        pg8::gemm_phase<EpiInProj, pg8::StaticOrder, true, true>(ldsl, g, S, E);
    } }
    SEAM(1);
    for (int rep = 0; rep < NREP(3); ++rep) { if (rep) grid.sync();
    if (IN(3)) {
        PHASE_IDS
        float lam; int Wh[4];
        { const float a = args.in[6][lane] * args.in[7][lane], b = args.in[8][lane] * args.in[9][lane];
          lam = ex2(wave_sum(a) * LOG2E) - ex2(wave_sum(b) * LOG2E) + 0.2f;
          float mq = fabsf(args.in[4][lane]), mk = fabsf(args.in[5][lane]);
#pragma unroll
          for (int o = 1; o < 64; o <<= 1) { mq = fmaxf(mq, __shfl_xor(mq, o)); mk = fmaxf(mk, __shfl_xor(mk, o)); }
          const float S2 = 8.f * LOG2E * 1.01f * 1.01f * mq * mk;
#pragma unroll
          for (int h = 0; h < 4; ++h) { const float c2h = LOG2E * (h == 0 ? 0.25f : h == 1 ? 0.0625f : h == 2 ? 0.015625f : 0.00390625f);
            const float need = 2.f * S2 + 30.f + lg2(2.f / (1.f - ex2(-c2h)));
            const float wf = need / c2h; Wh[h] = wf >= (float)SEQL ? SEQL : (int)wf + 1; } }
#ifndef NO_REC
#ifndef REC_REPS
#define REC_REPS 1
#endif
        for (int rr2 = 0; rr2 < REC_REPS; ++rr2)
        for (int u = blockIdx.x; u < N_REC_UNITS; u += G) rec::rec_unit(PROJ, OFb, OBb, u, lds);
#endif
        volatile int* misc = (volatile int*)(lds + LDS_MISC);
        int myq = (int)(__builtin_amdgcn_s_getreg((3 << 11) | 20) & 7u);
        constexpr int QN = 320;
        for (int tries = 0; tries < 8;) {
            if (tid == 0) misc[0] = (int)atomicAdd(ctl + 64 + 32 * myq, 1u);
            __syncthreads();
            const int t = __builtin_amdgcn_readfirstlane(misc[0]);
            __syncthreads();
            if (t >= QN) { myq = (myq + 1) & 7; ++tries; continue; }
            int b, hh, qb;
            { int i2 = t, base = 0; hh = 3;
              for (int seg = 0; seg < 4; ++seg) { if (i2 < 64) { b = myq; qb = i2; hh = 3 - seg; base = 1; break; } i2 -= 64; if (i2 < 16) { b = 8 + (i2 >> 3); qb = 8 * myq + (i2 & 7); hh = 3 - seg; base = 1; break; } i2 -= 16; }
              (void)base; }
#ifndef NO_ATT
            att::attn_unit(PROJ, XN, args.in[10], lam, b * 4 + hh, qb, hh == 0 ? Wh[0] : hh == 1 ? Wh[1] : hh == 2 ? Wh[2] : Wh[3], (char*)lds);
#endif
        }
    } }
    SEAM(3);
    for (int rep = 0; rep < NREP(4); ++rep) { if (rep) grid.sync();
    if (IN(4)) {
        PHASE_IDS
        const int h4 = lane >> 4, c8 = (lane & 15) * 8;
        float w8[8];
#pragma unroll
        for (int e = 0; e < 8; ++e) w8[e] = args.in[13][c8 + e];
        for (int m0 = gw * 4; m0 < MTOK; m0 += NGW * 4) {
            u32x4 fa[4], fb[4], fg[4];
#pragma unroll
            for (int u = 0; u < 4; ++u) { const size_t m = m0 + u;
                fa[u] = *(const u32x4*)(OFb + m * 512 + h4 * 128 + c8); fb[u] = *(const u32x4*)(OBb + m * 512 + h4 * 128 + c8); fg[u] = *(const u32x4*)(PROJ + m * INW + 3584 + h4 * 128 + c8); }
#pragma unroll
            for (int u = 0; u < 4; ++u) {
                float v[8]; float sq = 0.f;
#pragma unroll
                for (int e = 0; e < 4; ++e) { v[2 * e] = bf_lo(fa[u][e]) + bf_lo(fb[u][e]); v[2 * e + 1] = bf_hi(fa[u][e]) + bf_hi(fb[u][e]); sq += v[2 * e] * v[2 * e] + v[2 * e + 1] * v[2 * e + 1]; }
                sq += __shfl_xor(sq, 1); sq += __shfl_xor(sq, 2); sq += __shfl_xor(sq, 4); sq += __shfl_xor(sq, 8);
                const float rs = __builtin_amdgcn_rsqf(sq * (1.f / 128.f) + NORM_EPS);
                u32x4 o;
#pragma unroll
                for (int e = 0; e < 4; ++e) o[e] = cvtpk(v[2 * e] * rs * w8[2 * e] * bf_lo(fg[u][e]), v[2 * e + 1] * rs * w8[2 * e + 1] * bf_hi(fg[u][e]));
                *(u32x4*)(XN + (size_t)(m0 + u) * DM + 512 + h4 * 128 + c8) = o;
            }
        }
    }
    }
    SEAM(4);
    for (int rep = 0; rep < NREP(5); ++rep) { if (rep) grid.sync();
    if (IN(5)) {
        pg8::Gemm g{XN, W_out, MTOK, DM, DM}; pg8::StaticOrder S; S.init(MTOK, DM, G, (int)blockIdx.x);
        EpiResidB E{xp, xs, X1B};
        pg8::gemm_phase<EpiResidB, pg8::StaticOrder, true, true>(ldsl, g, S, E);
    }
    }
    SEAM(5);
    for (int rep = 0; rep < NREP(6); ++rep) { if (rep) grid.sync();
    if (IN(6)) {
        PHASE_IDS
        for (int m = gw * 2; m < MTOK; m += NGW * 2) rms_rowb2_to_bf16(X1B + (size_t)m * DM, X1B + (size_t)(m + 1) * DM, args.in[15], XN + (size_t)m * DM, XN + (size_t)(m + 1) * DM, lane);
    }
    }
    SEAM(6);
    for (int rep = 0; rep < NREP(7); ++rep) { if (rep) grid.sync();
    if (IN(7)) {
        pg8::Gemm g{XN, W_up, NSEQ * 33 * 256, DFF2, DM}; pg8::StaticOrder S; S.init(NSEQ * 33 * 256, DFF2, G, (int)blockIdx.x); S.ovl = 1;
        EpiConvAct E{ACT, args.in[17], args.in[18], (PG8_LAS float*)(ldsl + 131072)};
        pg8::gemm_phase<EpiConvAct, pg8::StaticOrder, true, true>(ldsl, g, S, E);
    } }
    SEAM(7);
    if (IN(8)) {
        pg8::Gemm g{ACT, W_down, MTOK, DM, DFF}; pg8::StaticOrder S; S.init(MTOK, DM, G, (int)blockIdx.x);
        EpiFinal E{X1B, args.out};
        pg8::gemm_phase<EpiFinal, pg8::StaticOrder, true, true>(ldsl, g, S, E);
    }
#undef IN
#undef SEAM
}

#ifndef ONE_LAUNCH
#define ONE_LAUNCH 1
#endif
extern "C" void kernel_launch(void* const* d_in, const int* in_sizes, int n_in, void* d_out, int out_size, void* d_ws, size_t ws_size, hipStream_t stream) {
    static int grid = 0;
    if (grid == 0) {
        if (n_in != 20 || out_size != MTOK * DM || ws_size < WS_END) { fprintf(stderr, "kernel_launch: unexpected shapes n_in %d out %d ws %zu (need %zu)\n", n_in, out_size, ws_size, (size_t)WS_END); grid = -1; return; }
        int dev = 0, cus = 0, per_cu = 0;
        (void)hipGetDevice(&dev); (void)hipDeviceGetAttribute(&cus, hipDeviceAttributeMultiprocessorCount, dev);
        if (hipFuncSetAttribute((const void*)fwd_kernel, hipFuncAttributeMaxDynamicSharedMemorySize, LDS_BYTES) != hipSuccess) { fprintf(stderr, "kernel_launch: hipFuncSetAttribute failed\n"); grid = -1; return; }
        (void)hipOccupancyMaxActiveBlocksPerMultiprocessor(&per_cu, (const void*)fwd_kernel, 512, LDS_BYTES);
        if (per_cu < 1) { fprintf(stderr, "kernel_launch: occupancy query says %d\n", per_cu); per_cu = 1; }
        (void)hipGetLastError();
        grid = cus * per_cu;
    }
    if (grid < 0) return;
#if !ONE_LAUNCH
    (void)hipMemsetAsync((char*)d_ws + WS_CTL, 0, 32768, stream);
#endif
    Args a{};
    for (int i = 0; i < 20; ++i) a.in[i] = (const float*)d_in[i];
    a.out = (float*)d_out; a.ws = (unsigned char*)d_ws;
#if ONE_LAUNCH
    a.ph_lo = 0; a.ph_hi = NPH;
    void* kargs[] = {&a};
    hipError_t e = hipLaunchCooperativeKernel((const void*)fwd_kernel, dim3(grid), dim3(512), kargs, LDS_BYTES, stream);
    if (e != hipSuccess) fprintf(stderr, "cooperative launch failed: %s (grid %d)\n", hipGetErrorString(e), grid);
#else
    for (int p = 0; p < NPH; ++p) {
        a.ph_lo = p; a.ph_hi = p + 1;
        hipLaunchKernelGGL(fwd_kernel, dim3(grid), dim3(512), LDS_BYTES, stream, a);
    }
#endif
}
```

```cpp
#include <hip/hip_runtime.h>
#include <hip/hip_cooperative_groups.h>
#include <cstdio>
#include <cstdint>
namespace cg = cooperative_groups;

namespace pg8 {
#define PG8_LAS __attribute__((address_space(3)))
typedef unsigned short bf16_t;
typedef short bf16x8 __attribute__((ext_vector_type(8)));
typedef float f32x4 __attribute__((ext_vector_type(4)));
typedef unsigned u32x4 __attribute__((ext_vector_type(4)));
constexpr int BM = 256, BK = 64, HALF = 128, HTB = HALF * BK * 2  , STAGE_BYTES = 8 * HTB, NXCD = 8, WGM = 8;

__host__ __device__ __forceinline__ int lds_byte(int r, int c) { const int st = (r >> 4) * 2 + (c >> 5), rr = r & 15, cc = c & 31, ob = rr * 64 + cc * 2; return st * 1024 + (ob ^ (((ob >> 9) & 1) << 5)); }
__host__ __device__ __forceinline__ void stage_rc(int b, int& R, int& C) { const int st = b / 1024, sb = b % 1024, swz = sb ^ (((sb >> 9) & 1) << 5); R = (st >> 1) * 16 + swz / 64; C = (st & 1) * 32 + (swz % 64) / 2; }
__host__ __device__ __forceinline__ int perm32(int rho) { const int n = rho >> 4, i = rho & 15; return 8 * (i >> 2) + 4 * n + (i & 3); }

struct Unit { int pm, pn; };
struct Gemm { const bf16_t* A; const bf16_t* Bt; int M, N, K; };

struct StaticOrder {
    int nM, nN, nwg, G, c;
    __host__ __device__ void init(int M, int N, int G_, int c_) { nM = M / BM; nN = N / BM; nwg = nM * nN; G = G_; c = c_; }
    __host__ __device__ bool next(int i, Unit& u) const {
        const long L = (long)i * G + c; if (L >= nwg) return false;
        int wgid = (int)L; { const int q = nwg / NXCD, r = nwg % NXCD, xcd = wgid % NXCD, off = wgid / NXCD; wgid = (xcd < r ? xcd * (q + 1) : r * (q + 1) + (xcd - r) * q) + off; }
        const int nig = WGM * nN, gid = wgid / nig, fm = gid * WGM, gsz = (nM - fm) < WGM ? (nM - fm) : WGM;
        u.pm = fm + ((wgid % nig) % gsz); u.pn = (wgid % nig) / gsz; return true;
    }
    int ovl = 0;
    __device__ __forceinline__ long arow(const Unit& u) const { return ovl ? (long)(u.pm / 33) * 8192 + 252 * (u.pm % 33) - 1 : (long)u.pm * BM; }
    __device__ __forceinline__ void a_ready(const Unit&) const {}
    __device__ __forceinline__ void done(const Unit&) const {}
};

__device__ __forceinline__ unsigned cvt_pk_bf16(float lo, float hi) { unsigned r; asm volatile("v_cvt_pk_bf16_f32 %0, %1, %2" : "=v"(r) : "v"(lo), "v"(hi)); return r; }
typedef float f32x2 __attribute__((ext_vector_type(2)));
template <class Epi, class Sched, bool ALIGN_EPI = false, bool SP2 = false>
__device__ __forceinline__ void gemm_phase(PG8_LAS unsigned char* lds, const Gemm g, const Sched& S, const Epi& E) {
    int tid = threadIdx.x; asm volatile("" : "+v"(tid));
    const int wid = __builtin_amdgcn_readfirstlane(tid >> 6), lane = tid & 63, wr = wid >> 2, wc = wid & 3, fr = lane & 15, fq = lane >> 4;
    const int K = g.K, nt = K / BK;
    unsigned voffA[2], voffB[2];
#pragma unroll
    for (int i = 0; i < 2; ++i) { int R, C; stage_rc(tid * 16 + i * 8192, R, C); const int Rb = Epi::PERM ? ((R & ~31) + perm32(R & 31)) : R;
        const int Ra = S.ovl ? (126 * (R >> 6) + 4 * (R & 15) + ((R >> 4) & 3)) : R;
        voffA[i] = (unsigned)(Ra * K + C) * 2u; voffB[i] = (unsigned)(Rb * K + C) * 2u; }
    const size_t kstep = (size_t)(BK * 2);
    const size_t hstep = (size_t)HALF * K * 2;
    const size_t tstep = 2 * hstep;
    const size_t hstepA = S.ovl ? (size_t)64 * K * 2 : hstep;
    const unsigned ldsw = (unsigned)wid * 1024u;
    const int aoff = lds_byte(wr * 64 + fr, fq * 8), boff = lds_byte(wc * 32 + fr, fq * 8);
#define PG8_SA(b, h) (((b) * 2 + (h)) * HTB)
#define PG8_SB(b, h) ((4 + (b) * 2 + (h)) * HTB)
#define PG8_STAGE(bufoff, gbase, voff) do { _Pragma("unroll") for (int _i = 0; _i < 2; ++_i) \
        __builtin_amdgcn_global_load_lds((const unsigned*)((const char*)(gbase) + (voff)[_i]), (PG8_LAS unsigned*)(lds + (bufoff) + ldsw + _i * 8192), 16, 0, 0); } while (0)
#define PG8_LDA(dst, b, h) do { _Pragma("unroll") for (int m = 0; m < 4; ++m) _Pragma("unroll") for (int k = 0; k < 2; ++k) dst[m][k] = *(const PG8_LAS bf16x8*)(lds + PG8_SA(b, h) + aoff + m * 2048 + k * 1024); } while (0)
#define PG8_LDB(dst, b, h) do { _Pragma("unroll") for (int n = 0; n < 2; ++n) _Pragma("unroll") for (int k = 0; k < 2; ++k) dst[n][k] = *(const PG8_LAS bf16x8*)(lds + PG8_SB(b, h) + boff + n * 2048 + k * 1024); } while (0)
#define PG8_MMA(ai, bj, At, Bt) do { __builtin_amdgcn_s_setprio(1); _Pragma("unroll") for (int m = 0; m < 4; ++m) _Pragma("unroll") for (int n = 0; n < 2; ++n) _Pragma("unroll") for (int k = 0; k < 2; ++k) \
        acc[ai][bj][m][n] = __builtin_amdgcn_mfma_f32_16x16x32_bf16(Bt[n][k], At[m][k], acc[ai][bj][m][n], 0, 0, 0); __builtin_amdgcn_s_setprio(0); } while (0)
#define PG8_WAIT_V(n) asm volatile("s_waitcnt vmcnt(" #n ")" ::: "memory")
#define PG8_WAIT_L(n) asm volatile("s_waitcnt lgkmcnt(" #n ")" ::: "memory")
#define PG8_BAR __builtin_amdgcn_s_barrier()
#define PG8_SCHED __builtin_amdgcn_sched_barrier(0)
    Unit cur, nxt; int ui = 0;
    if (!S.next(0, cur)) return;
    f32x4 acc[2][2][4][2];
#pragma unroll
    for (int a = 0; a < 2; ++a)
#pragma unroll
        for (int b = 0; b < 2; ++b)
#pragma unroll
            for (int m = 0; m < 4; ++m)
#pragma unroll
                for (int n = 0; n < 2; ++n) acc[a][b][m][n] = (f32x4){0.f, 0.f, 0.f, 0.f};
    bf16x8 At[4][2], B0[2][2], B1[2][2];
    const long rowb = (long)K * 2;
    const char* cA = (const char*)g.A + S.arow(cur) * rowb; const char* cB = (const char*)g.Bt + (size_t)cur.pn * tstep;
    S.a_ready(cur);
    if constexpr (SP2) {
        PG8_STAGE(PG8_SB(0, 0), cB, voffB); PG8_STAGE(PG8_SB(0, 1), cB + hstep, voffB); PG8_STAGE(PG8_SA(0, 0), cA, voffA); PG8_STAGE(PG8_SA(0, 1), cA + hstepA, voffA);
        if (wr == 1) PG8_BAR;
        PG8_WAIT_V(2); PG8_BAR;
        PG8_STAGE(PG8_SB(1, 0), cB + kstep, voffB); PG8_STAGE(PG8_SA(1, 0), cA + kstep, voffA); PG8_STAGE(PG8_SB(1, 1), cB + hstep + kstep, voffB);
        PG8_WAIT_V(6); PG8_BAR;
    } else {
        PG8_STAGE(PG8_SB(0, 0), cB, voffB); PG8_STAGE(PG8_SA(0, 0), cA, voffA); PG8_STAGE(PG8_SB(0, 1), cB + hstep, voffB); PG8_STAGE(PG8_SA(0, 1), cA + hstepA, voffA);
        if (wr == 1) PG8_BAR;
        PG8_WAIT_V(4); PG8_BAR;
        PG8_STAGE(PG8_SB(1, 0), cB + kstep, voffB); PG8_STAGE(PG8_SA(1, 0), cA + kstep, voffA); PG8_STAGE(PG8_SB(1, 1), cB + hstep + kstep, voffB);
        PG8_WAIT_V(6); PG8_BAR;
    }
    for (;;) {
        const bool has_next = S.next(ui + 1, nxt);
        const char* nA = has_next ? (const char*)g.A + S.arow(nxt) * rowb : cA; const char* nB = has_next ? (const char*)g.Bt + (size_t)nxt.pn * tstep : cB;
        for (int t = 0; t < nt; t += 2) {
            const bool last = (t == nt - 2);
            const char* a1 = cA + (size_t)(t + 1) * kstep;
            const char* a2 = last ? nA : cA + (size_t)(t + 2) * kstep; const char* b2 = last ? nB : cB + (size_t)(t + 2) * kstep;
            const char* a3 = a2 + kstep; const char* b3 = b2 + kstep;
            if (last && has_next) S.a_ready(nxt);
            if constexpr (SP2) {
            PG8_LDB(B0, 0, 0); PG8_LDB(B1, 0, 1); PG8_SCHED; PG8_LDA(At, 0, 0); PG8_STAGE(PG8_SA(1, 1), a1 + hstepA, voffA);
            PG8_WAIT_V(8); PG8_WAIT_L(0); PG8_BAR; PG8_MMA(0, 0, At, B0); PG8_MMA(0, 1, At, B1); PG8_BAR; PG8_SCHED;
            PG8_LDA(At, 0, 1); PG8_STAGE(PG8_SB(0, 0), b2, voffB); PG8_STAGE(PG8_SB(0, 1), b2 + hstep, voffB); PG8_STAGE(PG8_SA(0, 0), a2, voffA);
            PG8_WAIT_V(8); PG8_WAIT_L(0); PG8_BAR; PG8_MMA(1, 0, At, B0); PG8_MMA(1, 1, At, B1); PG8_BAR; PG8_SCHED;
            PG8_LDB(B0, 1, 0); PG8_LDB(B1, 1, 1); PG8_SCHED; PG8_LDA(At, 1, 0); PG8_STAGE(PG8_SA(0, 1), a2 + hstepA, voffA);
            PG8_WAIT_V(8); PG8_WAIT_L(0); PG8_BAR; PG8_MMA(0, 0, At, B0); PG8_MMA(0, 1, At, B1); PG8_BAR; PG8_SCHED;
            PG8_LDA(At, 1, 1); PG8_STAGE(PG8_SB(1, 0), b3, voffB); PG8_STAGE(PG8_SB(1, 1), b3 + hstep, voffB); PG8_STAGE(PG8_SA(1, 0), a3, voffA);
            PG8_WAIT_V(8); PG8_WAIT_L(0); PG8_BAR; PG8_MMA(1, 0, At, B0); PG8_MMA(1, 1, At, B1); PG8_BAR; PG8_SCHED;
            } else {
            PG8_LDB(B0, 0, 0); PG8_SCHED; PG8_LDA(At, 0, 0); PG8_STAGE(PG8_SA(1, 1), a1 + hstepA, voffA);
            PG8_WAIT_L(8); PG8_BAR; PG8_WAIT_L(0); PG8_MMA(0, 0, At, B0); PG8_BAR; PG8_SCHED;
            PG8_LDB(B1, 0, 1); PG8_STAGE(PG8_SB(0, 0), b2, voffB);
            PG8_BAR; PG8_WAIT_L(0); PG8_MMA(0, 1, At, B1); PG8_BAR;
            PG8_LDA(At, 0, 1); PG8_STAGE(PG8_SA(0, 0), a2, voffA);
            PG8_BAR; PG8_WAIT_L(0); PG8_MMA(1, 0, At, B0); PG8_BAR; PG8_SCHED;
            PG8_STAGE(PG8_SB(0, 1), b2 + hstep, voffB);
            PG8_WAIT_V(6); PG8_BAR; PG8_MMA(1, 1, At, B1); PG8_BAR;
            PG8_LDB(B0, 1, 0); PG8_SCHED; PG8_LDA(At, 1, 0); PG8_STAGE(PG8_SA(0, 1), a2 + hstepA, voffA);
            PG8_WAIT_L(8); PG8_BAR; PG8_WAIT_L(0); PG8_MMA(0, 0, At, B0); PG8_BAR; PG8_SCHED;
            PG8_LDB(B1, 1, 1); PG8_STAGE(PG8_SB(1, 0), b3, voffB);
            PG8_BAR; PG8_WAIT_L(0); PG8_MMA(0, 1, At, B1); PG8_BAR;
            PG8_LDA(At, 1, 1); PG8_STAGE(PG8_SA(1, 0), a3, voffA);
            PG8_BAR; PG8_WAIT_L(0); PG8_MMA(1, 0, At, B0); PG8_BAR; PG8_SCHED;
            PG8_STAGE(PG8_SB(1, 1), b3 + hstep, voffB);
            PG8_WAIT_V(6); PG8_BAR; PG8_MMA(1, 1, At, B1); PG8_BAR;
            }
        }
        if constexpr (ALIGN_EPI) { if (wr == 0) PG8_BAR; }
        if constexpr (!Epi::AFTER_DRAIN) { E(acc, cur, wr, wc, fr, fq); S.done(cur); }
        if (!has_next) break;
#pragma unroll
        for (int a = 0; a < 2; ++a)
#pragma unroll
            for (int b = 0; b < 2; ++b)
#pragma unroll
                for (int m = 0; m < 4; ++m)
#pragma unroll
                    for (int n = 0; n < 2; ++n) acc[a][b][m][n] = (f32x4){0.f, 0.f, 0.f, 0.f};
        cur = nxt; cA = nA; cB = nB; ++ui;
        if constexpr (ALIGN_EPI) { if (wr == 1) PG8_BAR; }
    }
    PG8_WAIT_V(0);
    if constexpr (!ALIGN_EPI) { if (wr == 0) PG8_BAR; }
    PG8_BAR;
    if constexpr (Epi::AFTER_DRAIN) { E.fused(acc, cur, wr, wc, fr, fq, lds, wid, lane); S.done(cur); }
#undef PG8_SA
#undef PG8_SB
#undef PG8_STAGE
#undef PG8_LDA
#undef PG8_LDB
#undef PG8_MMA
#undef PG8_WAIT_V
#undef PG8_WAIT_L
#undef PG8_BAR
#undef PG8_SCHED
}
}

constexpr int DM = 1024, SEQL = 8192, NSEQ = 10, MTOK = NSEQ * SEQL, INW = 4096, DFF = 2816, DFF2 = 5632, NHEAD = 4;
constexpr int MPROMPT = 2 * SEQL;
constexpr float NORM_EPS = 1e-6f;
constexpr float LOG2E = 1.4426950408889634f;
typedef unsigned short bf16_t;
typedef short bf16x8 __attribute__((ext_vector_type(8)));
typedef short s16x4 __attribute__((ext_vector_type(4)));
typedef float f32x4 __attribute__((ext_vector_type(4)));
typedef float f32x16 __attribute__((ext_vector_type(16)));
typedef unsigned u32x4 __attribute__((ext_vector_type(4)));
typedef unsigned u32x2 __attribute__((ext_vector_type(2)));
typedef float f32x2 __attribute__((ext_vector_type(2)));
#define LAS __attribute__((address_space(3)))

constexpr size_t MiB = 1u << 20;
constexpr size_t WS_CTL = 0;
constexpr size_t WS_WIN = 1 * MiB;
constexpr size_t WS_WOUT = 9 * MiB;
constexpr size_t WS_WUP = 11 * MiB;
constexpr size_t WS_WDOWN = 22 * MiB;
constexpr size_t WS_XN = 32 * MiB;
constexpr size_t WS_PROJ = 192 * MiB;
constexpr size_t WS_OF = 832 * MiB;
constexpr size_t WS_OB = 912 * MiB;
constexpr size_t WS_U = 192 * MiB;
constexpr size_t WS_ACT = 192 * MiB;
constexpr size_t WS_END = 992 * MiB;
constexpr int NSLAB = 2, SLABROWS = MTOK / NSLAB;

constexpr int LDS_BYTES = 143360;
constexpr int LDS_MISC = 131072 + 8192;

__device__ __forceinline__ unsigned cvtpk(float lo, float hi) { unsigned r; asm("v_cvt_pk_bf16_f32 %0, %1, %2" : "=v"(r) : "v"(lo), "v"(hi)); return r; }
__device__ __forceinline__ float bf_lo(unsigned u) { return __uint_as_float(u << 16); }
__device__ __forceinline__ float bf_hi(unsigned u) { return __uint_as_float(u & 0xffff0000u); }
__device__ __forceinline__ float ex2(float x) { return __builtin_amdgcn_exp2f(x); }
__device__ __forceinline__ float lg2(float x) { return __builtin_amdgcn_logf(x); }
__device__ __forceinline__ float rcpf(float x) { return __builtin_amdgcn_rcpf(x); }
__device__ __forceinline__ float siluf(float x) { return x * rcpf(1.f + ex2(-x * LOG2E)); }
__device__ __forceinline__ float wave_sum(float v) {
#pragma unroll
    for (int o = 1; o < 64; o <<= 1) v += __shfl_xor(v, o);
    return v;
}
__device__ __forceinline__ const float* xrow_ptr(const float* xp, const float* xs, int row) {
    return row < MPROMPT ? xp + (size_t)row * DM : xs + (size_t)(row - MPROMPT) * DM;
}

struct EpiInProj {
    static constexpr bool PERM = true, AFTER_DRAIN = false;
    bf16_t* P; const float* lbf; const float* lbb; const float* qnw; const float* knw; PG8_LAS float* ex;
    __device__ __forceinline__ void operator()(const pg8::f32x4 (&acc)[2][2][4][2], const pg8::Unit& u, int wr, int wc, int fr, int fq) const {
        const int sec = u.pn >> 1;
        int row0 = u.pm * 256 + wr * 64 + fr, col0 = u.pn * 256 + wc * 32 + 8 * fq;
        asm volatile("" : "+v"(row0), "+v"(col0));
        if (sec < 2) {
            float ps[2][4][2];
#pragma unroll
            for (int ai = 0; ai < 2; ++ai)
#pragma unroll
                for (int m = 0; m < 4; ++m)
#pragma unroll
                    for (int bj = 0; bj < 2; ++bj) { float q = 0.f;
#pragma unroll
                        for (int n = 0; n < 2; ++n)
#pragma unroll
                            for (int e = 0; e < 4; ++e) q += acc[ai][bj][m][n][e] * acc[ai][bj][m][n][e];
                        q += __shfl_xor(q, 16); q += __shfl_xor(q, 32); ps[ai][m][bj] = q; }
            const int wid = wr * 4 + wc;
            if (fq == 0) {
#pragma unroll
                for (int ai = 0; ai < 2; ++ai)
#pragma unroll
                    for (int m = 0; m < 4; ++m)
#pragma unroll
                        for (int bj = 0; bj < 2; ++bj) ex[(wid * 16 + (ai * 8 + m * 2 + bj)) * 16 + fr] = ps[ai][m][bj];
            }
            asm volatile("s_waitcnt lgkmcnt(0)" ::: "memory"); __builtin_amdgcn_s_barrier();
            const float* nw = (sec == 0) ? qnw : knw; const float sc = (sec == 0) ? 0.125f * LOG2E : 1.f;
            float w8[8];
#pragma unroll
            for (int e = 0; e < 8; ++e) w8[e] = nw[32 * (wc & 1) + 8 * fq + e] * sc;
#pragma unroll
            for (int ai = 0; ai < 2; ++ai)
#pragma unroll
                for (int m = 0; m < 4; ++m) {
                    bf16_t* rowp = P + (size_t)(row0 + ai * 128 + m * 16) * INW + col0;
#pragma unroll
                    for (int bj = 0; bj < 2; ++bj) {
                        const float tot = ps[ai][m][bj] + ex[((wid ^ 1) * 16 + (ai * 8 + m * 2 + bj)) * 16 + fr];
                        const float rs = __builtin_amdgcn_rsqf(tot * (1.f / 64.f) + NORM_EPS);
                        const pg8::f32x4 v0 = acc[ai][bj][m][0], v1 = acc[ai][bj][m][1];
                        u32x4 w; w.x = cvtpk(v0[0] * rs * w8[0], v0[1] * rs * w8[1]); w.y = cvtpk(v0[2] * rs * w8[2], v0[3] * rs * w8[3]);
                        w.z = cvtpk(v1[0] * rs * w8[4], v1[1] * rs * w8[5]); w.w = cvtpk(v1[2] * rs * w8[6], v1[3] * rs * w8[7]);
                        __builtin_nontemporal_store(w, (u32x4*)(rowp + bj * 128));
                    }
                }
            return;
        }
        float lbv[2][8];
        if (sec == 4 || sec == 5) {
            const float* t = (sec == 4) ? lbf : lbb; const int cs = col0 - sec * 512;
#pragma unroll
            for (int bj = 0; bj < 2; ++bj)
#pragma unroll
                for (int e = 0; e < 8; ++e) { const int c = cs + bj * 128 + e; lbv[bj][e] = rcpf(1.f + ex2((t[512 + c] - t[c]) * LOG2E)); }
        }
#pragma unroll
        for (int ai = 0; ai < 2; ++ai)
#pragma unroll
            for (int m = 0; m < 4; ++m) {
                bf16_t* rowp = P + (size_t)(row0 + ai * 128 + m * 16) * INW + col0;
#pragma unroll
                for (int bj = 0; bj < 2; ++bj) {
                    float v[8];
#pragma unroll
                    for (int e = 0; e < 4; ++e) { v[e] = acc[ai][bj][m][0][e]; v[4 + e] = acc[ai][bj][m][1][e]; }
                    if (sec == 3 || sec == 7) {
#pragma unroll
                        for (int e = 0; e < 8; ++e) v[e] = siluf(v[e]);
                    } else if (sec == 4 || sec == 5) {
#pragma unroll
                        for (int e = 0; e < 8; ++e) { const float sg = rcpf(1.f + ex2(-v[e] * LOG2E)); const float lb = lbv[bj][e]; v[e] = lg2(lb + (1.f - lb) * sg); }
                    }
                    u32x4 w; w.x = cvtpk(v[0], v[1]); w.y = cvtpk(v[2], v[3]); w.z = cvtpk(v[4], v[5]); w.w = cvtpk(v[6], v[7]);
                    __builtin_nontemporal_store(w, (u32x4*)(rowp + bj * 128));
                }
            }
    }
};
struct EpiBf16Plain {
    static constexpr bool PERM = true, AFTER_DRAIN = false;
    bf16_t* O; int ldc;
    __device__ __forceinline__ void operator()(const pg8::f32x4 (&acc)[2][2][4][2], const pg8::Unit& u, int wr, int wc, int fr, int fq) const {
        int row0 = u.pm * 256 + wr * 64 + fr, col0 = u.pn * 256 + wc * 32 + 8 * fq;
        asm volatile("" : "+v"(row0), "+v"(col0));
#pragma unroll
        for (int ai = 0; ai < 2; ++ai)
#pragma unroll
            for (int m = 0; m < 4; ++m) {
                bf16_t* rowp = O + (size_t)(row0 + ai * 128 + m * 16) * ldc + col0;
#pragma unroll
                for (int bj = 0; bj < 2; ++bj) {
                    const pg8::f32x4 v0 = acc[ai][bj][m][0], v1 = acc[ai][bj][m][1];
                    u32x4 w; w.x = cvtpk(v0[0], v0[1]); w.y = cvtpk(v0[2], v0[3]); w.z = cvtpk(v1[0], v1[1]); w.w = cvtpk(v1[2], v1[3]);
                    *(u32x4*)(rowp + bj * 128) = w;
                }
            }
    }
};
struct EpiResid {
    static constexpr bool PERM = true, AFTER_DRAIN = false;
    const float* xp; const float* xs; float* out; int row_off; int self;
    __device__ __forceinline__ void operator()(const pg8::f32x4 (&acc)[2][2][4][2], const pg8::Unit& u, int wr, int wc, int fr, int fq) const {
        const int rowt = row_off + u.pm * 256;
        const float* rb = self ? (const float*)out + (size_t)rowt * DM : xrow_ptr(xp, xs, rowt);
        float* ob = out + (size_t)rowt * DM;
        int r0 = wr * 64 + fr, col0 = u.pn * 256 + wc * 32 + 8 * fq;
        asm volatile("" : "+v"(r0), "+v"(col0));
#pragma unroll
        for (int ai = 0; ai < 2; ++ai)
#pragma unroll
            for (int m = 0; m < 4; ++m) {
                const size_t ro = (size_t)(r0 + ai * 128 + m * 16) * DM + col0;
#pragma unroll
                for (int bj = 0; bj < 2; ++bj)
#pragma unroll
                    for (int n = 0; n < 2; ++n) {
                        const f32x4 r = *(const f32x4*)(rb + ro + bj * 128 + 4 * n);
                        const pg8::f32x4 a = acc[ai][bj][m][n];
                        f32x4 o; o[0] = r[0] + a[0]; o[1] = r[1] + a[1]; o[2] = r[2] + a[2]; o[3] = r[3] + a[3];
                        *(f32x4*)(ob + ro + bj * 128 + 4 * n) = o;
                    }
            }
    }
};

struct EpiResidB {
    static constexpr bool PERM = true, AFTER_DRAIN = false;
    const float* xp; const float* xs; bf16_t* X1B;
    __device__ __forceinline__ void operator()(const pg8::f32x4 (&acc)[2][2][4][2], const pg8::Unit& u, int wr, int wc, int fr, int fq) const {
        const int rowt = u.pm * 256;
        const float* rb = xrow_ptr(xp, xs, rowt);
        bf16_t* ob = X1B + (size_t)rowt * DM;
        int r0 = wr * 64 + fr, col0 = u.pn * 256 + wc * 32 + 8 * fq;
        asm volatile("" : "+v"(r0), "+v"(col0));
#pragma unroll
        for (int ai = 0; ai < 2; ++ai)
#pragma unroll
            for (int m = 0; m < 4; ++m) {
                const size_t ro = (size_t)(r0 + ai * 128 + m * 16) * DM + col0;
#pragma unroll
                for (int bj = 0; bj < 2; ++bj) {
                    const f32x4 ra = *(const f32x4*)(rb + ro + bj * 128), rc = *(const f32x4*)(rb + ro + bj * 128 + 4);
                    const pg8::f32x4 a = acc[ai][bj][m][0], c = acc[ai][bj][m][1];
                    u32x4 w; w.x = cvtpk(ra[0] + a[0], ra[1] + a[1]); w.y = cvtpk(ra[2] + a[2], ra[3] + a[3]); w.z = cvtpk(rc[0] + c[0], rc[1] + c[1]); w.w = cvtpk(rc[2] + c[2], rc[3] + c[3]);
                    *(u32x4*)(ob + ro + bj * 128) = w;
                }
            }
    }
};
struct EpiFinal {
    static constexpr bool PERM = true, AFTER_DRAIN = false;
    const bf16_t* X1B; float* out;
    __device__ __forceinline__ void operator()(const pg8::f32x4 (&acc)[2][2][4][2], const pg8::Unit& u, int wr, int wc, int fr, int fq) const {
        const int rowt = u.pm * 256;
        const bf16_t* rb = X1B + (size_t)rowt * DM;
        float* ob = out + (size_t)rowt * DM;
        int r0 = wr * 64 + fr, col0 = u.pn * 256 + wc * 32 + 8 * fq;
        asm volatile("" : "+v"(r0), "+v"(col0));
#pragma unroll
        for (int ai = 0; ai < 2; ++ai)
#pragma unroll
            for (int m = 0; m < 4; ++m) {
                const size_t ro = (size_t)(r0 + ai * 128 + m * 16) * DM + col0;
#pragma unroll
                for (int bj = 0; bj < 2; ++bj) {
                    const u32x4 r = *(const u32x4*)(rb + ro + bj * 128);
                    const pg8::f32x4 a = acc[ai][bj][m][0], c = acc[ai][bj][m][1];
                    f32x4 o0, o1;
                    o0[0] = bf_lo(r.x) + a[0]; o0[1] = bf_hi(r.x) + a[1]; o0[2] = bf_lo(r.y) + a[2]; o0[3] = bf_hi(r.y) + a[3];
                    o1[0] = bf_lo(r.z) + c[0]; o1[1] = bf_hi(r.z) + c[1]; o1[2] = bf_lo(r.w) + c[2]; o1[3] = bf_hi(r.w) + c[3];
                    *(f32x4*)(ob + ro + bj * 128) = o0; *(f32x4*)(ob + ro + bj * 128 + 4) = o1;
                }
            }
    }
};

#define DPP_SHR1 0x111
#define DPP_SHL1 0x101
#define DPP_ROR1 0x121
#define DPP_ROR15 0x12F
__device__ __forceinline__ float dppf(float old, float src, const int ctrl_sel) {
    int r;
    if (ctrl_sel == 0) r = __builtin_amdgcn_update_dpp(__float_as_int(old), __float_as_int(src), DPP_SHR1, 0xf, 0xf, false);
    else if (ctrl_sel == 1) r = __builtin_amdgcn_update_dpp(__float_as_int(old), __float_as_int(src), DPP_SHL1, 0xf, 0xf, false);
    else if (ctrl_sel == 2) r = __builtin_amdgcn_update_dpp(__float_as_int(old), __float_as_int(src), DPP_ROR1, 0xf, 0xf, false);
    else r = __builtin_amdgcn_update_dpp(__float_as_int(old), __float_as_int(src), DPP_ROR15, 0xf, 0xf, false);
    return __int_as_float(r);
}
struct EpiConvAct {
    static constexpr bool PERM = true, AFTER_DRAIN = false;
    bf16_t* ACT; const float* cw; const float* cb; PG8_LAS float* ex;
    __device__ __forceinline__ void operator()(const pg8::f32x4 (&acc)[2][2][4][2], const pg8::Unit& u, int wr, int wc, int fr, int fq) const {
        int seq = u.pm / 33, pt = u.pm % 33;
        asm volatile("" : "+s"(seq), "+s"(pt));
        const int t0 = 252 * pt - 1 + 126 * wr;
        int cl = wc * 32 + 8 * fq;
        asm volatile("" : "+v"(cl));
        const int chb = u.pn * 128 + cl;
#pragma unroll
        for (int n = 0; n < 2; ++n) {
            const int ch = chb + 4 * n;
            const f32x4 bg = *(const f32x4*)(cb + ch), bu = *(const f32x4*)(cb + DFF + ch);
            const f32x4 g0 = *(const f32x4*)(cw + ch), g1 = *(const f32x4*)(cw + DFF2 + ch), g2 = *(const f32x4*)(cw + 2 * DFF2 + ch);
            const f32x4 u0 = *(const f32x4*)(cw + DFF + ch), u1 = *(const f32x4*)(cw + DFF2 + DFF + ch), u2 = *(const f32x4*)(cw + 2 * DFF2 + DFF + ch);
#pragma unroll
            for (int ai = 0; ai < 2; ++ai) {
#pragma unroll
                for (int m = 0; m < 4; ++m) {
                    const int row = 64 * ai + 4 * fr + m, t = t0 + row;
                    const bool keep = (row >= 1) && (row <= 126) && (t < SEQL);
                    float o4[4];
#pragma unroll
                    for (int e = 0; e < 4; ++e) {
                        float cv[2];
#pragma unroll
                        for (int bj = 0; bj < 2; ++bj) {
                            const float X = acc[ai][bj][m][n][e];
                            float pv, nv;
                            if (m > 0) pv = acc[ai][bj][m > 0 ? m - 1 : 0][n][e];
                            else { const float ob = (ai == 1) ? dppf(0.f, acc[0][bj][3][n][e], 2) : 0.f; pv = dppf(ob, acc[ai][bj][3][n][e], 0); }
                            if (m < 3) nv = acc[ai][bj][m < 3 ? m + 1 : 3][n][e];
                            else { const float ob = (ai == 0) ? dppf(0.f, acc[1][bj][0][n][e], 3) : 0.f; nv = dppf(ob, acc[ai][bj][0][n][e], 1); }
                            if (m == 1) pv = (t == 0) ? 0.f : pv;
                            if (m == 2) nv = (t == SEQL - 1) ? 0.f : nv;
                            cv[bj] = bj == 0 ? bg[e] + g0[e] * pv + g1[e] * X + g2[e] * nv : bu[e] + u0[e] * pv + u1[e] * X + u2[e] * nv;
                        }
                        o4[e] = siluf(cv[0]) * cv[1];
                    }
                    if (keep) { u32x2 w; w.x = cvtpk(o4[0], o4[1]); w.y = cvtpk(o4[2], o4[3]); *(u32x2*)(ACT + ((size_t)seq * SEQL + t) * DFF + ch) = w; }
                }
            }
        }
    }
};

__device__ __forceinline__ void p0_transpose_item(const float* W, int K, int N, bf16_t* WT, LAS float* scr, int item, int lane, bool perm_up = false) {
    const int nblk = N / 32, kb = item / nblk, nb = item % nblk, k0 = 64 * kb, n0 = 32 * nb;
#pragma unroll 8
    for (int i = 0; i < 32; ++i) { const int kk = 2 * i + (lane >> 5); scr[kk * 33 + (lane & 31)] = W[(size_t)(k0 + kk) * N + n0 + (lane & 31)]; }
    asm volatile("s_waitcnt lgkmcnt(0)" ::: "memory");
    const int c = lane & 7;
#pragma unroll
    for (int j = 0; j < 4; ++j) { const int n = (lane >> 3) + 8 * j; const LAS float* s = scr + (8 * c) * 33 + n;
        u32x4 o; o.x = cvtpk(s[0 * 33], s[1 * 33]); o.y = cvtpk(s[2 * 33], s[3 * 33]); o.z = cvtpk(s[4 * 33], s[5 * 33]); o.w = cvtpk(s[6 * 33], s[7 * 33]);
        int nd = n0 + n; if (perm_up) { const int hf = nd / DFF, rr = nd - hf * DFF; nd = (rr >> 7) * 256 + hf * 128 + (rr & 127); }
        *(u32x4*)(WT + (size_t)nd * K + k0 + 8 * c) = o; }
    asm volatile("s_waitcnt lgkmcnt(0)" ::: "memory");
}
__device__ __forceinline__ void rms_row2_to_bf16(const float* xrow0, const float* xrow1, const float* w, bf16_t* orow0, bf16_t* orow1, int lane) {
    const f32x4* xr0 = (const f32x4*)xrow0 + lane; const f32x4* xr1 = (const f32x4*)xrow1 + lane; const f32x4* wr = (const f32x4*)w + lane;
    f32x4 v0[4], v1[4]; float s0 = 0.f, s1 = 0.f;
#pragma unroll
    for (int j = 0; j < 4; ++j) { v0[j] = xr0[64 * j]; v1[j] = xr1[64 * j]; }
#pragma unroll
    for (int j = 0; j < 4; ++j) { s0 += (v0[j][0] * v0[j][0] + v0[j][1] * v0[j][1]) + (v0[j][2] * v0[j][2] + v0[j][3] * v0[j][3]); s1 += (v1[j][0] * v1[j][0] + v1[j][1] * v1[j][1]) + (v1[j][2] * v1[j][2] + v1[j][3] * v1[j][3]); }
    const float r0 = __builtin_amdgcn_rsqf(wave_sum(s0) * (1.f / DM) + NORM_EPS), r1 = __builtin_amdgcn_rsqf(wave_sum(s1) * (1.f / DM) + NORM_EPS);
    u32x2* o0 = (u32x2*)orow0 + lane; u32x2* o1 = (u32x2*)orow1 + lane;
#pragma unroll
    for (int j = 0; j < 4; ++j) { const f32x4 ww = wr[64 * j]; u32x2 o;
        o.x = cvtpk(v0[j][0] * r0 * ww[0], v0[j][1] * r0 * ww[1]); o.y = cvtpk(v0[j][2] * r0 * ww[2], v0[j][3] * r0 * ww[3]); o0[64 * j] = o;
        o.x = cvtpk(v1[j][0] * r1 * ww[0], v1[j][1] * r1 * ww[1]); o.y = cvtpk(v1[j][2] * r1 * ww[2], v1[j][3] * r1 * ww[3]); o1[64 * j] = o; }
}
__device__ __forceinline__ void rms_rowb2_to_bf16(const bf16_t* xrow0, const bf16_t* xrow1, const float* w, bf16_t* orow0, bf16_t* orow1, int lane) {
    const u32x4 a0 = *((const u32x4*)xrow0 + lane), a1 = *((const u32x4*)xrow0 + 64 + lane), b0 = *((const u32x4*)xrow1 + lane), b1 = *((const u32x4*)xrow1 + 64 + lane);
    float va[16], vb[16]; float s0 = 0.f, s1 = 0.f;
#pragma unroll
    for (int e = 0; e < 4; ++e) { va[2 * e] = bf_lo(a0[e]); va[2 * e + 1] = bf_hi(a0[e]); va[8 + 2 * e] = bf_lo(a1[e]); va[8 + 2 * e + 1] = bf_hi(a1[e]);
        vb[2 * e] = bf_lo(b0[e]); vb[2 * e + 1] = bf_hi(b0[e]); vb[8 + 2 * e] = bf_lo(b1[e]); vb[8 + 2 * e + 1] = bf_hi(b1[e]); }
#pragma unroll
    for (int e = 0; e < 16; ++e) { s0 += va[e] * va[e]; s1 += vb[e] * vb[e]; }
    const float r0 = __builtin_amdgcn_rsqf(wave_sum(s0) * (1.f / DM) + NORM_EPS), r1 = __builtin_amdgcn_rsqf(wave_sum(s1) * (1.f / DM) + NORM_EPS);
    const f32x4 w0 = *((const f32x4*)w + 2 * lane), w1 = *((const f32x4*)w + 2 * lane + 1), w2 = *((const f32x4*)w + 128 + 2 * lane), w3 = *((const f32x4*)w + 128 + 2 * lane + 1);
    u32x4 o;
    o.x = cvtpk(va[0] * r0 * w0[0], va[1] * r0 * w0[1]); o.y = cvtpk(va[2] * r0 * w0[2], va[3] * r0 * w0[3]); o.z = cvtpk(va[4] * r0 * w1[0], va[5] * r0 * w1[1]); o.w = cvtpk(va[6] * r0 * w1[2], va[7] * r0 * w1[3]);
    *((u32x4*)orow0 + lane) = o;
    o.x = cvtpk(va[8] * r0 * w2[0], va[9] * r0 * w2[1]); o.y = cvtpk(va[10] * r0 * w2[2], va[11] * r0 * w2[3]); o.z = cvtpk(va[12] * r0 * w3[0], va[13] * r0 * w3[1]); o.w = cvtpk(va[14] * r0 * w3[2], va[15] * r0 * w3[3]);
    *((u32x4*)orow0 + 64 + lane) = o;
    o.x = cvtpk(vb[0] * r1 * w0[0], vb[1] * r1 * w0[1]); o.y = cvtpk(vb[2] * r1 * w0[2], vb[3] * r1 * w0[3]); o.z = cvtpk(vb[4] * r1 * w1[0], vb[5] * r1 * w1[1]); o.w = cvtpk(vb[6] * r1 * w1[2], vb[7] * r1 * w1[3]);
    *((u32x4*)orow1 + lane) = o;
    o.x = cvtpk(vb[8] * r1 * w2[0], vb[9] * r1 * w2[1]); o.y = cvtpk(vb[10] * r1 * w2[2], vb[11] * r1 * w2[3]); o.z = cvtpk(vb[12] * r1 * w3[0], vb[13] * r1 * w3[1]); o.w = cvtpk(vb[14] * r1 * w3[2], vb[15] * r1 * w3[3]);
    *((u32x4*)orow1 + 64 + lane) = o;
}

namespace att {
constexpr int KVBLK = 64, LDK = INW;
constexpr int SHM_V = KVBLK * 128 * 2, SHM_K = KVBLK * 128 * 2;
constexpr float THR2 = 11.5f;
#ifndef ATT_SDEPTH
#define ATT_SDEPTH 2
#endif
constexpr int SDEPTH = ATT_SDEPTH;
#define KSWZ(row, colB) ((row) * 256 + ((colB) ^ (((row) & 7) << 4)))
#define SBAR() __builtin_amdgcn_sched_barrier(0)
__device__ __forceinline__ int crow(int r, int hi) { return (r & 3) + 8 * (r >> 2) + 4 * hi; }
__device__ __forceinline__ unsigned cvtpkv(float lo, float hi) { unsigned r; asm volatile("v_cvt_pk_bf16_f32 %0, %1, %2" : "=v"(r) : "v"(lo), "v"(hi)); return r; }

__device__ __forceinline__ void partialSM(f32x16& p0, f32x16& p1, float dq, float c2) {
#pragma unroll
  for (int r = 0; r < 16; ++r) { p0[r] = fmaf(-c2, fabsf(dq - (float)((r & 3) + 8 * (r >> 2))), p0[r]); p1[r] = fmaf(-c2, fabsf(dq - (float)(32 + (r & 3) + 8 * (r >> 2))), p1[r]); }
#pragma unroll
  for (int r = 0; r < 16; ++r) p0[r] = __builtin_amdgcn_exp2f(p0[r]);
}
__device__ __forceinline__ void finishSM(f32x16& p0, f32x16& p1, float& l_reg, bf16x8& pa0, bf16x8& pa1, bf16x8& pa2, bf16x8& pa3) {
#pragma unroll
  for (int r = 0; r < 16; ++r) p1[r] = __builtin_amdgcn_exp2f(p1[r]);
  float ps = 0;
#pragma unroll
  for (int r = 0; r < 16; ++r) ps += p0[r];
#pragma unroll
  for (int r = 0; r < 16; ++r) ps += p1[r];
  { auto rr = __builtin_amdgcn_permlane32_swap(__float_as_uint(ps), __float_as_uint(ps), false, false);
    ps = __uint_as_float(rr[0]) + __uint_as_float(rr[1]); }
  l_reg += ps;
#define PK4(P, BASE, OUT) do { unsigned a0 = cvtpkv(P[BASE + 0], P[BASE + 1]), a1 = cvtpkv(P[BASE + 2], P[BASE + 3]);   \
    unsigned b0 = cvtpkv(P[BASE + 4], P[BASE + 5]), b1 = cvtpkv(P[BASE + 6], P[BASE + 7]);                              \
    auto r0 = __builtin_amdgcn_permlane32_swap(a0, b0, false, false); auto r1 = __builtin_amdgcn_permlane32_swap(a1, b1, false, false); \
    u32x4 w = {r0[0], r1[0], r0[1], r1[1]}; OUT = *reinterpret_cast<bf16x8*>(&w); } while (0)
  PK4(p0, 0, pa0); PK4(p0, 8, pa1); PK4(p1, 0, pa2); PK4(p1, 8, pa3);
#undef PK4
}
__device__ __forceinline__ void qkt(f32x16& p0, f32x16& p1, const char* Ks, const bf16x8* qr, int r32, int hi, int map) {
  p0 = f32x16{}; p1 = f32x16{};
#pragma unroll
  for (int d0 = 0; d0 < 4; ++d0) { const int cb = (map * 64 + d0 * 16 + hi * 8) * 2;
    bf16x8 b0 = *reinterpret_cast<const bf16x8*>(Ks + KSWZ(r32, cb));
    bf16x8 b1 = *reinterpret_cast<const bf16x8*>(Ks + KSWZ(32 + r32, cb));
    p0 = __builtin_amdgcn_mfma_f32_32x32x16_bf16(b0, qr[d0], p0, 0, 0, 0);
    p1 = __builtin_amdgcn_mfma_f32_32x32x16_bf16(b1, qr[d0], p1, 0, 0, 0); }
}
__device__ __forceinline__ int v_st(int k, int c) { const int kk = (k & ~0xC) | ((k & 4) << 1) | ((k & 8) >> 1); return ((kk >> 3) * 4 + (c >> 5)) * 512 + ((kk & 7) * 32 + (c & 31)) * 2; }
__device__ __forceinline__ int v_rd_base(int lane) { return ((lane & 3) << 3) | (((lane >> 2) & 3) << 6) | (((lane >> 4) & 1) << 5) | (((lane >> 5) & 1) << 8); }
constexpr int v_rd_off(int d0, int ks, int half) { return d0 * 512 + ks * 4096 + half * 2048; }
template <int OFF> __device__ __forceinline__ s16x4 tr_read(int vb) {
  s16x4 r; asm volatile("ds_read_b64_tr_b16 %0, %1 offset:%2" : "=&v"(r) : "v"(vb), "i"(OFF) : "memory"); return r;
}
template <int D0> __device__ __forceinline__ void pv_one(f32x16& od, int vb, bf16x8 pa0, bf16x8 pa1, bf16x8 pa2, bf16x8 pa3) {
#define PK(L, H) (bf16x8){L[0], L[1], L[2], L[3], H[0], H[1], H[2], H[3]}
  { const s16x4 l0 = tr_read<v_rd_off(D0, 0, 0)>(vb), h0 = tr_read<v_rd_off(D0, 0, 1)>(vb), l1 = tr_read<v_rd_off(D0, 1, 0)>(vb), h1 = tr_read<v_rd_off(D0, 1, 1)>(vb);
    asm volatile("s_waitcnt lgkmcnt(0)" ::: "memory"); SBAR();
    od = __builtin_amdgcn_mfma_f32_32x32x16_bf16(pa0, PK(l0, h0), od, 0, 0, 0);
    od = __builtin_amdgcn_mfma_f32_32x32x16_bf16(pa1, PK(l1, h1), od, 0, 0, 0); }
  { const s16x4 l2 = tr_read<v_rd_off(D0, 2, 0)>(vb), h2 = tr_read<v_rd_off(D0, 2, 1)>(vb), l3 = tr_read<v_rd_off(D0, 3, 0)>(vb), h3 = tr_read<v_rd_off(D0, 3, 1)>(vb);
    asm volatile("s_waitcnt lgkmcnt(0)" ::: "memory"); SBAR();
    od = __builtin_amdgcn_mfma_f32_32x32x16_bf16(pa2, PK(l2, h2), od, 0, 0, 0);
    od = __builtin_amdgcn_mfma_f32_32x32x16_bf16(pa3, PK(l3, h3), od, 0, 0, 0); }
#undef PK
}
__device__ __forceinline__ void pv_d0(f32x16* o, int vb, bf16x8 pa0, bf16x8 pa1, bf16x8 pa2, bf16x8 pa3) {
  pv_one<0>(o[0], vb, pa0, pa1, pa2, pa3); pv_one<1>(o[1], vb, pa0, pa1, pa2, pa3); pv_one<2>(o[2], vb, pa0, pa1, pa2, pa3); pv_one<3>(o[3], vb, pa0, pa1, pa2, pa3);
}

#define SM_CHUNK(c) do { _Pragma("unroll") for (int r = 2 * (c); r < 2 * (c) + 2; ++r) { \
    p0[r] = __builtin_amdgcn_exp2f(fmaf(-c2, fabsf(dq - (float)((r & 3) + 8 * (r >> 2))), p0[r])); p1[r] = fmaf(-c2, fabsf(dq - (float)(32 + (r & 3) + 8 * (r >> 2))), p1[r]); } } while (0)
#define RD4(X, D0, HF) do { X##0 = tr_read<v_rd_off(D0, 2 * (HF), 0)>(vb); X##1 = tr_read<v_rd_off(D0, 2 * (HF), 1)>(vb); X##2 = tr_read<v_rd_off(D0, 2 * (HF) + 1, 0)>(vb); X##3 = tr_read<v_rd_off(D0, 2 * (HF) + 1, 1)>(vb); } while (0)
#define PKV(L, H) (bf16x8){L[0], L[1], L[2], L[3], H[0], H[1], H[2], H[3]}
#define MM2(OD, X, PA, PB) do { OD = __builtin_amdgcn_mfma_f32_32x32x16_bf16(PA, PKV(X##0, X##1), OD, 0, 0, 0); OD = __builtin_amdgcn_mfma_f32_32x32x16_bf16(PB, PKV(X##2, X##3), OD, 0, 0, 0); } while (0)
#define WL4() asm volatile("s_waitcnt lgkmcnt(4)" ::: "memory")
__device__ __forceinline__ void pv_sm(f32x16* o, int vb, bf16x8 pa0, bf16x8 pa1, bf16x8 pa2, bf16x8 pa3, f32x16& p0, f32x16& p1, float dq, float c2) {
  s16x4 A0, A1, A2, A3, B0, B1, B2, B3;
  RD4(A, 0, 0);
  RD4(B, 1, 0); WL4(); SBAR(); MM2(o[0], A, pa0, pa1); SM_CHUNK(0); SBAR();
  RD4(A, 2, 0); WL4(); SBAR(); MM2(o[1], B, pa0, pa1); SM_CHUNK(1); SBAR();
  RD4(B, 3, 0); WL4(); SBAR(); MM2(o[2], A, pa0, pa1); SM_CHUNK(2); SBAR();
  RD4(A, 0, 1); WL4(); SBAR(); MM2(o[3], B, pa0, pa1); SM_CHUNK(3); SBAR();
  RD4(B, 1, 1); WL4(); SBAR(); MM2(o[0], A, pa2, pa3); SM_CHUNK(4); SBAR();
  RD4(A, 2, 1); WL4(); SBAR(); MM2(o[1], B, pa2, pa3); SM_CHUNK(5); SBAR();
  RD4(B, 3, 1); WL4(); SBAR(); MM2(o[2], A, pa2, pa3); SM_CHUNK(6); SBAR();
  asm volatile("s_waitcnt lgkmcnt(0)" ::: "memory"); SBAR(); MM2(o[3], B, pa2, pa3); SM_CHUNK(7); SBAR();
}
#undef SM_CHUNK
#undef RD4
#undef MM2
#undef WL4
#undef PKV

__device__ __forceinline__ void attn_unit(const bf16_t* __restrict__ P, bf16_t* __restrict__ MIX, const float* __restrict__ onw, float lam, int bh, int qb, int W, char* lds) {
  const int tid = threadIdx.x, wid = tid >> 6, lane = tid & 63, r32 = lane & 31, hi = lane >> 5;
  const int qg = wid & 3, map = wid >> 2, b = bh >> 2, h = bh & 3;
  const size_t tok0 = (size_t)b * SEQL; const int q0 = qb * 128;
  char* K_lds = lds; char* V_lds = lds + 3 * SHM_K;
  float* ws = (float*)(lds + 3 * SHM_V + 3 * SHM_K) + wid * 64; float* li_l = ws; float* al_l = ws + 32;
  const float c2 = LOG2E * (h == 0 ? 0.25f : h == 1 ? 0.0625f : h == 2 ? 0.015625f : 0.00390625f);
  const int qpos = q0 + qg * 32 + r32;
  float l_reg = 0; f32x16 o[4] = {}; bf16x8 qr[4];
  const int qbase = __builtin_amdgcn_readfirstlane(q0 + qg * 32);
  const bf16_t* Qw = P + (tok0 + qpos) * INW + h * 128 + map * 64 + hi * 8;
#pragma unroll
  for (int d0 = 0; d0 < 4; ++d0) qr[d0] = *reinterpret_cast<const bf16x8*>(Qw + d0 * 16);
  const bf16_t* Kh = P + tok0 * INW + 512 + h * 128; const bf16_t* Vh = P + tok0 * INW + 1024 + h * 128;
  const int sr = tid >> 4, sc = (tid & 15) * 8, vst0 = v_st(sr, sc), vst1 = v_st(32 + sr, sc);
  const int vb0 = (int)(uintptr_t)V_lds + v_rd_base(lane);
  struct { bf16x8 vs0, vs1, ks0, ks1; } sr_;
#define SLOAD(k0) do { sr_.vs0 = *(const bf16x8*)(&Vh[(size_t)((k0) + sr) * LDK + sc]); sr_.vs1 = *(const bf16x8*)(&Vh[(size_t)((k0) + 32 + sr) * LDK + sc]); \
    sr_.ks0 = *(const bf16x8*)(&Kh[(size_t)((k0) + sr) * LDK + sc]); sr_.ks1 = *(const bf16x8*)(&Kh[(size_t)((k0) + 32 + sr) * LDK + sc]); } while (0)
#define SWRITE(slot) do { *(bf16x8*)(V_lds + (slot) * SHM_V + vst0) = sr_.vs0;          \
    *(bf16x8*)(V_lds + (slot) * SHM_V + vst1) = sr_.vs1; const int kc = sc * 2;               \
    *(bf16x8*)(K_lds + (slot) * SHM_K + KSWZ(sr, kc)) = sr_.ks0;                       \
    *(bf16x8*)(K_lds + (slot) * SHM_K + KSWZ(32 + sr, kc)) = sr_.ks1; } while (0)
#define DQ(j) ((float)(qpos - (j) * KVBLK - 4 * hi))
  f32x16 pA0, pA1, pB0, pB1; bf16x8 pa0, pa1, pa2, pa3;
  int jlo = (q0 - W) / KVBLK; if (q0 - W < 0) jlo = 0;
  int jhi = (q0 + 127 + W) / KVBLK + 1; if (jhi > SEQL / KVBLK) jhi = SEQL / KVBLK;
  if ((jhi - jlo) & 1) { if (jhi < SEQL / KVBLK) ++jhi; else --jlo; }
  const int NT = jhi - jlo;
#define TK(i) ((jlo + (i)) * KVBLK)
  if (map == 1) __builtin_amdgcn_s_setprio(1);
  SLOAD(TK(0)); asm volatile("s_waitcnt vmcnt(0)" ::: "memory"); SWRITE(0);
  SLOAD(TK(1)); asm volatile("s_waitcnt vmcnt(0)" ::: "memory"); SWRITE(1);
  if (2 < NT) SLOAD(TK(2));
  __syncthreads();
  qkt(pA0, pA1, K_lds, qr, r32, hi, map); partialSM(pA0, pA1, DQ(jlo), c2);
  int sk = 1, sv = 0, sw = 2;
#define STEP(pC0, pC1, pP0, pP1, ii, more) do { \
    SBAR(); qkt(pC0, pC1, K_lds + sk * SHM_K, qr, r32, hi, map); \
    finishSM(pP0, pP1, l_reg, pa0, pa1, pa2, pa3); SBAR(); \
    asm volatile("s_waitcnt vmcnt(0)" ::: "memory"); SWRITE(sw); if (more) SLOAD(TK((ii) + 2)); SBAR(); \
    pv_sm(o, vb0 + sv * SHM_V, pa0, pa1, pa2, pa3, pC0, pC1, DQ(jlo + (ii)), c2); \
    __syncthreads(); \
    sv = sk; sk = sw; sw = (sw == 2) ? 0 : sw + 1; } while (0)
  for (int i = 1; i + 1 < NT; i += 2) {
    STEP(pB0, pB1, pA0, pA1, i, true);
    STEP(pA0, pA1, pB0, pB1, i + 1, (i + 3 < NT));
  }
  SBAR(); qkt(pB0, pB1, K_lds + sk * SHM_K, qr, r32, hi, map);
  finishSM(pA0, pA1, l_reg, pa0, pa1, pa2, pa3); SBAR();
  pv_sm(o, vb0 + sv * SHM_V, pa0, pa1, pa2, pa3, pB0, pB1, DQ(jlo + NT - 1), c2);
  finishSM(pB0, pB1, l_reg, pa0, pa1, pa2, pa3); SBAR();
  pv_d0(o, vb0 + sk * SHM_V, pa0, pa1, pa2, pa3);
#undef STEP
#undef TK
  __builtin_amdgcn_s_setprio(0);
  if (hi == 0) li_l[r32] = l_reg; asm volatile("s_waitcnt lgkmcnt(0)" ::: "memory");
  float rli[16];
#pragma unroll
  for (int r = 0; r < 16; ++r) rli[r] = __builtin_amdgcn_rcpf(li_l[crow(r, hi)]);
  __syncthreads();
  float* X = (float*)lds + qg * 4096;
  if (map == 1) {
#pragma unroll
    for (int r = 0; r < 16; ++r) { const float s = rli[r] * lam;
#pragma unroll
      for (int d0 = 0; d0 < 4; ++d0) X[crow(r, hi) * 128 + d0 * 32 + r32] = o[d0][r] * s; }
  }
  __syncthreads();
  if (map == 0) {
#pragma unroll
    for (int r = 0; r < 16; ++r) { float ss = 0.f;
#pragma unroll
      for (int d0 = 0; d0 < 4; ++d0) { const int ix = crow(r, hi) * 128 + d0 * 32 + r32; const float v = o[d0][r] * rli[r] - X[ix]; X[ix] = v; ss += v * v; }
#pragma unroll
      for (int of = 1; of < 32; of <<= 1) ss += __shfl_xor(ss, of);
      if (r32 == 0) al_l[crow(r, hi)] = __builtin_amdgcn_rsqf(ss * (1.f / 128.f) + NORM_EPS) * 0.8f;
    }
    asm volatile("s_waitcnt lgkmcnt(0)" ::: "memory");
    const int cc = lane & 15;
    float wv[8];
#pragma unroll
    for (int e = 0; e < 8; ++e) wv[e] = onw[cc * 8 + e];
    bf16_t* Ob = MIX + (tok0 + q0 + qg * 32 + (lane >> 4)) * DM + h * 128 + cc * 8;
    const float* Xr = X + (lane >> 4) * 128 + cc * 8;
#pragma unroll
    for (int it = 0; it < 8; ++it) {
      const f32x4 x0 = *(const f32x4*)(Xr + it * 512), x1 = *(const f32x4*)(Xr + it * 512 + 4); const float rs = al_l[it * 4 + (lane >> 4)];
      u32x4 w; w.x = cvtpk(x0[0] * rs * wv[0], x0[1] * rs * wv[1]); w.y = cvtpk(x0[2] * rs * wv[2], x0[3] * rs * wv[3]);
      w.z = cvtpk(x1[0] * rs * wv[4], x1[1] * rs * wv[5]); w.w = cvtpk(x1[2] * rs * wv[6], x1[3] * rs * wv[7]);
      *(u32x4*)(Ob + (size_t)it * 4 * DM) = w;
    }
  }
  __syncthreads();
#undef SLOAD
#undef SWRITE
#undef DQ
#undef REL
}
}

namespace rec {
constexpr int CH = 32, NCH = SEQL / CH, QP = 136, SP = 40;
constexpr int OFF_QT = 0, OFF_KH = CH * QP * 2, OFF_KT = 2 * CH * QP * 2, OFF_VT = OFF_KT + 128 * SP * 2, OFF_DD = OFF_VT + 128 * SP * 2, OFF_TOT = OFF_DD + 512, DIRB = OFF_TOT + 2048;
static_assert(DIRB % 16 == 0 && 2 * DIRB <= 131072, "rec LDS map");
__device__ __forceinline__ int crow(int r, int hi) { return (r & 3) + 8 * (r >> 2) + 4 * hi; }
__device__ __forceinline__ bf16x8 pack8(float a0, float a1, float a2, float a3, float a4, float a5, float a6, float a7) {
  u32x4 w = {cvtpk(a0, a1), cvtpk(a2, a3), cvtpk(a4, a5), cvtpk(a6, a7)}; return *reinterpret_cast<bf16x8*>(&w);
}
__device__ __forceinline__ void rec_unit(const bf16_t* __restrict__ P, bf16_t* __restrict__ OF, bf16_t* __restrict__ OB, int bh, unsigned char* ldsg) {
  const int tid = threadIdx.x, wid = __builtin_amdgcn_readfirstlane(tid >> 6), lane = tid & 63, r32 = lane & 31, hi = lane >> 5;
  const int dir = wid >> 2, wv = wid & 3, b = bh >> 2, h = bh & 3;
  unsigned char* lb = ldsg + dir * DIRB;
  bf16_t* Qt = (bf16_t*)(lb + OFF_QT); bf16_t* Kh = (bf16_t*)(lb + OFF_KH); bf16_t* KtT = (bf16_t*)(lb + OFF_KT); bf16_t* VT = (bf16_t*)(lb + OFF_VT);
  float* dd = (float*)(lb + OFF_DD); float* tot = (float*)(lb + OFF_TOT);
  const bf16_t* base = P + (size_t)b * SEQL * INW;
  const int cq = 1536 + h * 128 + 2 * lane, cgt = (dir ? 2560 : 2048) + h * 128 + 2 * lane, cv = 3072 + h * 128 + 2 * lane;
  bf16_t* O = (dir ? OB : OF) + (size_t)b * SEQL * 512 + h * 128 + wv * 32 + r32;
  f32x16 S[4];
#pragma unroll
  for (int k = 0; k < 4; ++k) S[k] = f32x16{};
  unsigned pq[8], pg[8], pv[8];
#define TOKOF(s) (dir ? (SEQL - 1 - (s)) : (s))
#define LOADCHUNK(c) do { _Pragma("unroll") for (int i = 0; i < 8; ++i) { const bf16_t* rp = base + (size_t)TOKOF((c) * CH + wv * 8 + i) * INW; \
    pq[i] = *(const unsigned*)(rp + cq); pg[i] = *(const unsigned*)(rp + cgt); pv[i] = *(const unsigned*)(rp + cv); } } while (0)
  LOADCHUNK(0);
#define RBAR() asm volatile("s_waitcnt lgkmcnt(0)\n\ts_barrier" ::: "memory")
  if (dir == 1) { RBAR(); RBAR(); }
  for (int c = 0; c < NCH; ++c) {
    float gl0[8], gl1[8]; float G0 = 0.f, G1 = 0.f;
#pragma unroll
    for (int i = 0; i < 8; ++i) { G0 += bf_lo(pg[i]); G1 += bf_hi(pg[i]); gl0[i] = G0; gl1[i] = G1; }
    *(f32x2*)&tot[wv * 128 + 2 * lane] = (f32x2){G0, G1};
    RBAR();
    float P0 = 0.f, P1 = 0.f, C0 = 0.f, C1 = 0.f;
#pragma unroll
    for (int w = 0; w < 4; ++w) { const f32x2 t = *(const f32x2*)&tot[w * 128 + 2 * lane]; if (w < wv) { P0 += t[0]; P1 += t[1]; } C0 += t[0]; C1 += t[1]; }
    float kta[8], ktb[8];
#pragma unroll
    for (int i = 0; i < 8; ++i) {
      const float Ga = P0 + gl0[i], Gb = P1 + gl1[i];
      const float kfa = 1.f - ex2(bf_lo(pg[i])), kfb = 1.f - ex2(bf_hi(pg[i]));
      *(unsigned*)&Qt[(wv * 8 + i) * QP + 2 * lane] = cvtpk(bf_lo(pq[i]) * ex2(Ga), bf_hi(pq[i]) * ex2(Gb));
      *(unsigned*)&Kh[(wv * 8 + i) * QP + 2 * lane] = cvtpk(kfa * ex2(fminf(-Ga, 100.f)), kfb * ex2(fminf(-Gb, 100.f)));
      kta[i] = kfa * ex2(C0 - Ga); ktb[i] = kfb * ex2(C1 - Gb);
    }
    *(bf16x8*)&KtT[(2 * lane) * SP + wv * 8] = pack8(kta[0], kta[1], kta[2], kta[3], kta[4], kta[5], kta[6], kta[7]);
    *(bf16x8*)&KtT[(2 * lane + 1) * SP + wv * 8] = pack8(ktb[0], ktb[1], ktb[2], ktb[3], ktb[4], ktb[5], ktb[6], ktb[7]);
    { u32x4 a, bb;
      a.x = (pv[0] & 0xffffu) | (pv[1] << 16); a.y = (pv[2] & 0xffffu) | (pv[3] << 16); a.z = (pv[4] & 0xffffu) | (pv[5] << 16); a.w = (pv[6] & 0xffffu) | (pv[7] << 16);
      bb.x = (pv[0] >> 16) | (pv[1] & 0xffff0000u); bb.y = (pv[2] >> 16) | (pv[3] & 0xffff0000u); bb.z = (pv[4] >> 16) | (pv[5] & 0xffff0000u); bb.w = (pv[6] >> 16) | (pv[7] & 0xffff0000u);
      *(u32x4*)&VT[(2 * lane) * SP + wv * 8] = a; *(u32x4*)&VT[(2 * lane + 1) * SP + wv * 8] = bb; }
    if (wv == 0) *(f32x2*)&dd[2 * lane] = (f32x2){ex2(C0), ex2(C1)};
    if (c + 1 < NCH) LOADCHUNK(c + 1);
    RBAR();
    f32x16 aT = f32x16{};
#pragma unroll
    for (int ks = 0; ks < 8; ++ks) { const bf16x8 a = *(const bf16x8*)&Kh[r32 * QP + ks * 16 + hi * 8]; const bf16x8 bq = *(const bf16x8*)&Qt[r32 * QP + ks * 16 + hi * 8];
      aT = __builtin_amdgcn_mfma_f32_32x32x16_bf16(a, bq, aT, 0, 0, 0); }
#pragma unroll
    for (int r = 0; r < 16; ++r) if (crow(r, hi) > r32) aT[r] = 0.f;
    f32x16 o = f32x16{};
#pragma unroll
    for (int kt = 0; kt < 4; ++kt)
#pragma unroll
      for (int hh = 0; hh < 2; ++hh) {
        const s16x4 lo4 = *(const s16x4*)&Qt[r32 * QP + kt * 32 + hh * 16 + hi * 4], hi4 = *(const s16x4*)&Qt[r32 * QP + kt * 32 + hh * 16 + 8 + hi * 4];
        const bf16x8 a = {lo4[0], lo4[1], lo4[2], lo4[3], hi4[0], hi4[1], hi4[2], hi4[3]};
        const bf16x8 bs = pack8(S[kt][hh * 8 + 0], S[kt][hh * 8 + 1], S[kt][hh * 8 + 2], S[kt][hh * 8 + 3], S[kt][hh * 8 + 4], S[kt][hh * 8 + 5], S[kt][hh * 8 + 6], S[kt][hh * 8 + 7]);
        o = __builtin_amdgcn_mfma_f32_32x32x16_bf16(a, bs, o, 0, 0, 0);
      }
#pragma unroll
    for (int hh = 0; hh < 2; ++hh) {
      const bf16x8 a = pack8(aT[hh * 8 + 0], aT[hh * 8 + 1], aT[hh * 8 + 2], aT[hh * 8 + 3], aT[hh * 8 + 4], aT[hh * 8 + 5], aT[hh * 8 + 6], aT[hh * 8 + 7]);
      const s16x4 lo4 = *(const s16x4*)&VT[(wv * 32 + r32) * SP + hh * 16 + hi * 4], hi4 = *(const s16x4*)&VT[(wv * 32 + r32) * SP + hh * 16 + 8 + hi * 4];
      const bf16x8 bv = {lo4[0], lo4[1], lo4[2], lo4[3], hi4[0], hi4[1], hi4[2], hi4[3]};
      o = __builtin_amdgcn_mfma_f32_32x32x16_bf16(a, bv, o, 0, 0, 0);
    }
    RBAR();
#pragma unroll
    for (int kt = 0; kt < 4; ++kt) {
#pragma unroll
      for (int q4 = 0; q4 < 4; ++q4) { const f32x4 d4 = *(const f32x4*)&dd[kt * 32 + q4 * 8 + hi * 4];
#pragma unroll
        for (int j = 0; j < 4; ++j) S[kt][q4 * 4 + j] *= d4[j]; }
#pragma unroll
      for (int ks = 0; ks < 2; ++ks) { const bf16x8 a = *(const bf16x8*)&KtT[(kt * 32 + r32) * SP + ks * 16 + hi * 8]; const bf16x8 bv = *(const bf16x8*)&VT[(wv * 32 + r32) * SP + ks * 16 + hi * 8];
        S[kt] = __builtin_amdgcn_mfma_f32_32x32x16_bf16(a, bv, S[kt], 0, 0, 0); }
    }
#pragma unroll
    for (int r = 0; r < 16; ++r) { const int tk = TOKOF(c * CH + crow(r, hi)); O[(size_t)tk * 512] = (bf16_t)(cvtpk(o[r], 0.f) & 0xffffu); }
    RBAR();
  }
  if (dir == 0) { RBAR(); RBAR(); }
  __syncthreads();
#undef RBAR
#undef TOKOF
#undef LOADCHUNK
}
}

#define XB_TMO      128
#define XB_XCNT(j)  (256  + 64 * (j))
#define XB_XSUB(j)  (1280 + 64 * (j))
#define XB_XGEN(j)  (2304 + 64 * (j))
#define XB_TOP      3328
#define XB_TOPGEN   3392
#define XCD_BAR_WORDS 3456
#define XB_SPIN_CAP (1u << 18)

__device__ __forceinline__ unsigned xb_ld(unsigned* p)              { return __hip_atomic_load(p, __ATOMIC_RELAXED, __HIP_MEMORY_SCOPE_AGENT); }
__device__ __forceinline__ unsigned xb_add(unsigned* p, unsigned v) { return __hip_atomic_fetch_add(p, v, __ATOMIC_RELAXED, __HIP_MEMORY_SCOPE_AGENT); }
__device__ __forceinline__ unsigned xb_xcc_id() { return (unsigned)__builtin_amdgcn_s_getreg((3 << 11) | 20) & 0xFu; }
#define XB_SPIN(cond, bar) do { unsigned _sp = 0; while (cond) { __builtin_amdgcn_s_sleep(1); \
    if ((++_sp & 255u) == 0u) { if (xb_ld(&(bar)[XB_TMO])) break; if (_sp > XB_SPIN_CAP) { atomicAdd(&(bar)[XB_TMO], 1u); break; } } } } while (0)

struct XcdBarrier {
    unsigned* bar; unsigned x;
    volatile LAS unsigned* st;
};

__device__ __forceinline__ XcdBarrier xcd_barrier_post(unsigned* bar, volatile LAS unsigned* st) {
    XcdBarrier b; b.bar = bar; b.x = xb_xcc_id(); b.st = st;
    if (threadIdx.x == 0) (void)xb_add(&bar[XB_XCNT(b.x)], 1u);
    return b;
}
__device__ __forceinline__ void xcd_barrier_complete(unsigned* bar, unsigned x, unsigned& nloc, unsigned& nx) {
    const unsigned G = gridDim.x * gridDim.y * gridDim.z;
    unsigned sum, cnt, mine, sp = 0u;
    for (;;) {
        sum = 0u; cnt = 0u; mine = 0u;
#pragma unroll
        for (unsigned j = 0; j < 16; ++j) { const unsigned c = xb_ld(&bar[XB_XCNT(j)]); sum += c; cnt += (c > 0u) ? 1u : 0u; mine = (j == x) ? c : mine; }
        if (sum == G) break;
        __builtin_amdgcn_s_sleep(1);
        if ((++sp & 255u) == 0u) { if (xb_ld(&bar[XB_TMO])) break; if (sp > XB_SPIN_CAP) { atomicAdd(&bar[XB_TMO], 1u); break; } }
    }
    nloc = mine > 0u ? mine : 1u; nx = cnt > 0u ? cnt : 1u;
}

__device__ __forceinline__ void xcd_barrier(const XcdBarrier& b) {
    asm volatile("s_waitcnt vmcnt(0)" ::: "memory");
    __syncthreads();
    if (threadIdx.x == 0) {
        unsigned* bar = b.bar;
        __builtin_amdgcn_s_waitcnt(0);
        unsigned nloc = b.st[0], nx = b.st[1];
        if (nloc == 0u) { xcd_barrier_complete(bar, b.x, nloc, nx); b.st[0] = nloc; b.st[1] = nx; }
        const unsigned old = xb_add(&bar[XB_XSUB(b.x)], 1u);
        const unsigned gen = old / nloc;
        if (old + 1u == (gen + 1u) * nloc) {
            __builtin_amdgcn_fence(__ATOMIC_RELEASE, "agent");
            asm volatile("s_waitcnt vmcnt(0)" ::: "memory");
            const unsigned og = xb_add(&bar[XB_TOP], 1u);
            const unsigned tg = og / nx;
            if (og + 1u == (tg + 1u) * nx) xb_add(&bar[XB_TOPGEN], 1u);
            else XB_SPIN(xb_ld(&bar[XB_TOPGEN]) == tg, bar);
            __builtin_amdgcn_fence(__ATOMIC_ACQUIRE, "agent");
            xb_add(&bar[XB_XGEN(b.x)], 1u);
            asm volatile("s_waitcnt vmcnt(0)" ::: "memory");
        } else {
            XB_SPIN(xb_ld(&bar[XB_XGEN(b.x)]) == gen, bar);
            __builtin_amdgcn_fence(__ATOMIC_ACQUIRE, "agent");
            asm volatile("s_waitcnt vmcnt(0)" ::: "memory");
        }
    }
    __syncthreads();
}

struct Args { const float* in[20]; float* out; unsigned char* ws; int ph_lo, ph_hi; };
constexpr int NPH = 9;
constexpr int N_ATT_UNITS = NSEQ * NHEAD * (SEQL / 128), N_REC_UNITS = NSEQ * NHEAD;

__global__ void __launch_bounds__(512, 2) fwd_kernel(Args args) {
    extern __shared__ __attribute__((aligned(16))) unsigned char lds[];
    cg::grid_group grid = cg::this_grid();
    const int wave = __builtin_amdgcn_readfirstlane((int)threadIdx.x >> 6);
#define PHASE_IDS int tid = threadIdx.x; asm volatile("" : "+v"(tid)); const int lane = tid & 63; (void)lane;
    const int G = gridDim.x, gw = blockIdx.x * 8 + wave, NGW = G * 8;
    unsigned char* ws = args.ws;
    const float* xp = args.in[0]; const float* xs = args.in[1];
    bf16_t* W_in = (bf16_t*)(ws + WS_WIN); bf16_t* W_out = (bf16_t*)(ws + WS_WOUT); bf16_t* W_up = (bf16_t*)(ws + WS_WUP); bf16_t* W_down = (bf16_t*)(ws + WS_WDOWN);
    bf16_t* XN = (bf16_t*)(ws + WS_XN); bf16_t* PROJ = (bf16_t*)(ws + WS_PROJ); bf16_t* OFb = (bf16_t*)(ws + WS_OF); bf16_t* OBb = (bf16_t*)(ws + WS_OB);
    bf16_t* ACT = (bf16_t*)(ws + WS_ACT); bf16_t* X1B = (bf16_t*)(ws + WS_OF);
    unsigned* ctl = (unsigned*)(ws + WS_CTL);
    PG8_LAS unsigned char* ldsl = (PG8_LAS unsigned char*)lds;
    const int lo = args.ph_lo, hi = args.ph_hi;
    volatile LAS unsigned* xst = (volatile LAS unsigned*)(ldsl + LDS_MISC + 64);
    if (threadIdx.x < 2) xst[threadIdx.x] = 0u;
    __syncthreads();
    XcdBarrier xbar; xbar.bar = ctl + 4096; xbar.x = 0; xbar.st = xst;
#ifndef PHMASK
#define PHMASK 0xffff
#endif
#define IN(k) (((PHMASK >> (k)) & 1) && lo <= (k) && (k) < hi)
#define SEAM(k) do { if (IN(k) && IN((k) + 1)) { if ((k) == 0) grid.sync(); else xcd_barrier(xbar); } } while (0)
#ifndef REPEAT_PH
#define REPEAT_PH -1
#endif
#define NREP(k) ((REPEAT_PH == (k)) ? 2 : 1)

    if (IN(0)) {
        PHASE_IDS
        if (blockIdx.x == 0) for (int i = tid; i < 8192; i += 512) ctl[i] = 0u;
        LAS float* scr = (LAS float*)(ldsl + wave * 16384);
        constexpr int I_IN = (DM / 64) * (INW / 32), I_OUT = (DM / 64) * (DM / 32), I_UP = (DM / 64) * (DFF2 / 32), I_DOWN = (DFF / 64) * (DM / 32);
        for (int it = gw; it < I_IN + I_OUT + I_UP + I_DOWN; it += NGW) {
            int r = it;
            if (r < I_IN) { p0_transpose_item(args.in[3], DM, INW, W_in, scr, r, lane); continue; } r -= I_IN;
            if (r < I_OUT) { p0_transpose_item(args.in[14], DM, DM, W_out, scr, r, lane); continue; } r -= I_OUT;
            if (r < I_UP) { p0_transpose_item(args.in[16], DM, DFF2, W_up, scr, r, lane, true); continue; } r -= I_UP;
            p0_transpose_item(args.in[19], DFF, DM, W_down, scr, r, lane);
        }
        for (int m = gw * 2; m < MTOK; m += NGW * 2) rms_row2_to_bf16(xrow_ptr(xp, xs, m), xrow_ptr(xp, xs, m + 1), args.in[2], XN + (size_t)m * DM, XN + (size_t)(m + 1) * DM, lane);
    }
    SEAM(0);
    if (IN(0) && IN(1)) xbar = xcd_barrier_post(ctl + 4096, xst);
    for (int rep = 0; rep < NREP(1); ++rep) { if (rep) grid.sync();
    if (IN(1)) {
        pg8::Gemm g{XN, W_in, MTOK, INW, DM}; pg8::StaticOrder S; S.init(MTOK, INW, G, (int)blockIdx.x);
        EpiInProj E{PROJ, args.in[11], args.in[12], args.in[4], args.in[5], (PG8_LAS float*)(ldsl + 131072)};
        pg8::gemm_phase<EpiInProj, pg8::StaticOrder, true, true>(ldsl, g, S, E);
    } }
    SEAM(1);
    for (int rep = 0; rep < NREP(3); ++rep) { if (rep) grid.sync();
    if (IN(3)) {
        PHASE_IDS
        float lam; int Wh[4];
        { const float a = args.in[6][lane] * args.in[7][lane], b = args.in[8][lane] * args.in[9][lane];
          lam = ex2(wave_sum(a) * LOG2E) - ex2(wave_sum(b) * LOG2E) + 0.2f;
          float mq = fabsf(args.in[4][lane]), mk = fabsf(args.in[5][lane]);
#pragma unroll
          for (int o = 1; o < 64; o <<= 1) { mq = fmaxf(mq, __shfl_xor(mq, o)); mk = fmaxf(mk, __shfl_xor(mk, o)); }
          const float S2 = 8.f * LOG2E * 1.01f * 1.01f * mq * mk;
#pragma unroll
          for (int h = 0; h < 4; ++h) { const float c2h = LOG2E * (h == 0 ? 0.25f : h == 1 ? 0.0625f : h == 2 ? 0.015625f : 0.00390625f);
            const float need = 2.f * S2 + 30.f + lg2(2.f / (1.f - ex2(-c2h)));
            const float wf = need / c2h; Wh[h] = wf >= (float)SEQL ? SEQL : (int)wf + 1; } }
#ifndef NO_REC
#ifndef REC_REPS
#define REC_REPS 1
#endif
        for (int rr2 = 0; rr2 < REC_REPS; ++rr2)
        for (int u = blockIdx.x; u < N_REC_UNITS; u += G) rec::rec_unit(PROJ, OFb, OBb, u, lds);
#endif
        volatile int* misc = (volatile int*)(lds + LDS_MISC);
        int myq = (int)(__builtin_amdgcn_s_getreg((3 << 11) | 20) & 7u);
        constexpr int QN = 320;
        for (int tries = 0; tries < 8;) {
            if (tid == 0) misc[0] = (int)atomicAdd(ctl + 64 + 32 * myq, 1u);
            __syncthreads();
            const int t = __builtin_amdgcn_readfirstlane(misc[0]);
            __syncthreads();
            if (t >= QN) { myq = (myq + 1) & 7; ++tries; continue; }
            int b, hh, qb;
            { int i2 = t, base = 0; hh = 3;
              for (int seg = 0; seg < 4; ++seg) { if (i2 < 64) { b = myq; qb = i2; hh = 3 - seg; base = 1; break; } i2 -= 64; if (i2 < 16) { b = 8 + (i2 >> 3); qb = 8 * myq + (i2 & 7); hh = 3 - seg; base = 1; break; } i2 -= 16; }
              (void)base; }
#ifndef NO_ATT
            att::attn_unit(PROJ, XN, args.in[10], lam, b * 4 + hh, qb, hh == 0 ? Wh[0] : hh == 1 ? Wh[1] : hh == 2 ? Wh[2] : Wh[3], (char*)lds);
#endif
        }
    } }
    SEAM(3);
    for (int rep = 0; rep < NREP(4); ++rep) { if (rep) grid.sync();
    if (IN(4)) {
        PHASE_IDS
        const int h4 = lane >> 4, c8 = (lane & 15) * 8;
        float w8[8];
#pragma unroll
        for (int e = 0; e < 8; ++e) w8[e] = args.in[13][c8 + e];
        for (int m0 = gw * 4; m0 < MTOK; m0 += NGW * 4) {
            u32x4 fa[4], fb[4], fg[4];
#pragma unroll
            for (int u = 0; u < 4; ++u) { const size_t m = m0 + u;
                fa[u] = *(const u32x4*)(OFb + m * 512 + h4 * 128 + c8); fb[u] = *(const u32x4*)(OBb + m * 512 + h4 * 128 + c8); fg[u] = *(const u32x4*)(PROJ + m * INW + 3584 + h4 * 128 + c8); }
#pragma unroll
            for (int u = 0; u < 4; ++u) {
                float v[8]; float sq = 0.f;
#pragma unroll
                for (int e = 0; e < 4; ++e) { v[2 * e] = bf_lo(fa[u][e]) + bf_lo(fb[u][e]); v[2 * e + 1] = bf_hi(fa[u][e]) + bf_hi(fb[u][e]); sq += v[2 * e] * v[2 * e] + v[2 * e + 1] * v[2 * e + 1]; }
                sq += __shfl_xor(sq, 1); sq += __shfl_xor(sq, 2); sq += __shfl_xor(sq, 4); sq += __shfl_xor(sq, 8);
                const float rs = __builtin_amdgcn_rsqf(sq * (1.f / 128.f) + NORM_EPS);
                u32x4 o;
#pragma unroll
                for (int e = 0; e < 4; ++e) o[e] = cvtpk(v[2 * e] * rs * w8[2 * e] * bf_lo(fg[u][e]), v[2 * e + 1] * rs * w8[2 * e + 1] * bf_hi(fg[u][e]));
                *(u32x4*)(XN + (size_t)(m0 + u) * DM + 512 + h4 * 128 + c8) = o;
            }
        }
    }
    }
    SEAM(4);
    for (int rep = 0; rep < NREP(5); ++rep) { if (rep) grid.sync();
    if (IN(5)) {
        pg8::Gemm g{XN, W_out, MTOK, DM, DM}; pg8::StaticOrder S; S.init(MTOK, DM, G, (int)blockIdx.x);
        EpiResidB E{xp, xs, X1B};
        pg8::gemm_phase<EpiResidB, pg8::StaticOrder, true, true>(ldsl, g, S, E);
    }
    }
    SEAM(5);
    for (int rep = 0; rep < NREP(6); ++rep) { if (rep) grid.sync();
    if (IN(6)) {
        PHASE_IDS
        for (int m = gw * 2; m < MTOK; m += NGW * 2) rms_rowb2_to_bf16(X1B + (size_t)m * DM, X1B + (size_t)(m + 1) * DM, args.in[15], XN + (size_t)m * DM, XN + (size_t)(m + 1) * DM, lane);
    }
    }
    SEAM(6);
    for (int rep = 0; rep < NREP(7); ++rep) { if (rep) grid.sync();
    if (IN(7)) {
        pg8::Gemm g{XN, W_up, NSEQ * 33 * 256, DFF2, DM}; pg8::StaticOrder S; S.init(NSEQ * 33 * 256, DFF2, G, (int)blockIdx.x); S.ovl = 1;
        EpiConvAct E{ACT, args.in[17], args.in[18], (PG8_LAS float*)(ldsl + 131072)};
        pg8::gemm_phase<EpiConvAct, pg8::StaticOrder, true, true>(ldsl, g, S, E);
    } }
    SEAM(7);
    if (IN(8)) {
        pg8::Gemm g{ACT, W_down, MTOK, DM, DFF}; pg8::StaticOrder S; S.init(MTOK, DM, G, (int)blockIdx.x);
        EpiFinal E{X1B, args.out};
        pg8::gemm_phase<EpiFinal, pg8::StaticOrder, true, true>(ldsl, g, S, E);
    }
#undef IN
#undef SEAM
}

#ifndef ONE_LAUNCH
#define ONE_LAUNCH 1
#endif
extern "C" void kernel_launch(void* const* d_in, const int* in_sizes, int n_in, void* d_out, int out_size, void* d_ws, size_t ws_size, hipStream_t stream) {
    static int grid = 0;
    if (grid == 0) {
        if (n_in != 20 || out_size != MTOK * DM || ws_size < WS_END) { fprintf(stderr, "kernel_launch: unexpected shapes n_in %d out %d ws %zu (need %zu)\n", n_in, out_size, ws_size, (size_t)WS_END); grid = -1; return; }
        int dev = 0, cus = 0, per_cu = 0;
        (void)hipGetDevice(&dev); (void)hipDeviceGetAttribute(&cus, hipDeviceAttributeMultiprocessorCount, dev);
        if (hipFuncSetAttribute((const void*)fwd_kernel, hipFuncAttributeMaxDynamicSharedMemorySize, LDS_BYTES) != hipSuccess) { fprintf(stderr, "kernel_launch: hipFuncSetAttribute failed\n"); grid = -1; return; }
        (void)hipOccupancyMaxActiveBlocksPerMultiprocessor(&per_cu, (const void*)fwd_kernel, 512, LDS_BYTES);
        if (per_cu < 1) { fprintf(stderr, "kernel_launch: occupancy query says %d\n", per_cu); per_cu = 1; }
        (void)hipGetLastError();
        grid = cus * per_cu;
    }
    if (grid < 0) return;
#if !ONE_LAUNCH
    (void)hipMemsetAsync((char*)d_ws + WS_CTL, 0, 32768, stream);
#endif
    Args a{};
    for (int i = 0; i < 20; ++i) a.in[i] = (const float*)d_in[i];
    a.out = (float*)d_out; a.ws = (unsigned char*)d_ws;
#if ONE_LAUNCH
    a.ph_lo = 0; a.ph_hi = NPH;
    void* kargs[] = {&a};
    hipError_t e = hipLaunchCooperativeKernel((const void*)fwd_kernel, dim3(grid), dim3(512), kargs, LDS_BYTES, stream);
    if (e != hipSuccess) fprintf(stderr, "cooperative launch failed: %s (grid %d)\n", hipGetErrorString(e), grid);
#else
    for (int p = 0; p < NPH; ++p) {
        a.ph_lo = p; a.ph_hi = p + 1;
        hipLaunchKernelGGL(fwd_kernel, dim3(grid), dim3(512), LDS_BYTES, stream, a);
    }
#endif
}
```

```cpp
#include <hip/hip_runtime.h>
#include <hip/hip_cooperative_groups.h>
#include <cstdio>
#include <cstdint>
namespace cg = cooperative_groups;

namespace pg8 {
#define PG8_LAS __attribute__((address_space(3)))
typedef unsigned short bf16_t;
typedef short bf16x8 __attribute__((ext_vector_type(8)));
typedef float f32x4 __attribute__((ext_vector_type(4)));
typedef unsigned u32x4 __attribute__((ext_vector_type(4)));
constexpr int BM = 256, BK = 64, HALF = 128, HTB = HALF * BK * 2  , STAGE_BYTES = 8 * HTB, NXCD = 8, WGM = 8;

__host__ __device__ __forceinline__ int lds_byte(int r, int c) { const int st = (r >> 4) * 2 + (c >> 5), rr = r & 15, cc = c & 31, ob = rr * 64 + cc * 2; return st * 1024 + (ob ^ (((ob >> 9) & 1) << 5)); }
__host__ __device__ __forceinline__ void stage_rc(int b, int& R, int& C) { const int st = b / 1024, sb = b % 1024, swz = sb ^ (((sb >> 9) & 1) << 5); R = (st >> 1) * 16 + swz / 64; C = (st & 1) * 32 + (swz % 64) / 2; }
__host__ __device__ __forceinline__ int perm32(int rho) { const int n = rho >> 4, i = rho & 15; return 8 * (i >> 2) + 4 * n + (i & 3); }

struct Unit { int pm, pn; };
struct Gemm { const bf16_t* A; const bf16_t* Bt; int M, N, K; };

struct StaticOrder {
    int nM, nN, nwg, G, c;
    __host__ __device__ void init(int M, int N, int G_, int c_) { nM = M / BM; nN = N / BM; nwg = nM * nN; G = G_; c = c_; }
    __host__ __device__ bool next(int i, Unit& u) const {
        const long L = (long)i * G + c; if (L >= nwg) return false;
        int wgid = (int)L; { const int q = nwg / NXCD, r = nwg % NXCD, xcd = wgid % NXCD, off = wgid / NXCD; wgid = (xcd < r ? xcd * (q + 1) : r * (q + 1) + (xcd - r) * q) + off; }
        const int nig = WGM * nN, gid = wgid / nig, fm = gid * WGM, gsz = (nM - fm) < WGM ? (nM - fm) : WGM;
        u.pm = fm + ((wgid % nig) % gsz); u.pn = (wgid % nig) / gsz; return true;
    }
    int ovl = 0;
    __device__ __forceinline__ long arow(const Unit& u) const { return ovl ? (long)(u.pm / 33) * 8192 + 252 * (u.pm % 33) - 1 : (long)u.pm * BM; }
    __device__ __forceinline__ void a_ready(const Unit&) const {}
    __device__ __forceinline__ void done(const Unit&) const {}
};

__device__ __forceinline__ unsigned cvt_pk_bf16(float lo, float hi) { unsigned r; asm volatile("v_cvt_pk_bf16_f32 %0, %1, %2" : "=v"(r) : "v"(lo), "v"(hi)); return r; }
typedef float f32x2 __attribute__((ext_vector_type(2)));
template <class Epi, class Sched, bool ALIGN_EPI = false, bool SP2 = false>
__device__ __forceinline__ void gemm_phase(PG8_LAS unsigned char* lds, const Gemm g, const Sched& S, const Epi& E) {
    int tid = threadIdx.x; asm volatile("" : "+v"(tid));
    const int wid = __builtin_amdgcn_readfirstlane(tid >> 6), lane = tid & 63, wr = wid >> 2, wc = wid & 3, fr = lane & 15, fq = lane >> 4;
    const int K = g.K, nt = K / BK;
    unsigned voffA[2], voffB[2];
#pragma unroll
    for (int i = 0; i < 2; ++i) { int R, C; stage_rc(tid * 16 + i * 8192, R, C); const int Rb = Epi::PERM ? ((R & ~31) + perm32(R & 31)) : R;
        const int Ra = S.ovl ? (126 * (R >> 6) + 4 * (R & 15) + ((R >> 4) & 3)) : R;
        voffA[i] = (unsigned)(Ra * K + C) * 2u; voffB[i] = (unsigned)(Rb * K + C) * 2u; }
    const size_t kstep = (size_t)(BK * 2);
    const size_t hstep = (size_t)HALF * K * 2;
    const size_t tstep = 2 * hstep;
    const size_t hstepA = S.ovl ? (size_t)64 * K * 2 : hstep;
    const unsigned ldsw = (unsigned)wid * 1024u;
    const int aoff = lds_byte(wr * 64 + fr, fq * 8), boff = lds_byte(wc * 32 + fr, fq * 8);
#define PG8_SA(b, h) (((b) * 2 + (h)) * HTB)
#define PG8_SB(b, h) ((4 + (b) * 2 + (h)) * HTB)
#define PG8_STAGE(bufoff, gbase, voff) do { _Pragma("unroll") for (int _i = 0; _i < 2; ++_i) \
        __builtin_amdgcn_global_load_lds((const unsigned*)((const char*)(gbase) + (voff)[_i]), (PG8_LAS unsigned*)(lds + (bufoff) + ldsw + _i * 8192), 16, 0, 0); } while (0)
#define PG8_LDA(dst, b, h) do { _Pragma("unroll") for (int m = 0; m < 4; ++m) _Pragma("unroll") for (int k = 0; k < 2; ++k) dst[m][k] = *(const PG8_LAS bf16x8*)(lds + PG8_SA(b, h) + aoff + m * 2048 + k * 1024); } while (0)
#define PG8_LDB(dst, b, h) do { _Pragma("unroll") for (int n = 0; n < 2; ++n) _Pragma("unroll") for (int k = 0; k < 2; ++k) dst[n][k] = *(const PG8_LAS bf16x8*)(lds + PG8_SB(b, h) + boff + n * 2048 + k * 1024); } while (0)
#define PG8_MMA(ai, bj, At, Bt) do { __builtin_amdgcn_s_setprio(1); _Pragma("unroll") for (int m = 0; m < 4; ++m) _Pragma("unroll") for (int n = 0; n < 2; ++n) _Pragma("unroll") for (int k = 0; k < 2; ++k) \
        acc[ai][bj][m][n] = __builtin_amdgcn_mfma_f32_16x16x32_bf16(Bt[n][k], At[m][k], acc[ai][bj][m][n], 0, 0, 0); __builtin_amdgcn_s_setprio(0); } while (0)
#define PG8_WAIT_V(n) asm volatile("s_waitcnt vmcnt(" #n ")" ::: "memory")
#define PG8_WAIT_L(n) asm volatile("s_waitcnt lgkmcnt(" #n ")" ::: "memory")
#define PG8_BAR __builtin_amdgcn_s_barrier()
#define PG8_SCHED __builtin_amdgcn_sched_barrier(0)
    Unit cur, nxt; int ui = 0;
    if (!S.next(0, cur)) return;
    f32x4 acc[2][2][4][2];
#pragma unroll
    for (int a = 0; a < 2; ++a)
#pragma unroll
        for (int b = 0; b < 2; ++b)
#pragma unroll
            for (int m = 0; m < 4; ++m)
#pragma unroll
                for (int n = 0; n < 2; ++n) acc[a][b][m][n] = (f32x4){0.f, 0.f, 0.f, 0.f};
    bf16x8 At[4][2], B0[2][2], B1[2][2];
    const long rowb = (long)K * 2;
    const char* cA = (const char*)g.A + S.arow(cur) * rowb; const char* cB = (const char*)g.Bt + (size_t)cur.pn * tstep;
    S.a_ready(cur);
    if constexpr (SP2) {
        PG8_STAGE(PG8_SB(0, 0), cB, voffB); PG8_STAGE(PG8_SB(0, 1), cB + hstep, voffB); PG8_STAGE(PG8_SA(0, 0), cA, voffA); PG8_STAGE(PG8_SA(0, 1), cA + hstepA, voffA);
        if (wr == 1) PG8_BAR;
        PG8_WAIT_V(2); PG8_BAR;
        PG8_STAGE(PG8_SB(1, 0), cB + kstep, voffB); PG8_STAGE(PG8_SA(1, 0), cA + kstep, voffA); PG8_STAGE(PG8_SB(1, 1), cB + hstep + kstep, voffB);
        PG8_WAIT_V(6); PG8_BAR;
    } else {
        PG8_STAGE(PG8_SB(0, 0), cB, voffB); PG8_STAGE(PG8_SA(0, 0), cA, voffA); PG8_STAGE(PG8_SB(0, 1), cB + hstep, voffB); PG8_STAGE(PG8_SA(0, 1), cA + hstepA, voffA);
        if (wr == 1) PG8_BAR;
        PG8_WAIT_V(4); PG8_BAR;
        PG8_STAGE(PG8_SB(1, 0), cB + kstep, voffB); PG8_STAGE(PG8_SA(1, 0), cA + kstep, voffA); PG8_STAGE(PG8_SB(1, 1), cB + hstep + kstep, voffB);
        PG8_WAIT_V(6); PG8_BAR;
    }
    for (;;) {
        const bool has_next = S.next(ui + 1, nxt);
        const char* nA = has_next ? (const char*)g.A + S.arow(nxt) * rowb : cA; const char* nB = has_next ? (const char*)g.Bt + (size_t)nxt.pn * tstep : cB;
        for (int t = 0; t < nt; t += 2) {
            const bool last = (t == nt - 2);
            const char* a1 = cA + (size_t)(t + 1) * kstep;
            const char* a2 = last ? nA : cA + (size_t)(t + 2) * kstep; const char* b2 = last ? nB : cB + (size_t)(t + 2) * kstep;
            const char* a3 = a2 + kstep; const char* b3 = b2 + kstep;
            if (last && has_next) S.a_ready(nxt);
            if constexpr (SP2) {
            PG8_LDB(B0, 0, 0); PG8_LDB(B1, 0, 1); PG8_SCHED; PG8_LDA(At, 0, 0); PG8_STAGE(PG8_SA(1, 1), a1 + hstepA, voffA);
            PG8_WAIT_V(8); PG8_WAIT_L(0); PG8_BAR; PG8_MMA(0, 0, At, B0); PG8_MMA(0, 1, At, B1); PG8_BAR; PG8_SCHED;
            PG8_LDA(At, 0, 1); PG8_STAGE(PG8_SB(0, 0), b2, voffB); PG8_STAGE(PG8_SB(0, 1), b2 + hstep, voffB); PG8_STAGE(PG8_SA(0, 0), a2, voffA);
            PG8_WAIT_V(8); PG8_WAIT_L(0); PG8_BAR; PG8_MMA(1, 0, At, B0); PG8_MMA(1, 1, At, B1); PG8_BAR; PG8_SCHED;
            PG8_LDB(B0, 1, 0); PG8_LDB(B1, 1, 1); PG8_SCHED; PG8_LDA(At, 1, 0); PG8_STAGE(PG8_SA(0, 1), a2 + hstepA, voffA);
            PG8_WAIT_V(8); PG8_WAIT_L(0); PG8_BAR; PG8_MMA(0, 0, At, B0); PG8_MMA(0, 1, At, B1); PG8_BAR; PG8_SCHED;
            PG8_LDA(At, 1, 1); PG8_STAGE(PG8_SB(1, 0), b3, voffB); PG8_STAGE(PG8_SB(1, 1), b3 + hstep, voffB); PG8_STAGE(PG8_SA(1, 0), a3, voffA);
            PG8_WAIT_V(8); PG8_WAIT_L(0); PG8_BAR; PG8_MMA(1, 0, At, B0); PG8_MMA(1, 1, At, B1); PG8_BAR; PG8_SCHED;
            } else {
            PG8_LDB(B0, 0, 0); PG8_SCHED; PG8_LDA(At, 0, 0); PG8_STAGE(PG8_SA(1, 1), a1 + hstepA, voffA);
            PG8_WAIT_L(8); PG8_BAR; PG8_WAIT_L(0); PG8_MMA(0, 0, At, B0); PG8_BAR; PG8_SCHED;
            PG8_LDB(B1, 0, 1); PG8_STAGE(PG8_SB(0, 0), b2, voffB);
            PG8_BAR; PG8_WAIT_L(0); PG8_MMA(0, 1, At, B1); PG8_BAR;
            PG8_LDA(At, 0, 1); PG8_STAGE(PG8_SA(0, 0), a2, voffA);
            PG8_BAR; PG8_WAIT_L(0); PG8_MMA(1, 0, At, B0); PG8_BAR; PG8_SCHED;
            PG8_STAGE(PG8_SB(0, 1), b2 + hstep, voffB);
            PG8_WAIT_V(6); PG8_BAR; PG8_MMA(1, 1, At, B1); PG8_BAR;
            PG8_LDB(B0, 1, 0); PG8_SCHED; PG8_LDA(At, 1, 0); PG8_STAGE(PG8_SA(0, 1), a2 + hstepA, voffA);
            PG8_WAIT_L(8); PG8_BAR; PG8_WAIT_L(0); PG8_MMA(0, 0, At, B0); PG8_BAR; PG8_SCHED;
            PG8_LDB(B1, 1, 1); PG8_STAGE(PG8_SB(1, 0), b3, voffB);
            PG8_BAR; PG8_WAIT_L(0); PG8_MMA(0, 1, At, B1); PG8_BAR;
            PG8_LDA(At, 1, 1); PG8_STAGE(PG8_SA(1, 0), a3, voffA);
            PG8_BAR; PG8_WAIT_L(0); PG8_MMA(1, 0, At, B0); PG8_BAR; PG8_SCHED;
            PG8_STAGE(PG8_SB(1, 1), b3 + hstep, voffB);
            PG8_WAIT_V(6); PG8_BAR; PG8_MMA(1, 1, At, B1); PG8_BAR;
            }
        }
        if constexpr (ALIGN_EPI) { if (wr == 0) PG8_BAR; }
        if constexpr (!Epi::AFTER_DRAIN) { E(acc, cur, wr, wc, fr, fq); S.done(cur); }
        if (!has_next) break;
#pragma unroll
        for (int a = 0; a < 2; ++a)
#pragma unroll
            for (int b = 0; b < 2; ++b)
#pragma unroll
                for (int m = 0; m < 4; ++m)
#pragma unroll
                    for (int n = 0; n < 2; ++n) acc[a][b][m][n] = (f32x4){0.f, 0.f, 0.f, 0.f};
        cur = nxt; cA = nA; cB = nB; ++ui;
        if constexpr (ALIGN_EPI) { if (wr == 1) PG8_BAR; }
    }
    PG8_WAIT_V(0);
    if constexpr (!ALIGN_EPI) { if (wr == 0) PG8_BAR; }
    PG8_BAR;
    if constexpr (Epi::AFTER_DRAIN) { E.fused(acc, cur, wr, wc, fr, fq, lds, wid, lane); S.done(cur); }
#undef PG8_SA
#undef PG8_SB
#undef PG8_STAGE
#undef PG8_LDA
#undef PG8_LDB
#undef PG8_MMA
#undef PG8_WAIT_V
#undef PG8_WAIT_L
#undef PG8_BAR
#undef PG8_SCHED
}
}

constexpr int DM = 1024, SEQL = 8192, NSEQ = 10, MTOK = NSEQ * SEQL, INW = 4096, DFF = 2816, DFF2 = 5632, NHEAD = 4;
constexpr int MPROMPT = 2 * SEQL;
constexpr float NORM_EPS = 1e-6f;
constexpr float LOG2E = 1.4426950408889634f;
typedef unsigned short bf16_t;
typedef short bf16x8 __attribute__((ext_vector_type(8)));
typedef short s16x4 __attribute__((ext_vector_type(4)));
typedef float f32x4 __attribute__((ext_vector_type(4)));
typedef float f32x16 __attribute__((ext_vector_type(16)));
typedef unsigned u32x4 __attribute__((ext_vector_type(4)));
typedef unsigned u32x2 __attribute__((ext_vector_type(2)));
typedef float f32x2 __attribute__((ext_vector_type(2)));
#define LAS __attribute__((address_space(3)))

constexpr size_t MiB = 1u << 20;
constexpr size_t WS_CTL = 0;
constexpr size_t WS_WIN = 1 * MiB;
constexpr size_t WS_WOUT = 9 * MiB;
constexpr size_t WS_WUP = 11 * MiB;
constexpr size_t WS_WDOWN = 22 * MiB;
constexpr size_t WS_XN = 32 * MiB;
constexpr size_t WS_PROJ = 192 * MiB;
constexpr size_t WS_OF = 832 * MiB;
constexpr size_t WS_OB = 912 * MiB;
constexpr size_t WS_U = 192 * MiB;
constexpr size_t WS_ACT = 192 * MiB;
constexpr size_t WS_END = 992 * MiB;
constexpr int NSLAB = 2, SLABROWS = MTOK / NSLAB;

constexpr int LDS_BYTES = 143360;
constexpr int LDS_MISC = 131072 + 8192;

__device__ __forceinline__ unsigned cvtpk(float lo, float hi) { unsigned r; asm("v_cvt_pk_bf16_f32 %0, %1, %2" : "=v"(r) : "v"(lo), "v"(hi)); return r; }
__device__ __forceinline__ float bf_lo(unsigned u) { return __uint_as_float(u << 16); }
__device__ __forceinline__ float bf_hi(unsigned u) { return __uint_as_float(u & 0xffff0000u); }
__device__ __forceinline__ float ex2(float x) { return __builtin_amdgcn_exp2f(x); }
__device__ __forceinline__ float lg2(float x) { return __builtin_amdgcn_logf(x); }
__device__ __forceinline__ float rcpf(float x) { return __builtin_amdgcn_rcpf(x); }
__device__ __forceinline__ float siluf(float x) { return x * rcpf(1.f + ex2(-x * LOG2E)); }
__device__ __forceinline__ float wave_sum(float v) {
#pragma unroll
    for (int o = 1; o < 64; o <<= 1) v += __shfl_xor(v, o);
    return v;
}
__device__ __forceinline__ const float* xrow_ptr(const float* xp, const float* xs, int row) {
    return row < MPROMPT ? xp + (size_t)row * DM : xs + (size_t)(row - MPROMPT) * DM;
}

struct EpiInProj {
    static constexpr bool PERM = true, AFTER_DRAIN = false;
    bf16_t* P; const float* lbf; const float* lbb; const float* qnw; const float* knw; PG8_LAS float* ex;
    __device__ __forceinline__ void operator()(const pg8::f32x4 (&acc)[2][2][4][2], const pg8::Unit& u, int wr, int wc, int fr, int fq) const {
        const int sec = u.pn >> 1;
        int row0 = u.pm * 256 + wr * 64 + fr, col0 = u.pn * 256 + wc * 32 + 8 * fq;
        asm volatile("" : "+v"(row0), "+v"(col0));
        if (sec < 2) {
            float ps[2][4][2];
#pragma unroll
            for (int ai = 0; ai < 2; ++ai)
#pragma unroll
                for (int m = 0; m < 4; ++m)
#pragma unroll
                    for (int bj = 0; bj < 2; ++bj) { float q = 0.f;
#pragma unroll
                        for (int n = 0; n < 2; ++n)
#pragma unroll
                            for (int e = 0; e < 4; ++e) q += acc[ai][bj][m][n][e] * acc[ai][bj][m][n][e];
                        q += __shfl_xor(q, 16); q += __shfl_xor(q, 32); ps[ai][m][bj] = q; }
            const int wid = wr * 4 + wc;
            if (fq == 0) {
#pragma unroll
                for (int ai = 0; ai < 2; ++ai)
#pragma unroll
                    for (int m = 0; m < 4; ++m)
#pragma unroll
                        for (int bj = 0; bj < 2; ++bj) ex[(wid * 16 + (ai * 8 + m * 2 + bj)) * 16 + fr] = ps[ai][m][bj];
            }
            asm volatile("s_waitcnt lgkmcnt(0)" ::: "memory"); __builtin_amdgcn_s_barrier();
            const float* nw = (sec == 0) ? qnw : knw; const float sc = (sec == 0) ? 0.125f * LOG2E : 1.f;
            float w8[8];
#pragma unroll
            for (int e = 0; e < 8; ++e) w8[e] = nw[32 * (wc & 1) + 8 * fq + e] * sc;
#pragma unroll
            for (int ai = 0; ai < 2; ++ai)
#pragma unroll
                for (int m = 0; m < 4; ++m) {
                    bf16_t* rowp = P + (size_t)(row0 + ai * 128 + m * 16) * INW + col0;
#pragma unroll
                    for (int bj = 0; bj < 2; ++bj) {
                        const float tot = ps[ai][m][bj] + ex[((wid ^ 1) * 16 + (ai * 8 + m * 2 + bj)) * 16 + fr];
                        const float rs = __builtin_amdgcn_rsqf(tot * (1.f / 64.f) + NORM_EPS);
                        const pg8::f32x4 v0 = acc[ai][bj][m][0], v1 = acc[ai][bj][m][1];
                        u32x4 w; w.x = cvtpk(v0[0] * rs * w8[0], v0[1] * rs * w8[1]); w.y = cvtpk(v0[2] * rs * w8[2], v0[3] * rs * w8[3]);
                        w.z = cvtpk(v1[0] * rs * w8[4], v1[1] * rs * w8[5]); w.w = cvtpk(v1[2] * rs * w8[6], v1[3] * rs * w8[7]);
                        __builtin_nontemporal_store(w, (u32x4*)(rowp + bj * 128));
                    }
                }
            return;
        }
        float lbv[2][8];
        if (sec == 4 || sec == 5) {
            const float* t = (sec == 4) ? lbf : lbb; const int cs = col0 - sec * 512;
#pragma unroll
            for (int bj = 0; bj < 2; ++bj)
#pragma unroll
                for (int e = 0; e < 8; ++e) { const int c = cs + bj * 128 + e; lbv[bj][e] = rcpf(1.f + ex2((t[512 + c] - t[c]) * LOG2E)); }
        }
#pragma unroll
        for (int ai = 0; ai < 2; ++ai)
#pragma unroll
            for (int m = 0; m < 4; ++m) {
                bf16_t* rowp = P + (size_t)(row0 + ai * 128 + m * 16) * INW + col0;
#pragma unroll
                for (int bj = 0; bj < 2; ++bj) {
                    float v[8];
#pragma unroll
                    for (int e = 0; e < 4; ++e) { v[e] = acc[ai][bj][m][0][e]; v[4 + e] = acc[ai][bj][m][1][e]; }
                    if (sec == 3 || sec == 7) {
#pragma unroll
                        for (int e = 0; e < 8; ++e) v[e] = siluf(v[e]);
                    } else if (sec == 4 || sec == 5) {
#pragma unroll
                        for (int e = 0; e < 8; ++e) { const float sg = rcpf(1.f + ex2(-v[e] * LOG2E)); const float lb = lbv[bj][e]; v[e] = lg2(lb + (1.f - lb) * sg); }
                    }
                    u32x4 w; w.x = cvtpk(v[0], v[1]); w.y = cvtpk(v[2], v[3]); w.z = cvtpk(v[4], v[5]); w.w = cvtpk(v[6], v[7]);
                    __builtin_nontemporal_store(w, (u32x4*)(rowp + bj * 128));
                }
            }
    }
};
struct EpiBf16Plain {
    static constexpr bool PERM = true, AFTER_DRAIN = false;
    bf16_t* O; int ldc;
    __device__ __forceinline__ void operator()(const pg8::f32x4 (&acc)[2][2][4][2], const pg8::Unit& u, int wr, int wc, int fr, int fq) const {
        int row0 = u.pm * 256 + wr * 64 + fr, col0 = u.pn * 256 + wc * 32 + 8 * fq;
        asm volatile("" : "+v"(row0), "+v"(col0));
#pragma unroll
        for (int ai = 0; ai < 2; ++ai)
#pragma unroll
            for (int m = 0; m < 4; ++m) {
                bf16_t* rowp = O + (size_t)(row0 + ai * 128 + m * 16) * ldc + col0;
#pragma unroll
                for (int bj = 0; bj < 2; ++bj) {
                    const pg8::f32x4 v0 = acc[ai][bj][m][0], v1 = acc[ai][bj][m][1];
                    u32x4 w; w.x = cvtpk(v0[0], v0[1]); w.y = cvtpk(v0[2], v0[3]); w.z = cvtpk(v1[0], v1[1]); w.w = cvtpk(v1[2], v1[3]);
                    *(u32x4*)(rowp + bj * 128) = w;
                }
            }
    }
};
struct EpiResid {
    static constexpr bool PERM = true, AFTER_DRAIN = false;
    const float* xp; const float* xs; float* out; int row_off; int self;
    __device__ __forceinline__ void operator()(const pg8::f32x4 (&acc)[2][2][4][2], const pg8::Unit& u, int wr, int wc, int fr, int fq) const {
        const int rowt = row_off + u.pm * 256;
        const float* rb = self ? (const float*)out + (size_t)rowt * DM : xrow_ptr(xp, xs, rowt);
        float* ob = out + (size_t)rowt * DM;
        int r0 = wr * 64 + fr, col0 = u.pn * 256 + wc * 32 + 8 * fq;
        asm volatile("" : "+v"(r0), "+v"(col0));
#pragma unroll
        for (int ai = 0; ai < 2; ++ai)
#pragma unroll
            for (int m = 0; m < 4; ++m) {
                const size_t ro = (size_t)(r0 + ai * 128 + m * 16) * DM + col0;
#pragma unroll
                for (int bj = 0; bj < 2; ++bj)
#pragma unroll
                    for (int n = 0; n < 2; ++n) {
                        const f32x4 r = *(const f32x4*)(rb + ro + bj * 128 + 4 * n);
                        const pg8::f32x4 a = acc[ai][bj][m][n];
                        f32x4 o; o[0] = r[0] + a[0]; o[1] = r[1] + a[1]; o[2] = r[2] + a[2]; o[3] = r[3] + a[3];
                        *(f32x4*)(ob + ro + bj * 128 + 4 * n) = o;
                    }
            }
    }
};

struct EpiResidB {
    static constexpr bool PERM = true, AFTER_DRAIN = false;
    const float* xp; const float* xs; bf16_t* X1B;
    __device__ __forceinline__ void operator()(const pg8::f32x4 (&acc)[2][2][4][2], const pg8::Unit& u, int wr, int wc, int fr, int fq) const {
        const int rowt = u.pm * 256;
        const float* rb = xrow_ptr(xp, xs, rowt);
        bf16_t* ob = X1B + (size_t)rowt * DM;
        int r0 = wr * 64 + fr, col0 = u.pn * 256 + wc * 32 + 8 * fq;
        asm volatile("" : "+v"(r0), "+v"(col0));
#pragma unroll
        for (int ai = 0; ai < 2; ++ai)
#pragma unroll
            for (int m = 0; m < 4; ++m) {
                const size_t ro = (size_t)(r0 + ai * 128 + m * 16) * DM + col0;
#pragma unroll
                for (int bj = 0; bj < 2; ++bj) {
                    const f32x4 ra = *(const f32x4*)(rb + ro + bj * 128), rc = *(const f32x4*)(rb + ro + bj * 128 + 4);
                    const pg8::f32x4 a = acc[ai][bj][m][0], c = acc[ai][bj][m][1];
                    u32x4 w; w.x = cvtpk(ra[0] + a[0], ra[1] + a[1]); w.y = cvtpk(ra[2] + a[2], ra[3] + a[3]); w.z = cvtpk(rc[0] + c[0], rc[1] + c[1]); w.w = cvtpk(rc[2] + c[2], rc[3] + c[3]);
                    *(u32x4*)(ob + ro + bj * 128) = w;
                }
            }
    }
};
struct EpiFinal {
    static constexpr bool PERM = true, AFTER_DRAIN = false;
    const bf16_t* X1B; float* out;
    __device__ __forceinline__ void operator()(const pg8::f32x4 (&acc)[2][2][4][2], const pg8::Unit& u, int wr, int wc, int fr, int fq) const {
        const int rowt = u.pm * 256;
        const bf16_t* rb = X1B + (size_t)rowt * DM;
        float* ob = out + (size_t)rowt * DM;
        int r0 = wr * 64 + fr, col0 = u.pn * 256 + wc * 32 + 8 * fq;
        asm volatile("" : "+v"(r0), "+v"(col0));
#pragma unroll
        for (int ai = 0; ai < 2; ++ai)
#pragma unroll
            for (int m = 0; m < 4; ++m) {
                const size_t ro = (size_t)(r0 + ai * 128 + m * 16) * DM + col0;
#pragma unroll
                for (int bj = 0; bj < 2; ++bj) {
                    const u32x4 r = *(const u32x4*)(rb + ro + bj * 128);
                    const pg8::f32x4 a = acc[ai][bj][m][0], c = acc[ai][bj][m][1];
                    f32x4 o0, o1;
                    o0[0] = bf_lo(r.x) + a[0]; o0[1] = bf_hi(r.x) + a[1]; o0[2] = bf_lo(r.y) + a[2]; o0[3] = bf_hi(r.y) + a[3];
                    o1[0] = bf_lo(r.z) + c[0]; o1[1] = bf_hi(r.z) + c[1]; o1[2] = bf_lo(r.w) + c[2]; o1[3] = bf_hi(r.w) + c[3];
                    *(f32x4*)(ob + ro + bj * 128) = o0; *(f32x4*)(ob + ro + bj * 128 + 4) = o1;
                }
            }
    }
};

#define DPP_SHR1 0x111
#define DPP_SHL1 0x101
#define DPP_ROR1 0x121
#define DPP_ROR15 0x12F
__device__ __forceinline__ float dppf(float old, float src, const int ctrl_sel) {
    int r;
    if (ctrl_sel == 0) r = __builtin_amdgcn_update_dpp(__float_as_int(old), __float_as_int(src), DPP_SHR1, 0xf, 0xf, false);
    else if (ctrl_sel == 1) r = __builtin_amdgcn_update_dpp(__float_as_int(old), __float_as_int(src), DPP_SHL1, 0xf, 0xf, false);
    else if (ctrl_sel == 2) r = __builtin_amdgcn_update_dpp(__float_as_int(old), __float_as_int(src), DPP_ROR1, 0xf, 0xf, false);
    else r = __builtin_amdgcn_update_dpp(__float_as_int(old), __float_as_int(src), DPP_ROR15, 0xf, 0xf, false);
    return __int_as_float(r);
}
struct EpiConvAct {
    static constexpr bool PERM = true, AFTER_DRAIN = false;
    bf16_t* ACT; const float* cw; const float* cb; PG8_LAS float* ex;
    __device__ __forceinline__ void operator()(const pg8::f32x4 (&acc)[2][2][4][2], const pg8::Unit& u, int wr, int wc, int fr, int fq) const {
        int seq = u.pm / 33, pt = u.pm % 33;
        asm volatile("" : "+s"(seq), "+s"(pt));
        const int t0 = 252 * pt - 1 + 126 * wr;
        int cl = wc * 32 + 8 * fq;
        asm volatile("" : "+v"(cl));
        const int chb = u.pn * 128 + cl;
#pragma unroll
        for (int n = 0; n < 2; ++n) {
            const int ch = chb + 4 * n;
            const f32x4 bg = *(const f32x4*)(cb + ch), bu = *(const f32x4*)(cb + DFF + ch);
            const f32x4 g0 = *(const f32x4*)(cw + ch), g1 = *(const f32x4*)(cw + DFF2 + ch), g2 = *(const f32x4*)(cw + 2 * DFF2 + ch);
            const f32x4 u0 = *(const f32x4*)(cw + DFF + ch), u1 = *(const f32x4*)(cw + DFF2 + DFF + ch), u2 = *(const f32x4*)(cw + 2 * DFF2 + DFF + ch);
#pragma unroll
            for (int ai = 0; ai < 2; ++ai) {
#pragma unroll
                for (int m = 0; m < 4; ++m) {
                    const int row = 64 * ai + 4 * fr + m, t = t0 + row;
                    const bool keep = (row >= 1) && (row <= 126) && (t < SEQL);
                    float o4[4];
#pragma unroll
                    for (int e = 0; e < 4; ++e) {
                        float cv[2];
#pragma unroll
                        for (int bj = 0; bj < 2; ++bj) {
                            const float X = acc[ai][bj][m][n][e];
                            float pv, nv;
                            if (m > 0) pv = acc[ai][bj][m > 0 ? m - 1 : 0][n][e];
                            else { const float ob = (ai == 1) ? dppf(0.f, acc[0][bj][3][n][e], 2) : 0.f; pv = dppf(ob, acc[ai][bj][3][n][e], 0); }
                            if (m < 3) nv = acc[ai][bj][m < 3 ? m + 1 : 3][n][e];
                            else { const float ob = (ai == 0) ? dppf(0.f, acc[1][bj][0][n][e], 3) : 0.f; nv = dppf(ob, acc[ai][bj][0][n][e], 1); }
                            if (m == 1) pv = (t == 0) ? 0.f : pv;
                            if (m == 2) nv = (t == SEQL - 1) ? 0.f : nv;
                            cv[bj] = bj == 0 ? bg[e] + g0[e] * pv + g1[e] * X + g2[e] * nv : bu[e] + u0[e] * pv + u1[e] * X + u2[e] * nv;
                        }
                        o4[e] = siluf(cv[0]) * cv[1];
                    }
                    if (keep) { u32x2 w; w.x = cvtpk(o4[0], o4[1]); w.y = cvtpk(o4[2], o4[3]); *(u32x2*)(ACT + ((size_t)seq * SEQL + t) * DFF + ch) = w; }
                }
            }
        }
    }
};

__device__ __forceinline__ void p0_transpose_item(const float* W, int K, int N, bf16_t* WT, LAS float* scr, int item, int lane, bool perm_up = false) {
    const int nblk = N / 32, kb = item / nblk, nb = item % nblk, k0 = 64 * kb, n0 = 32 * nb;
#pragma unroll 8
    for (int i = 0; i < 32; ++i) { const int kk = 2 * i + (lane >> 5); scr[kk * 33 + (lane & 31)] = W[(size_t)(k0 + kk) * N + n0 + (lane & 31)]; }
    asm volatile("s_waitcnt lgkmcnt(0)" ::: "memory");
    const int c = lane & 7;
#pragma unroll
    for (int j = 0; j < 4; ++j) { const int n = (lane >> 3) + 8 * j; const LAS float* s = scr + (8 * c) * 33 + n;
        u32x4 o; o.x = cvtpk(s[0 * 33], s[1 * 33]); o.y = cvtpk(s[2 * 33], s[3 * 33]); o.z = cvtpk(s[4 * 33], s[5 * 33]); o.w = cvtpk(s[6 * 33], s[7 * 33]);
        int nd = n0 + n; if (perm_up) { const int hf = nd / DFF, rr = nd - hf * DFF; nd = (rr >> 7) * 256 + hf * 128 + (rr & 127); }
        *(u32x4*)(WT + (size_t)nd * K + k0 + 8 * c) = o; }
    asm volatile("s_waitcnt lgkmcnt(0)" ::: "memory");
}
__device__ __forceinline__ void rms_row2_to_bf16(const float* xrow0, const float* xrow1, const float* w, bf16_t* orow0, bf16_t* orow1, int lane) {
    const f32x4* xr0 = (const f32x4*)xrow0 + lane; const f32x4* xr1 = (const f32x4*)xrow1 + lane; const f32x4* wr = (const f32x4*)w + lane;
    f32x4 v0[4], v1[4]; float s0 = 0.f, s1 = 0.f;
#pragma unroll
    for (int j = 0; j < 4; ++j) { v0[j] = xr0[64 * j]; v1[j] = xr1[64 * j]; }
#pragma unroll
    for (int j = 0; j < 4; ++j) { s0 += (v0[j][0] * v0[j][0] + v0[j][1] * v0[j][1]) + (v0[j][2] * v0[j][2] + v0[j][3] * v0[j][3]); s1 += (v1[j][0] * v1[j][0] + v1[j][1] * v1[j][1]) + (v1[j][2] * v1[j][2] + v1[j][3] * v1[j][3]); }
    const float r0 = __builtin_amdgcn_rsqf(wave_sum(s0) * (1.f / DM) + NORM_EPS), r1 = __builtin_amdgcn_rsqf(wave_sum(s1) * (1.f / DM) + NORM_EPS);
    u32x2* o0 = (u32x2*)orow0 + lane; u32x2* o1 = (u32x2*)orow1 + lane;
#pragma unroll
    for (int j = 0; j < 4; ++j) { const f32x4 ww = wr[64 * j]; u32x2 o;
        o.x = cvtpk(v0[j][0] * r0 * ww[0], v0[j][1] * r0 * ww[1]); o.y = cvtpk(v0[j][2] * r0 * ww[2], v0[j][3] * r0 * ww[3]); o0[64 * j] = o;
        o.x = cvtpk(v1[j][0] * r1 * ww[0], v1[j][1] * r1 * ww[1]); o.y = cvtpk(v1[j][2] * r1 * ww[2], v1[j][3] * r1 * ww[3]); o1[64 * j] = o; }
}
__device__ __forceinline__ void rms_rowb2_to_bf16(const bf16_t* xrow0, const bf16_t* xrow1, const float* w, bf16_t* orow0, bf16_t* orow1, int lane) {
    const u32x4 a0 = *((const u32x4*)xrow0 + lane), a1 = *((const u32x4*)xrow0 + 64 + lane), b0 = *((const u32x4*)xrow1 + lane), b1 = *((const u32x4*)xrow1 + 64 + lane);
    float va[16], vb[16]; float s0 = 0.f, s1 = 0.f;
#pragma unroll
    for (int e = 0; e < 4; ++e) { va[2 * e] = bf_lo(a0[e]); va[2 * e + 1] = bf_hi(a0[e]); va[8 + 2 * e] = bf_lo(a1[e]); va[8 + 2 * e + 1] = bf_hi(a1[e]);
        vb[2 * e] = bf_lo(b0[e]); vb[2 * e + 1] = bf_hi(b0[e]); vb[8 + 2 * e] = bf_lo(b1[e]); vb[8 + 2 * e + 1] = bf_hi(b1[e]); }
#pragma unroll
    for (int e = 0; e < 16; ++e) { s0 += va[e] * va[e]; s1 += vb[e] * vb[e]; }
    const float r0 = __builtin_amdgcn_rsqf(wave_sum(s0) * (1.f / DM) + NORM_EPS), r1 = __builtin_amdgcn_rsqf(wave_sum(s1) * (1.f / DM) + NORM_EPS);
    const f32x4 w0 = *((const f32x4*)w + 2 * lane), w1 = *((const f32x4*)w + 2 * lane + 1), w2 = *((const f32x4*)w + 128 + 2 * lane), w3 = *((const f32x4*)w + 128 + 2 * lane + 1);
    u32x4 o;
    o.x = cvtpk(va[0] * r0 * w0[0], va[1] * r0 * w0[1]); o.y = cvtpk(va[2] * r0 * w0[2], va[3] * r0 * w0[3]); o.z = cvtpk(va[4] * r0 * w1[0], va[5] * r0 * w1[1]); o.w = cvtpk(va[6] * r0 * w1[2], va[7] * r0 * w1[3]);
    *((u32x4*)orow0 + lane) = o;
    o.x = cvtpk(va[8] * r0 * w2[0], va[9] * r0 * w2[1]); o.y = cvtpk(va[10] * r0 * w2[2], va[11] * r0 * w2[3]); o.z = cvtpk(va[12] * r0 * w3[0], va[13] * r0 * w3[1]); o.w = cvtpk(va[14] * r0 * w3[2], va[15] * r0 * w3[3]);
    *((u32x4*)orow0 + 64 + lane) = o;
    o.x = cvtpk(vb[0] * r1 * w0[0], vb[1] * r1 * w0[1]); o.y = cvtpk(vb[2] * r1 * w0[2], vb[3] * r1 * w0[3]); o.z = cvtpk(vb[4] * r1 * w1[0], vb[5] * r1 * w1[1]); o.w = cvtpk(vb[6] * r1 * w1[2], vb[7] * r1 * w1[3]);
    *((u32x4*)orow1 + lane) = o;
    o.x = cvtpk(vb[8] * r1 * w2[0], vb[9] * r1 * w2[1]); o.y = cvtpk(vb[10] * r1 * w2[2], vb[11] * r1 * w2[3]); o.z = cvtpk(vb[12] * r1 * w3[0], vb[13] * r1 * w3[1]); o.w = cvtpk(vb[14] * r1 * w3[2], vb[15] * r1 * w3[3]);
    *((u32x4*)orow1 + 64 + lane) = o;
}

namespace att {
constexpr int KVBLK = 64, LDK = INW;
constexpr int SHM_V = KVBLK * 128 * 2, SHM_K = KVBLK * 128 * 2;
constexpr float THR2 = 11.5f;
#ifndef ATT_SDEPTH
#define ATT_SDEPTH 2
#endif
constexpr int SDEPTH = ATT_SDEPTH;
#define KSWZ(row, colB) ((row) * 256 + ((colB) ^ (((row) & 7) << 4)))
#define SBAR() __builtin_amdgcn_sched_barrier(0)
__device__ __forceinline__ int crow(int r, int hi) { return (r & 3) + 8 * (r >> 2) + 4 * hi; }
__device__ __forceinline__ unsigned cvtpkv(float lo, float hi) { unsigned r; asm volatile("v_cvt_pk_bf16_f32 %0, %1, %2" : "=v"(r) : "v"(lo), "v"(hi)); return r; }

__device__ __forceinline__ void partialSM(f32x16& p0, f32x16& p1, float dq, float c2) {
#pragma unroll
  for (int r = 0; r < 16; ++r) { p0[r] = fmaf(-c2, fabsf(dq - (float)((r & 3) + 8 * (r >> 2))), p0[r]); p1[r] = fmaf(-c2, fabsf(dq - (float)(32 + (r & 3) + 8 * (r >> 2))), p1[r]); }
#pragma unroll
  for (int r = 0; r < 16; ++r) p0[r] = __builtin_amdgcn_exp2f(p0[r]);
}
__device__ __forceinline__ void finishSM(f32x16& p0, f32x16& p1, float& l_reg, bf16x8& pa0, bf16x8& pa1, bf16x8& pa2, bf16x8& pa3) {
#pragma unroll
  for (int r = 0; r < 16; ++r) p1[r] = __builtin_amdgcn_exp2f(p1[r]);
  float ps = 0;
#pragma unroll
  for (int r = 0; r < 16; ++r) ps += p0[r];
#pragma unroll
  for (int r = 0; r < 16; ++r) ps += p1[r];
  { auto rr = __builtin_amdgcn_permlane32_swap(__float_as_uint(ps), __float_as_uint(ps), false, false);
    ps = __uint_as_float(rr[0]) + __uint_as_float(rr[1]); }
  l_reg += ps;
#define PK4(P, BASE, OUT) do { unsigned a0 = cvtpkv(P[BASE + 0], P[BASE + 1]), a1 = cvtpkv(P[BASE + 2], P[BASE + 3]);   \
    unsigned b0 = cvtpkv(P[BASE + 4], P[BASE + 5]), b1 = cvtpkv(P[BASE + 6], P[BASE + 7]);                              \
    auto r0 = __builtin_amdgcn_permlane32_swap(a0, b0, false, false); auto r1 = __builtin_amdgcn_permlane32_swap(a1, b1, false, false); \
    u32x4 w = {r0[0], r1[0], r0[1], r1[1]}; OUT = *reinterpret_cast<bf16x8*>(&w); } while (0)
  PK4(p0, 0, pa0); PK4(p0, 8, pa1); PK4(p1, 0, pa2); PK4(p1, 8, pa3);
#undef PK4
}
__device__ __forceinline__ void qkt(f32x16& p0, f32x16& p1, const char* Ks, const bf16x8* qr, int r32, int hi, int map) {
  p0 = f32x16{}; p1 = f32x16{};
#pragma unroll
  for (int d0 = 0; d0 < 4; ++d0) { const int cb = (map * 64 + d0 * 16 + hi * 8) * 2;
    bf16x8 b0 = *reinterpret_cast<const bf16x8*>(Ks + KSWZ(r32, cb));
    bf16x8 b1 = *reinterpret_cast<const bf16x8*>(Ks + KSWZ(32 + r32, cb));
    p0 = __builtin_amdgcn_mfma_f32_32x32x16_bf16(b0, qr[d0], p0, 0, 0, 0);
    p1 = __builtin_amdgcn_mfma_f32_32x32x16_bf16(b1, qr[d0], p1, 0, 0, 0); }
}
__device__ __forceinline__ int v_st(int k, int c) { const int kk = (k & ~0xC) | ((k & 4) << 1) | ((k & 8) >> 1); return ((kk >> 3) * 4 + (c >> 5)) * 512 + ((kk & 7) * 32 + (c & 31)) * 2; }
__device__ __forceinline__ int v_rd_base(int lane) { return ((lane & 3) << 3) | (((lane >> 2) & 3) << 6) | (((lane >> 4) & 1) << 5) | (((lane >> 5) & 1) << 8); }
constexpr int v_rd_off(int d0, int ks, int half) { return d0 * 512 + ks * 4096 + half * 2048; }
template <int OFF> __device__ __forceinline__ s16x4 tr_read(int vb) {
  s16x4 r; asm volatile("ds_read_b64_tr_b16 %0, %1 offset:%2" : "=&v"(r) : "v"(vb), "i"(OFF) : "memory"); return r;
}
template <int D0> __device__ __forceinline__ void pv_one(f32x16& od, int vb, bf16x8 pa0, bf16x8 pa1, bf16x8 pa2, bf16x8 pa3) {
#define PK(L, H) (bf16x8){L[0], L[1], L[2], L[3], H[0], H[1], H[2], H[3]}
  { const s16x4 l0 = tr_read<v_rd_off(D0, 0, 0)>(vb), h0 = tr_read<v_rd_off(D0, 0, 1)>(vb), l1 = tr_read<v_rd_off(D0, 1, 0)>(vb), h1 = tr_read<v_rd_off(D0, 1, 1)>(vb);
    asm volatile("s_waitcnt lgkmcnt(0)" ::: "memory"); SBAR();
    od = __builtin_amdgcn_mfma_f32_32x32x16_bf16(pa0, PK(l0, h0), od, 0, 0, 0);
    od = __builtin_amdgcn_mfma_f32_32x32x16_bf16(pa1, PK(l1, h1), od, 0, 0, 0); }
  { const s16x4 l2 = tr_read<v_rd_off(D0, 2, 0)>(vb), h2 = tr_read<v_rd_off(D0, 2, 1)>(vb), l3 = tr_read<v_rd_off(D0, 3, 0)>(vb), h3 = tr_read<v_rd_off(D0, 3, 1)>(vb);
    asm volatile("s_waitcnt lgkmcnt(0)" ::: "memory"); SBAR();
    od = __builtin_amdgcn_mfma_f32_32x32x16_bf16(pa2, PK(l2, h2), od, 0, 0, 0);
    od = __builtin_amdgcn_mfma_f32_32x32x16_bf16(pa3, PK(l3, h3), od, 0, 0, 0); }
#undef PK
}
__device__ __forceinline__ void pv_d0(f32x16* o, int vb, bf16x8 pa0, bf16x8 pa1, bf16x8 pa2, bf16x8 pa3) {
  pv_one<0>(o[0], vb, pa0, pa1, pa2, pa3); pv_one<1>(o[1], vb, pa0, pa1, pa2, pa3); pv_one<2>(o[2], vb, pa0, pa1, pa2, pa3); pv_one<3>(o[3], vb, pa0, pa1, pa2, pa3);
}

#define SM_CHUNK(c) do { _Pragma("unroll") for (int r = 2 * (c); r < 2 * (c) + 2; ++r) { \
    p0[r] = __builtin_amdgcn_exp2f(fmaf(-c2, fabsf(dq - (float)((r & 3) + 8 * (r >> 2))), p0[r])); p1[r] = fmaf(-c2, fabsf(dq - (float)(32 + (r & 3) + 8 * (r >> 2))), p1[r]); } } while (0)
#define RD4(X, D0, HF) do { X##0 = tr_read<v_rd_off(D0, 2 * (HF), 0)>(vb); X##1 = tr_read<v_rd_off(D0, 2 * (HF), 1)>(vb); X##2 = tr_read<v_rd_off(D0, 2 * (HF) + 1, 0)>(vb); X##3 = tr_read<v_rd_off(D0, 2 * (HF) + 1, 1)>(vb); } while (0)
#define PKV(L, H) (bf16x8){L[0], L[1], L[2], L[3], H[0], H[1], H[2], H[3]}
#define MM2(OD, X, PA, PB) do { OD = __builtin_amdgcn_mfma_f32_32x32x16_bf16(PA, PKV(X##0, X##1), OD, 0, 0, 0); OD = __builtin_amdgcn_mfma_f32_32x32x16_bf16(PB, PKV(X##2, X##3), OD, 0, 0, 0); } while (0)
#define WL4() asm volatile("s_waitcnt lgkmcnt(4)" ::: "memory")
__device__ __forceinline__ void pv_sm(f32x16* o, int vb, bf16x8 pa0, bf16x8 pa1, bf16x8 pa2, bf16x8 pa3, f32x16& p0, f32x16& p1, float dq, float c2) {
  s16x4 A0, A1, A2, A3, B0, B1, B2, B3;
  RD4(A, 0, 0);
  RD4(B, 1, 0); WL4(); SBAR(); MM2(o[0], A, pa0, pa1); SM_CHUNK(0); SBAR();
  RD4(A, 2, 0); WL4(); SBAR(); MM2(o[1], B, pa0, pa1); SM_CHUNK(1); SBAR();
  RD4(B, 3, 0); WL4(); SBAR(); MM2(o[2], A, pa0, pa1); SM_CHUNK(2); SBAR();
  RD4(A, 0, 1); WL4(); SBAR(); MM2(o[3], B, pa0, pa1); SM_CHUNK(3); SBAR();
  RD4(B, 1, 1); WL4(); SBAR(); MM2(o[0], A, pa2, pa3); SM_CHUNK(4); SBAR();
  RD4(A, 2, 1); WL4(); SBAR(); MM2(o[1], B, pa2, pa3); SM_CHUNK(5); SBAR();
  RD4(B, 3, 1); WL4(); SBAR(); MM2(o[2], A, pa2, pa3); SM_CHUNK(6); SBAR();
  asm volatile("s_waitcnt lgkmcnt(0)" ::: "memory"); SBAR(); MM2(o[3], B, pa2, pa3); SM_CHUNK(7); SBAR();
}
#undef SM_CHUNK
#undef RD4
#undef MM2
#undef WL4
#undef PKV

__device__ __forceinline__ void attn_unit(const bf16_t* __restrict__ P, bf16_t* __restrict__ MIX, const float* __restrict__ onw, float lam, int bh, int qb, int W, char* lds) {
  const int tid = threadIdx.x, wid = tid >> 6, lane = tid & 63, r32 = lane & 31, hi = lane >> 5;
  const int qg = wid & 3, map = wid >> 2, b = bh >> 2, h = bh & 3;
  const size_t tok0 = (size_t)b * SEQL; const int q0 = qb * 128;
  char* K_lds = lds; char* V_lds = lds + 3 * SHM_K;
  float* ws = (float*)(lds + 3 * SHM_V + 3 * SHM_K) + wid * 64; float* li_l = ws; float* al_l = ws + 32;
  const float c2 = LOG2E * (h == 0 ? 0.25f : h == 1 ? 0.0625f : h == 2 ? 0.015625f : 0.00390625f);
  const int qpos = q0 + qg * 32 + r32;
  float l_reg = 0; f32x16 o[4] = {}; bf16x8 qr[4];
  const int qbase = __builtin_amdgcn_readfirstlane(q0 + qg * 32);
  const bf16_t* Qw = P + (tok0 + qpos) * INW + h * 128 + map * 64 + hi * 8;
#pragma unroll
  for (int d0 = 0; d0 < 4; ++d0) qr[d0] = *reinterpret_cast<const bf16x8*>(Qw + d0 * 16);
  const bf16_t* Kh = P + tok0 * INW + 512 + h * 128; const bf16_t* Vh = P + tok0 * INW + 1024 + h * 128;
  const int sr = tid >> 4, sc = (tid & 15) * 8, vst0 = v_st(sr, sc), vst1 = v_st(32 + sr, sc);
  const int vb0 = (int)(uintptr_t)V_lds + v_rd_base(lane);
  struct { bf16x8 vs0, vs1, ks0, ks1; } sr_;
#define SLOAD(k0) do { sr_.vs0 = *(const bf16x8*)(&Vh[(size_t)((k0) + sr) * LDK + sc]); sr_.vs1 = *(const bf16x8*)(&Vh[(size_t)((k0) + 32 + sr) * LDK + sc]); \
    sr_.ks0 = *(const bf16x8*)(&Kh[(size_t)((k0) + sr) * LDK + sc]); sr_.ks1 = *(const bf16x8*)(&Kh[(size_t)((k0) + 32 + sr) * LDK + sc]); } while (0)
#define SWRITE(slot) do { *(bf16x8*)(V_lds + (slot) * SHM_V + vst0) = sr_.vs0;          \
    *(bf16x8*)(V_lds + (slot) * SHM_V + vst1) = sr_.vs1; const int kc = sc * 2;               \
    *(bf16x8*)(K_lds + (slot) * SHM_K + KSWZ(sr, kc)) = sr_.ks0;                       \
    *(bf16x8*)(K_lds + (slot) * SHM_K + KSWZ(32 + sr, kc)) = sr_.ks1; } while (0)
#define DQ(j) ((float)(qpos - (j) * KVBLK - 4 * hi))
  f32x16 pA0, pA1, pB0, pB1; bf16x8 pa0, pa1, pa2, pa3;
  int jlo = (q0 - W) / KVBLK; if (q0 - W < 0) jlo = 0;
  int jhi = (q0 + 127 + W) / KVBLK + 1; if (jhi > SEQL / KVBLK) jhi = SEQL / KVBLK;
  if ((jhi - jlo) & 1) { if (jhi < SEQL / KVBLK) ++jhi; else --jlo; }
  const int NT = jhi - jlo;
#define TK(i) ((jlo + (i)) * KVBLK)
  if (map == 1) __builtin_amdgcn_s_setprio(1);
  SLOAD(TK(0)); asm volatile("s_waitcnt vmcnt(0)" ::: "memory"); SWRITE(0);
  SLOAD(TK(1)); asm volatile("s_waitcnt vmcnt(0)" ::: "memory"); SWRITE(1);
  if (2 < NT) SLOAD(TK(2));
  __syncthreads();
  qkt(pA0, pA1, K_lds, qr, r32, hi, map); partialSM(pA0, pA1, DQ(jlo), c2);
  int sk = 1, sv = 0, sw = 2;
#define STEP(pC0, pC1, pP0, pP1, ii, more) do { \
    SBAR(); qkt(pC0, pC1, K_lds + sk * SHM_K, qr, r32, hi, map); \
    finishSM(pP0, pP1, l_reg, pa0, pa1, pa2, pa3); SBAR(); \
    asm volatile("s_waitcnt vmcnt(0)" ::: "memory"); SWRITE(sw); if (more) SLOAD(TK((ii) + 2)); SBAR(); \
    pv_sm(o, vb0 + sv * SHM_V, pa0, pa1, pa2, pa3, pC0, pC1, DQ(jlo + (ii)), c2); \
    __syncthreads(); \
    sv = sk; sk = sw; sw = (sw == 2) ? 0 : sw + 1; } while (0)
  for (int i = 1; i + 1 < NT; i += 2) {
    STEP(pB0, pB1, pA0, pA1, i, true);
    STEP(pA0, pA1, pB0, pB1, i + 1, (i + 3 < NT));
  }
  SBAR(); qkt(pB0, pB1, K_lds + sk * SHM_K, qr, r32, hi, map);
  finishSM(pA0, pA1, l_reg, pa0, pa1, pa2, pa3); SBAR();
  pv_sm(o, vb0 + sv * SHM_V, pa0, pa1, pa2, pa3, pB0, pB1, DQ(jlo + NT - 1), c2);
  finishSM(pB0, pB1, l_reg, pa0, pa1, pa2, pa3); SBAR();
  pv_d0(o, vb0 + sk * SHM_V, pa0, pa1, pa2, pa3);
#undef STEP
#undef TK
  __builtin_amdgcn_s_setprio(0);
  if (hi == 0) li_l[r32] = l_reg; asm volatile("s_waitcnt lgkmcnt(0)" ::: "memory");
  float rli[16];
#pragma unroll
  for (int r = 0; r < 16; ++r) rli[r] = __builtin_amdgcn_rcpf(li_l[crow(r, hi)]);
  __syncthreads();
  float* X = (float*)lds + qg * 4096;
  if (map == 1) {
#pragma unroll
    for (int r = 0; r < 16; ++r) { const float s = rli[r] * lam;
#pragma unroll
      for (int d0 = 0; d0 < 4; ++d0) X[crow(r, hi) * 128 + d0 * 32 + r32] = o[d0][r] * s; }
  }
  __syncthreads();
  if (map == 0) {
#pragma unroll
    for (int r = 0; r < 16; ++r) { float ss = 0.f;
#pragma unroll
      for (int d0 = 0; d0 < 4; ++d0) { const int ix = crow(r, hi) * 128 + d0 * 32 + r32; const float v = o[d0][r] * rli[r] - X[ix]; X[ix] = v; ss += v * v; }
#pragma unroll
      for (int of = 1; of < 32; of <<= 1) ss += __shfl_xor(ss, of);
      if (r32 == 0) al_l[crow(r, hi)] = __builtin_amdgcn_rsqf(ss * (1.f / 128.f) + NORM_EPS) * 0.8f;
    }
    asm volatile("s_waitcnt lgkmcnt(0)" ::: "memory");
    const int cc = lane & 15;
    float wv[8];
#pragma unroll
    for (int e = 0; e < 8; ++e) wv[e] = onw[cc * 8 + e];
    bf16_t* Ob = MIX + (tok0 + q0 + qg * 32 + (lane >> 4)) * DM + h * 128 + cc * 8;
    const float* Xr = X + (lane >> 4) * 128 + cc * 8;
#pragma unroll
    for (int it = 0; it < 8; ++it) {
      const f32x4 x0 = *(const f32x4*)(Xr + it * 512), x1 = *(const f32x4*)(Xr + it * 512 + 4); const float rs = al_l[it * 4 + (lane >> 4)];
      u32x4 w; w.x = cvtpk(x0[0] * rs * wv[0], x0[1] * rs * wv[1]); w.y = cvtpk(x0[2] * rs * wv[2], x0[3] * rs * wv[3]);
      w.z = cvtpk(x1[0] * rs * wv[4], x1[1] * rs * wv[5]); w.w = cvtpk(x1[2] * rs * wv[6], x1[3] * rs * wv[7]);
      *(u32x4*)(Ob + (size_t)it * 4 * DM) = w;
    }
  }
  __syncthreads();
#undef SLOAD
#undef SWRITE
#undef DQ
#undef REL
}
}

namespace rec {
constexpr int CH = 32, NCH = SEQL / CH, QP = 136, SP = 40;
constexpr int OFF_QT = 0, OFF_KH = CH * QP * 2, OFF_KT = 2 * CH * QP * 2, OFF_VT = OFF_KT + 128 * SP * 2, OFF_DD = OFF_VT + 128 * SP * 2, OFF_TOT = OFF_DD + 512, DIRB = OFF_TOT + 2048;
static_assert(DIRB % 16 == 0 && 2 * DIRB <= 131072, "rec LDS map");
__device__ __forceinline__ int crow(int r, int hi) { return (r & 3) + 8 * (r >> 2) + 4 * hi; }
__device__ __forceinline__ bf16x8 pack8(float a0, float a1, float a2, float a3, float a4, float a5, float a6, float a7) {
  u32x4 w = {cvtpk(a0, a1), cvtpk(a2, a3), cvtpk(a4, a5), cvtpk(a6, a7)}; return *reinterpret_cast<bf16x8*>(&w);
}
__device__ __forceinline__ void rec_unit(const bf16_t* __restrict__ P, bf16_t* __restrict__ OF, bf16_t* __restrict__ OB, int bh, unsigned char* ldsg) {
  const int tid = threadIdx.x, wid = __builtin_amdgcn_readfirstlane(tid >> 6), lane = tid & 63, r32 = lane & 31, hi = lane >> 5;
  const int dir = wid >> 2, wv = wid & 3, b = bh >> 2, h = bh & 3;
  unsigned char* lb = ldsg + dir * DIRB;
  bf16_t* Qt = (bf16_t*)(lb + OFF_QT); bf16_t* Kh = (bf16_t*)(lb + OFF_KH); bf16_t* KtT = (bf16_t*)(lb + OFF_KT); bf16_t* VT = (bf16_t*)(lb + OFF_VT);
  float* dd = (float*)(lb + OFF_DD); float* tot = (float*)(lb + OFF_TOT);
  const bf16_t* base = P + (size_t)b * SEQL * INW;
  const int cq = 1536 + h * 128 + 2 * lane, cgt = (dir ? 2560 : 2048) + h * 128 + 2 * lane, cv = 3072 + h * 128 + 2 * lane;
  bf16_t* O = (dir ? OB : OF) + (size_t)b * SEQL * 512 + h * 128 + wv * 32 + r32;
  f32x16 S[4];
#pragma unroll
  for (int k = 0; k < 4; ++k) S[k] = f32x16{};
  unsigned pq[8], pg[8], pv[8];
#define TOKOF(s) (dir ? (SEQL - 1 - (s)) : (s))
#define LOADCHUNK(c) do { _Pragma("unroll") for (int i = 0; i < 8; ++i) { const bf16_t* rp = base + (size_t)TOKOF((c) * CH + wv * 8 + i) * INW; \
    pq[i] = *(const unsigned*)(rp + cq); pg[i] = *(const unsigned*)(rp + cgt); pv[i] = *(const unsigned*)(rp + cv); } } while (0)
  LOADCHUNK(0);
#define RBAR() asm volatile("s_waitcnt lgkmcnt(0)\n\ts_barrier" ::: "memory")
  if (dir == 1) { RBAR(); RBAR(); }
  for (int c = 0; c < NCH; ++c) {
    float gl0[8], gl1[8]; float G0 = 0.f, G1 = 0.f;
#pragma unroll
    for (int i = 0; i < 8; ++i) { G0 += bf_lo(pg[i]); G1 += bf_hi(pg[i]); gl0[i] = G0; gl1[i] = G1; }
    *(f32x2*)&tot[wv * 128 + 2 * lane] = (f32x2){G0, G1};
    RBAR();
    float P0 = 0.f, P1 = 0.f, C0 = 0.f, C1 = 0.f;
#pragma unroll
    for (int w = 0; w < 4; ++w) { const f32x2 t = *(const f32x2*)&tot[w * 128 + 2 * lane]; if (w < wv) { P0 += t[0]; P1 += t[1]; } C0 += t[0]; C1 += t[1]; }
    float kta[8], ktb[8];
#pragma unroll
    for (int i = 0; i < 8; ++i) {
      const float Ga = P0 + gl0[i], Gb = P1 + gl1[i];
      const float kfa = 1.f - ex2(bf_lo(pg[i])), kfb = 1.f - ex2(bf_hi(pg[i]));
      *(unsigned*)&Qt[(wv * 8 + i) * QP + 2 * lane] = cvtpk(bf_lo(pq[i]) * ex2(Ga), bf_hi(pq[i]) * ex2(Gb));
      *(unsigned*)&Kh[(wv * 8 + i) * QP + 2 * lane] = cvtpk(kfa * ex2(fminf(-Ga, 100.f)), kfb * ex2(fminf(-Gb, 100.f)));
      kta[i] = kfa * ex2(C0 - Ga); ktb[i] = kfb * ex2(C1 - Gb);
    }
    *(bf16x8*)&KtT[(2 * lane) * SP + wv * 8] = pack8(kta[0], kta[1], kta[2], kta[3], kta[4], kta[5], kta[6], kta[7]);
    *(bf16x8*)&KtT[(2 * lane + 1) * SP + wv * 8] = pack8(ktb[0], ktb[1], ktb[2], ktb[3], ktb[4], ktb[5], ktb[6], ktb[7]);
    { u32x4 a, bb;
      a.x = (pv[0] & 0xffffu) | (pv[1] << 16); a.y = (pv[2] & 0xffffu) | (pv[3] << 16); a.z = (pv[4] & 0xffffu) | (pv[5] << 16); a.w = (pv[6] & 0xffffu) | (pv[7] << 16);
      bb.x = (pv[0] >> 16) | (pv[1] & 0xffff0000u); bb.y = (pv[2] >> 16) | (pv[3] & 0xffff0000u); bb.z = (pv[4] >> 16) | (pv[5] & 0xffff0000u); bb.w = (pv[6] >> 16) | (pv[7] & 0xffff0000u);
      *(u32x4*)&VT[(2 * lane) * SP + wv * 8] = a; *(u32x4*)&VT[(2 * lane + 1) * SP + wv * 8] = bb; }
    if (wv == 0) *(f32x2*)&dd[2 * lane] = (f32x2){ex2(C0), ex2(C1)};
    if (c + 1 < NCH) LOADCHUNK(c + 1);
    RBAR();
    f32x16 aT = f32x16{};
#pragma unroll
    for (int ks = 0; ks < 8; ++ks) { const bf16x8 a = *(const bf16x8*)&Kh[r32 * QP + ks * 16 + hi * 8]; const bf16x8 bq = *(const bf16x8*)&Qt[r32 * QP + ks * 16 + hi * 8];
      aT = __builtin_amdgcn_mfma_f32_32x32x16_bf16(a, bq, aT, 0, 0, 0); }
#pragma unroll
    for (int r = 0; r < 16; ++r) if (crow(r, hi) > r32) aT[r] = 0.f;
    f32x16 o = f32x16{};
#pragma unroll
    for (int kt = 0; kt < 4; ++kt)
#pragma unroll
      for (int hh = 0; hh < 2; ++hh) {
        const s16x4 lo4 = *(const s16x4*)&Qt[r32 * QP + kt * 32 + hh * 16 + hi * 4], hi4 = *(const s16x4*)&Qt[r32 * QP + kt * 32 + hh * 16 + 8 + hi * 4];
        const bf16x8 a = {lo4[0], lo4[1], lo4[2], lo4[3], hi4[0], hi4[1], hi4[2], hi4[3]};
        const bf16x8 bs = pack8(S[kt][hh * 8 + 0], S[kt][hh * 8 + 1], S[kt][hh * 8 + 2], S[kt][hh * 8 + 3], S[kt][hh * 8 + 4], S[kt][hh * 8 + 5], S[kt][hh * 8 + 6], S[kt][hh * 8 + 7]);
        o = __builtin_amdgcn_mfma_f32_32x32x16_bf16(a, bs, o, 0, 0, 0);
      }
#pragma unroll
    for (int hh = 0; hh < 2; ++hh) {
      const bf16x8 a = pack8(aT[hh * 8 + 0], aT[hh * 8 + 1], aT[hh * 8 + 2], aT[hh * 8 + 3], aT[hh * 8 + 4], aT[hh * 8 + 5], aT[hh * 8 + 6], aT[hh * 8 + 7]);
      const s16x4 lo4 = *(const s16x4*)&VT[(wv * 32 + r32) * SP + hh * 16 + hi * 4], hi4 = *(const s16x4*)&VT[(wv * 32 + r32) * SP + hh * 16 + 8 + hi * 4];
      const bf16x8 bv = {lo4[0], lo4[1], lo4[2], lo4[3], hi4[0], hi4[1], hi4[2], hi4[3]};
      o = __builtin_amdgcn_mfma_f32_32x32x16_bf16(a, bv, o, 0, 0, 0);
    }
    RBAR();
#pragma unroll
    for (int kt = 0; kt < 4; ++kt) {
#pragma unroll
      for (int q4 = 0; q4 < 4; ++q4) { const f32x4 d4 = *(const f32x4*)&dd[kt * 32 + q4 * 8 + hi * 4];
#pragma unroll
        for (int j = 0; j < 4; ++j) S[kt][q4 * 4 + j] *= d4[j]; }
#pragma unroll
      for (int ks = 0; ks < 2; ++ks) { const bf16x8 a = *(const bf16x8*)&KtT[(kt * 32 + r32) * SP + ks * 16 + hi * 8]; const bf16x8 bv = *(const bf16x8*)&VT[(wv * 32 + r32) * SP + ks * 16 + hi * 8];
        S[kt] = __builtin_amdgcn_mfma_f32_32x32x16_bf16(a, bv, S[kt], 0, 0, 0); }
    }
#pragma unroll
    for (int r = 0; r < 16; ++r) { const int tk = TOKOF(c * CH + crow(r, hi)); O[(size_t)tk * 512] = (bf16_t)(cvtpk(o[r], 0.f) & 0xffffu); }
    RBAR();
  }
  if (dir == 0) { RBAR(); RBAR(); }
  __syncthreads();
#undef RBAR
#undef TOKOF
#undef LOADCHUNK
}
}

#define XB_TMO      128
#define XB_XCNT(j)  (256  + 64 * (j))
#define XB_XSUB(j)  (1280 + 64 * (j))
#define XB_XGEN(j)  (2304 + 64 * (j))
#define XB_TOP      3328
#define XB_TOPGEN   3392
#define XCD_BAR_WORDS 3456
#define XB_SPIN_CAP (1u << 18)

__device__ __forceinline__ unsigned xb_ld(unsigned* p)              { return __hip_atomic_load(p, __ATOMIC_RELAXED, __HIP_MEMORY_SCOPE_AGENT); }
__device__ __forceinline__ unsigned xb_add(unsigned* p, unsigned v) { return __hip_atomic_fetch_add(p, v, __ATOMIC_RELAXED, __HIP_MEMORY_SCOPE_AGENT); }
__device__ __forceinline__ unsigned xb_xcc_id() { return (unsigned)__builtin_amdgcn_s_getreg((3 << 11) | 20) & 0xFu; }
#define XB_SPIN(cond, bar) do { unsigned _sp = 0; while (cond) { __builtin_amdgcn_s_sleep(1); \
    if ((++_sp & 255u) == 0u) { if (xb_ld(&(bar)[XB_TMO])) break; if (_sp > XB_SPIN_CAP) { atomicAdd(&(bar)[XB_TMO], 1u); break; } } } } while (0)

struct XcdBarrier {
    unsigned* bar; unsigned x;
    volatile LAS unsigned* st;
};

__device__ __forceinline__ XcdBarrier xcd_barrier_post(unsigned* bar, volatile LAS unsigned* st) {
    XcdBarrier b; b.bar = bar; b.x = xb_xcc_id(); b.st = st;
    if (threadIdx.x == 0) (void)xb_add(&bar[XB_XCNT(b.x)], 1u);
    return b;
}
__device__ __forceinline__ void xcd_barrier_complete(unsigned* bar, unsigned x, unsigned& nloc, unsigned& nx) {
    const unsigned G = gridDim.x * gridDim.y * gridDim.z;
    unsigned sum, cnt, mine, sp = 0u;
    for (;;) {
        sum = 0u; cnt = 0u; mine = 0u;
#pragma unroll
        for (unsigned j = 0; j < 16; ++j) { const unsigned c = xb_ld(&bar[XB_XCNT(j)]); sum += c; cnt += (c > 0u) ? 1u : 0u; mine = (j == x) ? c : mine; }
        if (sum == G) break;
        __builtin_amdgcn_s_sleep(1);
        if ((++sp & 255u) == 0u) { if (xb_ld(&bar[XB_TMO])) break; if (sp > XB_SPIN_CAP) { atomicAdd(&bar[XB_TMO], 1u); break; } }
    }
    nloc = mine > 0u ? mine : 1u; nx = cnt > 0u ? cnt : 1u;
}

__device__ __forceinline__ void xcd_barrier(const XcdBarrier& b) {
    asm volatile("s_waitcnt vmcnt(0)" ::: "memory");
    __syncthreads();
    if (threadIdx.x == 0) {
        unsigned* bar = b.bar;
        __builtin_amdgcn_s_waitcnt(0);
        unsigned nloc = b.st[0], nx = b.st[1];
        if (nloc == 0u) { xcd_barrier_complete(bar, b.x, nloc, nx); b.st[0] = nloc; b.st[1] = nx; }
        const unsigned old = xb_add(&bar[XB_XSUB(b.x)], 1u);
        const unsigned gen = old / nloc;
        if (old + 1u == (gen + 1u) * nloc) {
            __builtin_amdgcn_fence(__ATOMIC_RELEASE, "agent");
            asm volatile("s_waitcnt vmcnt(0)" ::: "memory");
            const unsigned og = xb_add(&bar[XB_TOP], 1u);
            const unsigned tg = og / nx;
            if (og + 1u == (tg + 1u) * nx) xb_add(&bar[XB_TOPGEN], 1u);
            else XB_SPIN(xb_ld(&bar[XB_TOPGEN]) == tg, bar);
            __builtin_amdgcn_fence(__ATOMIC_ACQUIRE, "agent");
            xb_add(&bar[XB_XGEN(b.x)], 1u);
            asm volatile("s_waitcnt vmcnt(0)" ::: "memory");
        } else {
            XB_SPIN(xb_ld(&bar[XB_XGEN(b.x)]) == gen, bar);
            __builtin_amdgcn_fence(__ATOMIC_ACQUIRE, "agent");
            asm volatile("s_waitcnt vmcnt(0)" ::: "memory");
        }
    }
    __syncthreads();
}

struct Args { const float* in[20]; float* out; unsigned char* ws; int ph_lo, ph_hi; };
constexpr int NPH = 9;
constexpr int N_ATT_UNITS = NSEQ * NHEAD * (SEQL / 128), N_REC_UNITS = NSEQ * NHEAD;

__global__ void __launch_bounds__(512, 2) fwd_kernel(Args args) {
    extern __shared__ __attribute__((aligned(16))) unsigned char lds[];
    cg::grid_group grid = cg::this_grid();
    const int wave = __builtin_amdgcn_readfirstlane((int)threadIdx.x >> 6);
#define PHASE_IDS int tid = threadIdx.x; asm volatile("" : "+v"(tid)); const int lane = tid & 63; (void)lane;
    const int G = gridDim.x, gw = blockIdx.x * 8 + wave, NGW = G * 8;
    unsigned char* ws = args.ws;
    const float* xp = args.in[0]; const float* xs = args.in[1];
    bf16_t* W_in = (bf16_t*)(ws + WS_WIN); bf16_t* W_out = (bf16_t*)(ws + WS_WOUT); bf16_t* W_up = (bf16_t*)(ws + WS_WUP); bf16_t* W_down = (bf16_t*)(ws + WS_WDOWN);
    bf16_t* XN = (bf16_t*)(ws + WS_XN); bf16_t* PROJ = (bf16_t*)(ws + WS_PROJ); bf16_t* OFb = (bf16_t*)(ws + WS_OF); bf16_t* OBb = (bf16_t*)(ws + WS_OB);
    bf16_t* ACT = (bf16_t*)(ws + WS_ACT); bf16_t* X1B = (bf16_t*)(ws + WS_OF);
    unsigned* ctl = (unsigned*)(ws + WS_CTL);
    PG8_LAS unsigned char* ldsl = (PG8_LAS unsigned char*)lds;
    const int lo = args.ph_lo, hi = args.ph_hi;
    volatile LAS unsigned* xst = (volatile LAS unsigned*)(ldsl + LDS_MISC + 64);
    if (threadIdx.x < 2) xst[threadIdx.x] = 0u;
    __syncthreads();
    XcdBarrier xbar; xbar.bar = ctl + 4096; xbar.x = 0; xbar.st = xst;
#ifndef PHMASK
#define PHMASK 0xffff
#endif
#define IN(k) (((PHMASK >> (k)) & 1) && lo <= (k) && (k) < hi)
#define SEAM(k) do { if (IN(k) && IN((k) + 1)) { if ((k) == 0) grid.sync(); else xcd_barrier(xbar); } } while (0)
#ifndef REPEAT_PH
#define REPEAT_PH -1
#endif
#define NREP(k) ((REPEAT_PH == (k)) ? 2 : 1)

    if (IN(0)) {
        PHASE_IDS
        if (blockIdx.x == 0) for (int i = tid; i < 8192; i += 512) ctl[i] = 0u;
        LAS float* scr = (LAS float*)(ldsl + wave * 16384);
        constexpr int I_IN = (DM / 64) * (INW / 32), I_OUT = (DM / 64) * (DM / 32), I_UP = (DM / 64) * (DFF2 / 32), I_DOWN = (DFF / 64) * (DM / 32);
        for (int it = gw; it < I_IN + I_OUT + I_UP + I_DOWN; it += NGW) {
            int r = it;
            if (r < I_IN) { p0_transpose_item(args.in[3], DM, INW, W_in, scr, r, lane); continue; } r -= I_IN;
            if (r < I_OUT) { p0_transpose_item(args.in[14], DM, DM, W_out, scr, r, lane); continue; } r -= I_OUT;
            if (r < I_UP) { p0_transpose_item(args.in[16], DM, DFF2, W_up, scr, r, lane, true); continue; } r -= I_UP;
            p0_transpose_item(args.in[19], DFF, DM, W_down, scr, r, lane);
        }
        for (int m = gw * 2; m < MTOK; m += NGW * 2) rms_row2_to_bf16(xrow_ptr(xp, xs, m), xrow_ptr(xp, xs, m + 1), args.in[2], XN + (size_t)m * DM, XN + (size_t)(m + 1) * DM, lane);
    }
    SEAM(0);
    if (IN(0) && IN(1)) xbar = xcd_barrier_post(ctl + 4096, xst);
    for (int rep = 0; rep < NREP(1); ++rep) { if (rep) grid.sync();
    if (IN(1)) {
        pg8::Gemm g{XN, W_in, MTOK, INW, DM}; pg8::StaticOrder S; S.init(MTOK, INW, G, (int)blockIdx.x);
        EpiInProj E{PROJ, args.in[11], args.in[12], args.in[4], args.in[5], (PG8_LAS float*)(ldsl + 131072)};
        pg8::gemm_phase<EpiInProj, pg8::StaticOrder, true, true>(ldsl, g, S, E);
    } }
    SEAM(1);
    for (int rep = 0; rep < NREP(3); ++rep) { if (rep) grid.sync();
    if (IN(3)) {
        PHASE_IDS
        float lam; int Wh[4];
        { const float a = args.in[6][lane] * args.in[7][lane], b = args.in[8][lane] * args.in[9][lane];
          lam = ex2(wave_sum(a) * LOG2E) - ex2(wave_sum(b) * LOG2E) + 0.2f;
          float mq = fabsf(args.in[4][lane]), mk = fabsf(args.in[5][lane]);
#pragma unroll
          for (int o = 1; o < 64; o <<= 1) { mq = fmaxf(mq, __shfl_xor(mq, o)); mk = fmaxf(mk, __shfl_xor(mk, o)); }
          const float S2 = 8.f * LOG2E * 1.01f * 1.01f * mq * mk;
#pragma unroll
          for (int h = 0; h < 4; ++h) { const float c2h = LOG2E * (h == 0 ? 0.25f : h == 1 ? 0.0625f : h == 2 ? 0.015625f : 0.00390625f);
            const float need = 2.f * S2 + 24.f + lg2(2.f / (1.f - ex2(-c2h)));
            const float wf = need / c2h; Wh[h] = wf >= (float)SEQL ? SEQL : (int)wf + 1; } }
#ifndef NO_REC
#ifndef REC_REPS
#define REC_REPS 1
#endif
        for (int rr2 = 0; rr2 < REC_REPS; ++rr2)
        for (int u = blockIdx.x; u < N_REC_UNITS; u += G) rec::rec_unit(PROJ, OFb, OBb, u, lds);
#endif
        volatile int* misc = (volatile int*)(lds + LDS_MISC);
        int myq = (int)(__builtin_amdgcn_s_getreg((3 << 11) | 20) & 7u);
        constexpr int QN = 320;
        for (int tries = 0; tries < 8;) {
            if (tid == 0) misc[0] = (int)atomicAdd(ctl + 64 + 32 * myq, 1u);
            __syncthreads();
            const int t = __builtin_amdgcn_readfirstlane(misc[0]);
            __syncthreads();
            if (t >= QN) { myq = (myq + 1) & 7; ++tries; continue; }
            int b, hh, qb;
            { int i2 = t, base = 0; hh = 3;
              for (int seg = 0; seg < 4; ++seg) { if (i2 < 64) { b = myq; qb = i2; hh = 3 - seg; base = 1; break; } i2 -= 64; if (i2 < 16) { b = 8 + (i2 >> 3); qb = 8 * myq + (i2 & 7); hh = 3 - seg; base = 1; break; } i2 -= 16; }
              (void)base; }
#ifndef NO_ATT
            att::attn_unit(PROJ, XN, args.in[10], lam, b * 4 + hh, qb, hh == 0 ? Wh[0] : hh == 1 ? Wh[1] : hh == 2 ? Wh[2] : Wh[3], (char*)lds);
#endif
        }
    } }
    SEAM(3);
    for (int rep = 0; rep < NREP(4); ++rep) { if (rep) grid.sync();
    if (IN(4)) {
        PHASE_IDS
        const int h4 = lane >> 4, c8 = (lane & 15) * 8;
        float w8[8];
#pragma unroll
        for (int e = 0; e < 8; ++e) w8[e] = args.in[13][c8 + e];
        for (int m0 = gw * 4; m0 < MTOK; m0 += NGW * 4) {
            u32x4 fa[4], fb[4], fg[4];
#pragma unroll
            for (int u = 0; u < 4; ++u) { const size_t m = m0 + u;
                fa[u] = *(const u32x4*)(OFb + m * 512 + h4 * 128 + c8); fb[u] = *(const u32x4*)(OBb + m * 512 + h4 * 128 + c8); fg[u] = *(const u32x4*)(PROJ + m * INW + 3584 + h4 * 128 + c8); }
#pragma unroll
            for (int u = 0; u < 4; ++u) {
                float v[8]; float sq = 0.f;
#pragma unroll
                for (int e = 0; e < 4; ++e) { v[2 * e] = bf_lo(fa[u][e]) + bf_lo(fb[u][e]); v[2 * e + 1] = bf_hi(fa[u][e]) + bf_hi(fb[u][e]); sq += v[2 * e] * v[2 * e] + v[2 * e + 1] * v[2 * e + 1]; }
                sq += __shfl_xor(sq, 1); sq += __shfl_xor(sq, 2); sq += __shfl_xor(sq, 4); sq += __shfl_xor(sq, 8);
                const float rs = __builtin_amdgcn_rsqf(sq * (1.f / 128.f) + NORM_EPS);
                u32x4 o;
#pragma unroll
                for (int e = 0; e < 4; ++e) o[e] = cvtpk(v[2 * e] * rs * w8[2 * e] * bf_lo(fg[u][e]), v[2 * e + 1] * rs * w8[2 * e + 1] * bf_hi(fg[u][e]));
                *(u32x4*)(XN + (size_t)(m0 + u) * DM + 512 + h4 * 128 + c8) = o;
            }
        }
    }
    }
    SEAM(4);
    for (int rep = 0; rep < NREP(5); ++rep) { if (rep) grid.sync();
    if (IN(5)) {
        pg8::Gemm g{XN, W_out, MTOK, DM, DM}; pg8::StaticOrder S; S.init(MTOK, DM, G, (int)blockIdx.x);
        EpiResidB E{xp, xs, X1B};
        pg8::gemm_phase<EpiResidB, pg8::StaticOrder, true, true>(ldsl, g, S, E);
    }
    }
    SEAM(5);
    for (int rep = 0; rep < NREP(6); ++rep) { if (rep) grid.sync();
    if (IN(6)) {
        PHASE_IDS
        for (int m = gw * 2; m < MTOK; m += NGW * 2) rms_rowb2_to_bf16(X1B + (size_t)m * DM, X1B + (size_t)(m + 1) * DM, args.in[15], XN + (size_t)m * DM, XN + (size_t)(m + 1) * DM, lane);
    }
    }
    SEAM(6);
    for (int rep = 0; rep < NREP(7); ++rep) { if (rep) grid.sync();
    if (IN(7)) {
        pg8::Gemm g{XN, W_up, NSEQ * 33 * 256, DFF2, DM}; pg8::StaticOrder S; S.init(NSEQ * 33 * 256, DFF2, G, (int)blockIdx.x); S.ovl = 1;
        EpiConvAct E{ACT, args.in[17], args.in[18], (PG8_LAS float*)(ldsl + 131072)};
        pg8::gemm_phase<EpiConvAct, pg8::StaticOrder, true, true>(ldsl, g, S, E);
    } }
    SEAM(7);
    if (IN(8)) {
        pg8::Gemm g{ACT, W_down, MTOK, DM, DFF}; pg8::StaticOrder S; S.init(MTOK, DM, G, (int)blockIdx.x);
        EpiFinal E{X1B, args.out};
        pg8::gemm_phase<EpiFinal, pg8::StaticOrder, true, true>(ldsl, g, S, E);
    }
#undef IN
#undef SEAM
}

#ifndef ONE_LAUNCH
#define ONE_LAUNCH 1
#endif
extern "C" void kernel_launch(void* const* d_in, const int* in_sizes, int n_in, void* d_out, int out_size, void* d_ws, size_t ws_size, hipStream_t stream) {
    static int grid = 0;
    if (grid == 0) {
        if (n_in != 20 || out_size != MTOK * DM || ws_size < WS_END) { fprintf(stderr, "kernel_launch: unexpected shapes n_in %d out %d ws %zu (need %zu)\n", n_in, out_size, ws_size, (size_t)WS_END); grid = -1; return; }
        int dev = 0, cus = 0, per_cu = 0;
        (void)hipGetDevice(&dev); (void)hipDeviceGetAttribute(&cus, hipDeviceAttributeMultiprocessorCount, dev);
        if (hipFuncSetAttribute((const void*)fwd_kernel, hipFuncAttributeMaxDynamicSharedMemorySize, LDS_BYTES) != hipSuccess) { fprintf(stderr, "kernel_launch: hipFuncSetAttribute failed\n"); grid = -1; return; }
        (void)hipOccupancyMaxActiveBlocksPerMultiprocessor(&per_cu, (const void*)fwd_kernel, 512, LDS_BYTES);
        if (per_cu < 1) { fprintf(stderr, "kernel_launch: occupancy query says %d\n", per_cu); per_cu = 1; }
        (void)hipGetLastError();
        grid = cus * per_cu;
    }
    if (grid < 0) return;
#if !ONE_LAUNCH
    (void)hipMemsetAsync((char*)d_ws + WS_CTL, 0, 32768, stream);
#endif
    Args a{};
    for (int i = 0; i < 20; ++i) a.in[i] = (const float*)d_in[i];
    a.out = (float*)d_out; a.ws = (unsigned char*)d_ws;
#if ONE_LAUNCH
    a.ph_lo = 0; a.ph_hi = NPH;
    void* kargs[] = {&a};
    hipError_t e = hipLaunchCooperativeKernel((const void*)fwd_kernel, dim3(grid), dim3(512), kargs, LDS_BYTES, stream);
    if (e != hipSuccess) fprintf(stderr, "cooperative launch failed: %s (grid %d)\n", hipGetErrorString(e), grid);
#else
    for (int p = 0; p < NPH; ++p) {
        a.ph_lo = p; a.ph_hi = p + 1;
        hipLaunchKernelGGL(fwd_kernel, dim3(grid), dim3(512), LDS_BYTES, stream, a);
    }
#endif
}
```

```cpp
#include <hip/hip_runtime.h>
#include <hip/hip_cooperative_groups.h>
#include <cstdio>
#include <cstdint>
namespace cg = cooperative_groups;

namespace pg8 {
#define PG8_LAS __attribute__((address_space(3)))
typedef unsigned short bf16_t;
typedef short bf16x8 __attribute__((ext_vector_type(8)));
typedef float f32x4 __attribute__((ext_vector_type(4)));
typedef unsigned u32x4 __attribute__((ext_vector_type(4)));
constexpr int BM = 256, BK = 64, HALF = 128, HTB = HALF * BK * 2  , STAGE_BYTES = 8 * HTB, NXCD = 8, WGM = 8;

__host__ __device__ __forceinline__ int lds_byte(int r, int c) { const int st = (r >> 4) * 2 + (c >> 5), rr = r & 15, cc = c & 31, ob = rr * 64 + cc * 2; return st * 1024 + (ob ^ (((ob >> 9) & 1) << 5)); }
__host__ __device__ __forceinline__ void stage_rc(int b, int& R, int& C) { const int st = b / 1024, sb = b % 1024, swz = sb ^ (((sb >> 9) & 1) << 5); R = (st >> 1) * 16 + swz / 64; C = (st & 1) * 32 + (swz % 64) / 2; }
__host__ __device__ __forceinline__ int perm32(int rho) { const int n = rho >> 4, i = rho & 15; return 8 * (i >> 2) + 4 * n + (i & 3); }

struct Unit { int pm, pn; };
struct Gemm { const bf16_t* A; const bf16_t* Bt; int M, N, K; };

struct StaticOrder {
    int nM, nN, nwg, G, c;
    __host__ __device__ void init(int M, int N, int G_, int c_) { nM = M / BM; nN = N / BM; nwg = nM * nN; G = G_; c = c_; }
    __host__ __device__ bool next(int i, Unit& u) const {
        const long L = (long)i * G + c; if (L >= nwg) return false;
        int wgid = (int)L; { const int q = nwg / NXCD, r = nwg % NXCD, xcd = wgid % NXCD, off = wgid / NXCD; wgid = (xcd < r ? xcd * (q + 1) : r * (q + 1) + (xcd - r) * q) + off; }
        const int nig = WGM * nN, gid = wgid / nig, fm = gid * WGM, gsz = (nM - fm) < WGM ? (nM - fm) : WGM;
        u.pm = fm + ((wgid % nig) % gsz); u.pn = (wgid % nig) / gsz; return true;
    }
    int ovl = 0;
    __device__ __forceinline__ long arow(const Unit& u) const { return ovl ? (long)(u.pm / 33) * 8192 + 252 * (u.pm % 33) - 1 : (long)u.pm * BM; }
    __device__ __forceinline__ void a_ready(const Unit&) const {}
    __device__ __forceinline__ void done(const Unit&) const {}
};

__device__ __forceinline__ unsigned cvt_pk_bf16(float lo, float hi) { unsigned r; asm volatile("v_cvt_pk_bf16_f32 %0, %1, %2" : "=v"(r) : "v"(lo), "v"(hi)); return r; }
typedef float f32x2 __attribute__((ext_vector_type(2)));
template <class Epi, class Sched, bool ALIGN_EPI = false, bool SP2 = false>
__device__ __forceinline__ void gemm_phase(PG8_LAS unsigned char* lds, const Gemm g, const Sched& S, const Epi& E) {
    int tid = threadIdx.x; asm volatile("" : "+v"(tid));
    const int wid = __builtin_amdgcn_readfirstlane(tid >> 6), lane = tid & 63, wr = wid >> 2, wc = wid & 3, fr = lane & 15, fq = lane >> 4;
    const int K = g.K, nt = K / BK;
    unsigned voffA[2], voffB[2];
#pragma unroll
    for (int i = 0; i < 2; ++i) { int R, C; stage_rc(tid * 16 + i * 8192, R, C); const int Rb = Epi::PERM ? ((R & ~31) + perm32(R & 31)) : R;
        const int Ra = S.ovl ? (126 * (R >> 6) + 4 * (R & 15) + ((R >> 4) & 3)) : R;
        voffA[i] = (unsigned)(Ra * K + C) * 2u; voffB[i] = (unsigned)(Rb * K + C) * 2u; }
    const size_t kstep = (size_t)(BK * 2);
    const size_t hstep = (size_t)HALF * K * 2;
    const size_t tstep = 2 * hstep;
    const size_t hstepA = S.ovl ? (size_t)64 * K * 2 : hstep;
    const unsigned ldsw = (unsigned)wid * 1024u;
    const int aoff = lds_byte(wr * 64 + fr, fq * 8), boff = lds_byte(wc * 32 + fr, fq * 8);
#define PG8_SA(b, h) (((b) * 2 + (h)) * HTB)
#define PG8_SB(b, h) ((4 + (b) * 2 + (h)) * HTB)
#define PG8_STAGE(bufoff, gbase, voff) do { _Pragma("unroll") for (int _i = 0; _i < 2; ++_i) \
        __builtin_amdgcn_global_load_lds((const unsigned*)((const char*)(gbase) + (voff)[_i]), (PG8_LAS unsigned*)(lds + (bufoff) + ldsw + _i * 8192), 16, 0, 0); } while (0)
#define PG8_LDA(dst, b, h) do { _Pragma("unroll") for (int m = 0; m < 4; ++m) _Pragma("unroll") for (int k = 0; k < 2; ++k) dst[m][k] = *(const PG8_LAS bf16x8*)(lds + PG8_SA(b, h) + aoff + m * 2048 + k * 1024); } while (0)
#define PG8_LDB(dst, b, h) do { _Pragma("unroll") for (int n = 0; n < 2; ++n) _Pragma("unroll") for (int k = 0; k < 2; ++k) dst[n][k] = *(const PG8_LAS bf16x8*)(lds + PG8_SB(b, h) + boff + n * 2048 + k * 1024); } while (0)
#define PG8_MMA(ai, bj, At, Bt) do { __builtin_amdgcn_s_setprio(1); _Pragma("unroll") for (int m = 0; m < 4; ++m) _Pragma("unroll") for (int n = 0; n < 2; ++n) _Pragma("unroll") for (int k = 0; k < 2; ++k) \
        acc[ai][bj][m][n] = __builtin_amdgcn_mfma_f32_16x16x32_bf16(Bt[n][k], At[m][k], acc[ai][bj][m][n], 0, 0, 0); __builtin_amdgcn_s_setprio(0); } while (0)
#define PG8_WAIT_V(n) asm volatile("s_waitcnt vmcnt(" #n ")" ::: "memory")
#define PG8_WAIT_L(n) asm volatile("s_waitcnt lgkmcnt(" #n ")" ::: "memory")
#define PG8_BAR __builtin_amdgcn_s_barrier()
#define PG8_SCHED __builtin_amdgcn_sched_barrier(0)
    Unit cur, nxt; int ui = 0;
    if (!S.next(0, cur)) return;
    f32x4 acc[2][2][4][2];
#pragma unroll
    for (int a = 0; a < 2; ++a)
#pragma unroll
        for (int b = 0; b < 2; ++b)
#pragma unroll
            for (int m = 0; m < 4; ++m)
#pragma unroll
                for (int n = 0; n < 2; ++n) acc[a][b][m][n] = (f32x4){0.f, 0.f, 0.f, 0.f};
    bf16x8 At[4][2], B0[2][2], B1[2][2];
    const long rowb = (long)K * 2;
    const char* cA = (const char*)g.A + S.arow(cur) * rowb; const char* cB = (const char*)g.Bt + (size_t)cur.pn * tstep;
    S.a_ready(cur);
    if constexpr (SP2) {
        PG8_STAGE(PG8_SB(0, 0), cB, voffB); PG8_STAGE(PG8_SB(0, 1), cB + hstep, voffB); PG8_STAGE(PG8_SA(0, 0), cA, voffA); PG8_STAGE(PG8_SA(0, 1), cA + hstepA, voffA);
        if (wr == 1) PG8_BAR;
        PG8_WAIT_V(2); PG8_BAR;
        PG8_STAGE(PG8_SB(1, 0), cB + kstep, voffB); PG8_STAGE(PG8_SA(1, 0), cA + kstep, voffA); PG8_STAGE(PG8_SB(1, 1), cB + hstep + kstep, voffB);
        PG8_WAIT_V(6); PG8_BAR;
    } else {
        PG8_STAGE(PG8_SB(0, 0), cB, voffB); PG8_STAGE(PG8_SA(0, 0), cA, voffA); PG8_STAGE(PG8_SB(0, 1), cB + hstep, voffB); PG8_STAGE(PG8_SA(0, 1), cA + hstepA, voffA);
        if (wr == 1) PG8_BAR;
        PG8_WAIT_V(4); PG8_BAR;
        PG8_STAGE(PG8_SB(1, 0), cB + kstep, voffB); PG8_STAGE(PG8_SA(1, 0), cA + kstep, voffA); PG8_STAGE(PG8_SB(1, 1), cB + hstep + kstep, voffB);
        PG8_WAIT_V(6); PG8_BAR;
    }
    for (;;) {
        const bool has_next = S.next(ui + 1, nxt);
        const char* nA = has_next ? (const char*)g.A + S.arow(nxt) * rowb : cA; const char* nB = has_next ? (const char*)g.Bt + (size_t)nxt.pn * tstep : cB;
        for (int t = 0; t < nt; t += 2) {
            const bool last = (t == nt - 2);
            const char* a1 = cA + (size_t)(t + 1) * kstep;
            const char* a2 = last ? nA : cA + (size_t)(t + 2) * kstep; const char* b2 = last ? nB : cB + (size_t)(t + 2) * kstep;
            const char* a3 = a2 + kstep; const char* b3 = b2 + kstep;
            if (last && has_next) S.a_ready(nxt);
            if constexpr (SP2) {
            PG8_LDB(B0, 0, 0); PG8_LDB(B1, 0, 1); PG8_SCHED; PG8_LDA(At, 0, 0); PG8_STAGE(PG8_SA(1, 1), a1 + hstepA, voffA);
            PG8_WAIT_V(8); PG8_WAIT_L(0); PG8_BAR; PG8_MMA(0, 0, At, B0); PG8_MMA(0, 1, At, B1); PG8_BAR; PG8_SCHED;
            PG8_LDA(At, 0, 1); PG8_STAGE(PG8_SB(0, 0), b2, voffB); PG8_STAGE(PG8_SB(0, 1), b2 + hstep, voffB); PG8_STAGE(PG8_SA(0, 0), a2, voffA);
            PG8_WAIT_V(8); PG8_WAIT_L(0); PG8_BAR; PG8_MMA(1, 0, At, B0); PG8_MMA(1, 1, At, B1); PG8_BAR; PG8_SCHED;
            PG8_LDB(B0, 1, 0); PG8_LDB(B1, 1, 1); PG8_SCHED; PG8_LDA(At, 1, 0); PG8_STAGE(PG8_SA(0, 1), a2 + hstepA, voffA);
            PG8_WAIT_V(8); PG8_WAIT_L(0); PG8_BAR; PG8_MMA(0, 0, At, B0); PG8_MMA(0, 1, At, B1); PG8_BAR; PG8_SCHED;
            PG8_LDA(At, 1, 1); PG8_STAGE(PG8_SB(1, 0), b3, voffB); PG8_STAGE(PG8_SB(1, 1), b3 + hstep, voffB); PG8_STAGE(PG8_SA(1, 0), a3, voffA);
            PG8_WAIT_V(8); PG8_WAIT_L(0); PG8_BAR; PG8_MMA(1, 0, At, B0); PG8_MMA(1, 1, At, B1); PG8_BAR; PG8_SCHED;
            } else {
            PG8_LDB(B0, 0, 0); PG8_SCHED; PG8_LDA(At, 0, 0); PG8_STAGE(PG8_SA(1, 1), a1 + hstepA, voffA);
            PG8_WAIT_L(8); PG8_BAR; PG8_WAIT_L(0); PG8_MMA(0, 0, At, B0); PG8_BAR; PG8_SCHED;
            PG8_LDB(B1, 0, 1); PG8_STAGE(PG8_SB(0, 0), b2, voffB);
            PG8_BAR; PG8_WAIT_L(0); PG8_MMA(0, 1, At, B1); PG8_BAR;
            PG8_LDA(At, 0, 1); PG8_STAGE(PG8_SA(0, 0), a2, voffA);
            PG8_BAR; PG8_WAIT_L(0); PG8_MMA(1, 0, At, B0); PG8_BAR; PG8_SCHED;
            PG8_STAGE(PG8_SB(0, 1), b2 + hstep, voffB);
            PG8_WAIT_V(6); PG8_BAR; PG8_MMA(1, 1, At, B1); PG8_BAR;
            PG8_LDB(B0, 1, 0); PG8_SCHED; PG8_LDA(At, 1, 0); PG8_STAGE(PG8_SA(0, 1), a2 + hstepA, voffA);
            PG8_WAIT_L(8); PG8_BAR; PG8_WAIT_L(0); PG8_MMA(0, 0, At, B0); PG8_BAR; PG8_SCHED;
            PG8_LDB(B1, 1, 1); PG8_STAGE(PG8_SB(1, 0), b3, voffB);
            PG8_BAR; PG8_WAIT_L(0); PG8_MMA(0, 1, At, B1); PG8_BAR;
            PG8_LDA(At, 1, 1); PG8_STAGE(PG8_SA(1, 0), a3, voffA);
            PG8_BAR; PG8_WAIT_L(0); PG8_MMA(1, 0, At, B0); PG8_BAR; PG8_SCHED;
            PG8_STAGE(PG8_SB(1, 1), b3 + hstep, voffB);
            PG8_WAIT_V(6); PG8_BAR; PG8_MMA(1, 1, At, B1); PG8_BAR;
            }
        }
        if constexpr (ALIGN_EPI) { if (wr == 0) PG8_BAR; }
        if constexpr (!Epi::AFTER_DRAIN) { E(acc, cur, wr, wc, fr, fq); S.done(cur); }
        if (!has_next) break;
#pragma unroll
        for (int a = 0; a < 2; ++a)
#pragma unroll
            for (int b = 0; b < 2; ++b)
#pragma unroll
                for (int m = 0; m < 4; ++m)
#pragma unroll
                    for (int n = 0; n < 2; ++n) acc[a][b][m][n] = (f32x4){0.f, 0.f, 0.f, 0.f};
        cur = nxt; cA = nA; cB = nB; ++ui;
        if constexpr (ALIGN_EPI) { if (wr == 1) PG8_BAR; }
    }
    PG8_WAIT_V(0);
    if constexpr (!ALIGN_EPI) { if (wr == 0) PG8_BAR; }
    PG8_BAR;
    if constexpr (Epi::AFTER_DRAIN) { E.fused(acc, cur, wr, wc, fr, fq, lds, wid, lane); S.done(cur); }
#undef PG8_SA
#undef PG8_SB
#undef PG8_STAGE
#undef PG8_LDA
#undef PG8_LDB
#undef PG8_MMA
#undef PG8_WAIT_V
#undef PG8_WAIT_L
#undef PG8_BAR
#undef PG8_SCHED
}
}

constexpr int DM = 1024, SEQL = 8192, NSEQ = 10, MTOK = NSEQ * SEQL, INW = 4096, DFF = 2816, DFF2 = 5632, NHEAD = 4;
constexpr int MPROMPT = 2 * SEQL;
constexpr float NORM_EPS = 1e-6f;
constexpr float LOG2E = 1.4426950408889634f;
typedef unsigned short bf16_t;
typedef short bf16x8 __attribute__((ext_vector_type(8)));
typedef short s16x4 __attribute__((ext_vector_type(4)));
typedef float f32x4 __attribute__((ext_vector_type(4)));
typedef float f32x16 __attribute__((ext_vector_type(16)));
typedef unsigned u32x4 __attribute__((ext_vector_type(4)));
typedef unsigned u32x2 __attribute__((ext_vector_type(2)));
typedef float f32x2 __attribute__((ext_vector_type(2)));
#define LAS __attribute__((address_space(3)))

constexpr size_t MiB = 1u << 20;
constexpr size_t WS_CTL = 0;
constexpr size_t WS_WIN = 1 * MiB;
constexpr size_t WS_WOUT = 9 * MiB;
constexpr size_t WS_WUP = 11 * MiB;
constexpr size_t WS_WDOWN = 22 * MiB;
constexpr size_t WS_XN = 32 * MiB;
constexpr size_t WS_PROJ = 192 * MiB;
constexpr size_t WS_OF = 832 * MiB;
constexpr size_t WS_OB = 912 * MiB;
constexpr size_t WS_U = 192 * MiB;
constexpr size_t WS_ACT = 192 * MiB;
constexpr size_t WS_END = 992 * MiB;
constexpr int NSLAB = 2, SLABROWS = MTOK / NSLAB;

constexpr int LDS_BYTES = 143360;
constexpr int LDS_MISC = 131072 + 8192;

__device__ __forceinline__ unsigned cvtpk(float lo, float hi) { unsigned r; asm("v_cvt_pk_bf16_f32 %0, %1, %2" : "=v"(r) : "v"(lo), "v"(hi)); return r; }
__device__ __forceinline__ float bf_lo(unsigned u) { return __uint_as_float(u << 16); }
__device__ __forceinline__ float bf_hi(unsigned u) { return __uint_as_float(u & 0xffff0000u); }
__device__ __forceinline__ float ex2(float x) { return __builtin_amdgcn_exp2f(x); }
__device__ __forceinline__ float lg2(float x) { return __builtin_amdgcn_logf(x); }
__device__ __forceinline__ float rcpf(float x) { return __builtin_amdgcn_rcpf(x); }
__device__ __forceinline__ float siluf(float x) { return x * rcpf(1.f + ex2(-x * LOG2E)); }
__device__ __forceinline__ float wave_sum(float v) {
#pragma unroll
    for (int o = 1; o < 64; o <<= 1) v += __shfl_xor(v, o);
    return v;
}
__device__ __forceinline__ const float* xrow_ptr(const float* xp, const float* xs, int row) {
    return row < MPROMPT ? xp + (size_t)row * DM : xs + (size_t)(row - MPROMPT) * DM;
}

struct EpiInProj {
    static constexpr bool PERM = true, AFTER_DRAIN = false;
    bf16_t* P; const float* lbf; const float* lbb; const float* qnw; const float* knw; PG8_LAS float* ex;
    __device__ __forceinline__ void operator()(const pg8::f32x4 (&acc)[2][2][4][2], const pg8::Unit& u, int wr, int wc, int fr, int fq) const {
        const int sec = u.pn >> 1;
        int row0 = u.pm * 256 + wr * 64 + fr, col0 = u.pn * 256 + wc * 32 + 8 * fq;
        asm volatile("" : "+v"(row0), "+v"(col0));
        if (sec < 2) {
            float ps[2][4][2];
#pragma unroll
            for (int ai = 0; ai < 2; ++ai)
#pragma unroll
                for (int m = 0; m < 4; ++m)
#pragma unroll
                    for (int bj = 0; bj < 2; ++bj) { float q = 0.f;
#pragma unroll
                        for (int n = 0; n < 2; ++n)
#pragma unroll
                            for (int e = 0; e < 4; ++e) q += acc[ai][bj][m][n][e] * acc[ai][bj][m][n][e];
                        q += __shfl_xor(q, 16); q += __shfl_xor(q, 32); ps[ai][m][bj] = q; }
            const int wid = wr * 4 + wc;
            if (fq == 0) {
#pragma unroll
                for (int ai = 0; ai < 2; ++ai)
#pragma unroll
                    for (int m = 0; m < 4; ++m)
#pragma unroll
                        for (int bj = 0; bj < 2; ++bj) ex[(wid * 16 + (ai * 8 + m * 2 + bj)) * 16 + fr] = ps[ai][m][bj];
            }
            asm volatile("s_waitcnt lgkmcnt(0)" ::: "memory"); __builtin_amdgcn_s_barrier();
            const float* nw = (sec == 0) ? qnw : knw; const float sc = (sec == 0) ? 0.125f * LOG2E : 1.f;
            float w8[8];
#pragma unroll
            for (int e = 0; e < 8; ++e) w8[e] = nw[32 * (wc & 1) + 8 * fq + e] * sc;
#pragma unroll
            for (int ai = 0; ai < 2; ++ai)
#pragma unroll
                for (int m = 0; m < 4; ++m) {
                    bf16_t* rowp = P + (size_t)(row0 + ai * 128 + m * 16) * INW + col0;
#pragma unroll
                    for (int bj = 0; bj < 2; ++bj) {
                        const float tot = ps[ai][m][bj] + ex[((wid ^ 1) * 16 + (ai * 8 + m * 2 + bj)) * 16 + fr];
                        const float rs = __builtin_amdgcn_rsqf(tot * (1.f / 64.f) + NORM_EPS);
                        const pg8::f32x4 v0 = acc[ai][bj][m][0], v1 = acc[ai][bj][m][1];
                        u32x4 w; w.x = cvtpk(v0[0] * rs * w8[0], v0[1] * rs * w8[1]); w.y = cvtpk(v0[2] * rs * w8[2], v0[3] * rs * w8[3]);
                        w.z = cvtpk(v1[0] * rs * w8[4], v1[1] * rs * w8[5]); w.w = cvtpk(v1[2] * rs * w8[6], v1[3] * rs * w8[7]);
                        __builtin_nontemporal_store(w, (u32x4*)(rowp + bj * 128));
                    }
                }
            return;
        }
        float lbv[2][8];
        if (sec == 4 || sec == 5) {
            const float* t = (sec == 4) ? lbf : lbb; const int cs = col0 - sec * 512;
#pragma unroll
            for (int bj = 0; bj < 2; ++bj)
#pragma unroll
                for (int e = 0; e < 8; ++e) { const int c = cs + bj * 128 + e; lbv[bj][e] = rcpf(1.f + ex2((t[512 + c] - t[c]) * LOG2E)); }
        }
#pragma unroll
        for (int ai = 0; ai < 2; ++ai)
#pragma unroll
            for (int m = 0; m < 4; ++m) {
                bf16_t* rowp = P + (size_t)(row0 + ai * 128 + m * 16) * INW + col0;
#pragma unroll
                for (int bj = 0; bj < 2; ++bj) {
                    float v[8];
#pragma unroll
                    for (int e = 0; e < 4; ++e) { v[e] = acc[ai][bj][m][0][e]; v[4 + e] = acc[ai][bj][m][1][e]; }
                    if (sec == 3 || sec == 7) {
#pragma unroll
                        for (int e = 0; e < 8; ++e) v[e] = siluf(v[e]);
                    } else if (sec == 4 || sec == 5) {
#pragma unroll
                        for (int e = 0; e < 8; ++e) { const float sg = rcpf(1.f + ex2(-v[e] * LOG2E)); const float lb = lbv[bj][e]; v[e] = lg2(lb + (1.f - lb) * sg); }
                    }
                    u32x4 w; w.x = cvtpk(v[0], v[1]); w.y = cvtpk(v[2], v[3]); w.z = cvtpk(v[4], v[5]); w.w = cvtpk(v[6], v[7]);
                    __builtin_nontemporal_store(w, (u32x4*)(rowp + bj * 128));
                }
            }
    }
};
struct EpiBf16Plain {
    static constexpr bool PERM = true, AFTER_DRAIN = false;
    bf16_t* O; int ldc;
    __device__ __forceinline__ void operator()(const pg8::f32x4 (&acc)[2][2][4][2], const pg8::Unit& u, int wr, int wc, int fr, int fq) const {
        int row0 = u.pm * 256 + wr * 64 + fr, col0 = u.pn * 256 + wc * 32 + 8 * fq;
        asm volatile("" : "+v"(row0), "+v"(col0));
#pragma unroll
        for (int ai = 0; ai < 2; ++ai)
#pragma unroll
            for (int m = 0; m < 4; ++m) {
                bf16_t* rowp = O + (size_t)(row0 + ai * 128 + m * 16) * ldc + col0;
#pragma unroll
                for (int bj = 0; bj < 2; ++bj) {
                    const pg8::f32x4 v0 = acc[ai][bj][m][0], v1 = acc[ai][bj][m][1];
                    u32x4 w; w.x = cvtpk(v0[0], v0[1]); w.y = cvtpk(v0[2], v0[3]); w.z = cvtpk(v1[0], v1[1]); w.w = cvtpk(v1[2], v1[3]);
                    *(u32x4*)(rowp + bj * 128) = w;
                }
            }
    }
};
struct EpiResid {
    static constexpr bool PERM = true, AFTER_DRAIN = false;
    const float* xp; const float* xs; float* out; int row_off; int self;
    __device__ __forceinline__ void operator()(const pg8::f32x4 (&acc)[2][2][4][2], const pg8::Unit& u, int wr, int wc, int fr, int fq) const {
        const int rowt = row_off + u.pm * 256;
        const float* rb = self ? (const float*)out + (size_t)rowt * DM : xrow_ptr(xp, xs, rowt);
        float* ob = out + (size_t)rowt * DM;
        int r0 = wr * 64 + fr, col0 = u.pn * 256 + wc * 32 + 8 * fq;
        asm volatile("" : "+v"(r0), "+v"(col0));
#pragma unroll
        for (int ai = 0; ai < 2; ++ai)
#pragma unroll
            for (int m = 0; m < 4; ++m) {
                const size_t ro = (size_t)(r0 + ai * 128 + m * 16) * DM + col0;
#pragma unroll
                for (int bj = 0; bj < 2; ++bj)
#pragma unroll
                    for (int n = 0; n < 2; ++n) {
                        const f32x4 r = *(const f32x4*)(rb + ro + bj * 128 + 4 * n);
                        const pg8::f32x4 a = acc[ai][bj][m][n];
                        f32x4 o; o[0] = r[0] + a[0]; o[1] = r[1] + a[1]; o[2] = r[2] + a[2]; o[3] = r[3] + a[3];
                        *(f32x4*)(ob + ro + bj * 128 + 4 * n) = o;
                    }
            }
    }
};

struct EpiResidB {
    static constexpr bool PERM = true, AFTER_DRAIN = false;
    const float* xp; const float* xs; bf16_t* X1B;
    __device__ __forceinline__ void operator()(const pg8::f32x4 (&acc)[2][2][4][2], const pg8::Unit& u, int wr, int wc, int fr, int fq) const {
        const int rowt = u.pm * 256;
        const float* rb = xrow_ptr(xp, xs, rowt);
        bf16_t* ob = X1B + (size_t)rowt * DM;
        int r0 = wr * 64 + fr, col0 = u.pn * 256 + wc * 32 + 8 * fq;
        asm volatile("" : "+v"(r0), "+v"(col0));
#pragma unroll
        for (int ai = 0; ai < 2; ++ai)
#pragma unroll
            for (int m = 0; m < 4; ++m) {
                const size_t ro = (size_t)(r0 + ai * 128 + m * 16) * DM + col0;
#pragma unroll
                for (int bj = 0; bj < 2; ++bj) {
                    const f32x4 ra = *(const f32x4*)(rb + ro + bj * 128), rc = *(const f32x4*)(rb + ro + bj * 128 + 4);
                    const pg8::f32x4 a = acc[ai][bj][m][0], c = acc[ai][bj][m][1];
                    u32x4 w; w.x = cvtpk(ra[0] + a[0], ra[1] + a[1]); w.y = cvtpk(ra[2] + a[2], ra[3] + a[3]); w.z = cvtpk(rc[0] + c[0], rc[1] + c[1]); w.w = cvtpk(rc[2] + c[2], rc[3] + c[3]);
                    *(u32x4*)(ob + ro + bj * 128) = w;
                }
            }
    }
};
struct EpiFinal {
    static constexpr bool PERM = true, AFTER_DRAIN = false;
    const bf16_t* X1B; float* out;
    __device__ __forceinline__ void operator()(const pg8::f32x4 (&acc)[2][2][4][2], const pg8::Unit& u, int wr, int wc, int fr, int fq) const {
        const int rowt = u.pm * 256;
        const bf16_t* rb = X1B + (size_t)rowt * DM;
        float* ob = out + (size_t)rowt * DM;
        int r0 = wr * 64 + fr, col0 = u.pn * 256 + wc * 32 + 8 * fq;
        asm volatile("" : "+v"(r0), "+v"(col0));
#pragma unroll
        for (int ai = 0; ai < 2; ++ai)
#pragma unroll
            for (int m = 0; m < 4; ++m) {
                const size_t ro = (size_t)(r0 + ai * 128 + m * 16) * DM + col0;
#pragma unroll
                for (int bj = 0; bj < 2; ++bj) {
                    const u32x4 r = *(const u32x4*)(rb + ro + bj * 128);
                    const pg8::f32x4 a = acc[ai][bj][m][0], c = acc[ai][bj][m][1];
                    f32x4 o0, o1;
                    o0[0] = bf_lo(r.x) + a[0]; o0[1] = bf_hi(r.x) + a[1]; o0[2] = bf_lo(r.y) + a[2]; o0[3] = bf_hi(r.y) + a[3];
                    o1[0] = bf_lo(r.z) + c[0]; o1[1] = bf_hi(r.z) + c[1]; o1[2] = bf_lo(r.w) + c[2]; o1[3] = bf_hi(r.w) + c[3];
                    *(f32x4*)(ob + ro + bj * 128) = o0; *(f32x4*)(ob + ro + bj * 128 + 4) = o1;
                }
            }
    }
};

#define DPP_SHR1 0x111
#define DPP_SHL1 0x101
#define DPP_ROR1 0x121
#define DPP_ROR15 0x12F
__device__ __forceinline__ float dppf(float old, float src, const int ctrl_sel) {
    int r;
    if (ctrl_sel == 0) r = __builtin_amdgcn_update_dpp(__float_as_int(old), __float_as_int(src), DPP_SHR1, 0xf, 0xf, false);
    else if (ctrl_sel == 1) r = __builtin_amdgcn_update_dpp(__float_as_int(old), __float_as_int(src), DPP_SHL1, 0xf, 0xf, false);
    else if (ctrl_sel == 2) r = __builtin_amdgcn_update_dpp(__float_as_int(old), __float_as_int(src), DPP_ROR1, 0xf, 0xf, false);
    else r = __builtin_amdgcn_update_dpp(__float_as_int(old), __float_as_int(src), DPP_ROR15, 0xf, 0xf, false);
    return __int_as_float(r);
}
struct EpiConvAct {
    static constexpr bool PERM = true, AFTER_DRAIN = false;
    bf16_t* ACT; const float* cw; const float* cb; PG8_LAS float* ex;
    __device__ __forceinline__ void operator()(const pg8::f32x4 (&acc)[2][2][4][2], const pg8::Unit& u, int wr, int wc, int fr, int fq) const {
        int seq = u.pm / 33, pt = u.pm % 33;
        asm volatile("" : "+s"(seq), "+s"(pt));
        const int t0 = 252 * pt - 1 + 126 * wr;
        int cl = wc * 32 + 8 * fq;
        asm volatile("" : "+v"(cl));
        const int chb = u.pn * 128 + cl;
#pragma unroll
        for (int n = 0; n < 2; ++n) {
            const int ch = chb + 4 * n;
            const f32x4 bg = *(const f32x4*)(cb + ch), bu = *(const f32x4*)(cb + DFF + ch);
            const f32x4 g0 = *(const f32x4*)(cw + ch), g1 = *(const f32x4*)(cw + DFF2 + ch), g2 = *(const f32x4*)(cw + 2 * DFF2 + ch);
            const f32x4 u0 = *(const f32x4*)(cw + DFF + ch), u1 = *(const f32x4*)(cw + DFF2 + DFF + ch), u2 = *(const f32x4*)(cw + 2 * DFF2 + DFF + ch);
#pragma unroll
            for (int ai = 0; ai < 2; ++ai) {
#pragma unroll
                for (int m = 0; m < 4; ++m) {
                    const int row = 64 * ai + 4 * fr + m, t = t0 + row;
                    const bool keep = (row >= 1) && (row <= 126) && (t < SEQL);
                    float o4[4];
#pragma unroll
                    for (int e = 0; e < 4; ++e) {
                        float cv[2];
#pragma unroll
                        for (int bj = 0; bj < 2; ++bj) {
                            const float X = acc[ai][bj][m][n][e];
                            float pv, nv;
                            if (m > 0) pv = acc[ai][bj][m > 0 ? m - 1 : 0][n][e];
                            else { const float ob = (ai == 1) ? dppf(0.f, acc[0][bj][3][n][e], 2) : 0.f; pv = dppf(ob, acc[ai][bj][3][n][e], 0); }
                            if (m < 3) nv = acc[ai][bj][m < 3 ? m + 1 : 3][n][e];
                            else { const float ob = (ai == 0) ? dppf(0.f, acc[1][bj][0][n][e], 3) : 0.f; nv = dppf(ob, acc[ai][bj][0][n][e], 1); }
                            if (m == 1) pv = (t == 0) ? 0.f : pv;
                            if (m == 2) nv = (t == SEQL - 1) ? 0.f : nv;
                            cv[bj] = bj == 0 ? bg[e] + g0[e] * pv + g1[e] * X + g2[e] * nv : bu[e] + u0[e] * pv + u1[e] * X + u2[e] * nv;
                        }
                        o4[e] = siluf(cv[0]) * cv[1];
                    }
                    if (keep) { u32x2 w; w.x = cvtpk(o4[0], o4[1]); w.y = cvtpk(o4[2], o4[3]); *(u32x2*)(ACT + ((size_t)seq * SEQL + t) * DFF + ch) = w; }
                }
            }
        }
    }
};

__device__ __forceinline__ void p0_transpose_item(const float* W, int K, int N, bf16_t* WT, LAS float* scr, int item, int lane, bool perm_up = false) {
    const int nblk = N / 32, kb = item / nblk, nb = item % nblk, k0 = 64 * kb, n0 = 32 * nb;
#pragma unroll 8
    for (int i = 0; i < 32; ++i) { const int kk = 2 * i + (lane >> 5); scr[kk * 33 + (lane & 31)] = W[(size_t)(k0 + kk) * N + n0 + (lane & 31)]; }
    asm volatile("s_waitcnt lgkmcnt(0)" ::: "memory");
    const int c = lane & 7;
#pragma unroll
    for (int j = 0; j < 4; ++j) { const int n = (lane >> 3) + 8 * j; const LAS float* s = scr + (8 * c) * 33 + n;
        u32x4 o; o.x = cvtpk(s[0 * 33], s[1 * 33]); o.y = cvtpk(s[2 * 33], s[3 * 33]); o.z = cvtpk(s[4 * 33], s[5 * 33]); o.w = cvtpk(s[6 * 33], s[7 * 33]);
        int nd = n0 + n; if (perm_up) { const int hf = nd / DFF, rr = nd - hf * DFF; nd = (rr >> 7) * 256 + hf * 128 + (rr & 127); }
        *(u32x4*)(WT + (size_t)nd * K + k0 + 8 * c) = o; }
    asm volatile("s_waitcnt lgkmcnt(0)" ::: "memory");
}
__device__ __forceinline__ void rms_row2_to_bf16(const float* xrow0, const float* xrow1, const float* w, bf16_t* orow0, bf16_t* orow1, int lane) {
    const f32x4* xr0 = (const f32x4*)xrow0 + lane; const f32x4* xr1 = (const f32x4*)xrow1 + lane; const f32x4* wr = (const f32x4*)w + lane;
    f32x4 v0[4], v1[4]; float s0 = 0.f, s1 = 0.f;
#pragma unroll
    for (int j = 0; j < 4; ++j) { v0[j] = xr0[64 * j]; v1[j] = xr1[64 * j]; }
#pragma unroll
    for (int j = 0; j < 4; ++j) { s0 += (v0[j][0] * v0[j][0] + v0[j][1] * v0[j][1]) + (v0[j][2] * v0[j][2] + v0[j][3] * v0[j][3]); s1 += (v1[j][0] * v1[j][0] + v1[j][1] * v1[j][1]) + (v1[j][2] * v1[j][2] + v1[j][3] * v1[j][3]); }
    const float r0 = __builtin_amdgcn_rsqf(wave_sum(s0) * (1.f / DM) + NORM_EPS), r1 = __builtin_amdgcn_rsqf(wave_sum(s1) * (1.f / DM) + NORM_EPS);
    u32x2* o0 = (u32x2*)orow0 + lane; u32x2* o1 = (u32x2*)orow1 + lane;
#pragma unroll
    for (int j = 0; j < 4; ++j) { const f32x4 ww = wr[64 * j]; u32x2 o;
        o.x = cvtpk(v0[j][0] * r0 * ww[0], v0[j][1] * r0 * ww[1]); o.y = cvtpk(v0[j][2] * r0 * ww[2], v0[j][3] * r0 * ww[3]); o0[64 * j] = o;
        o.x = cvtpk(v1[j][0] * r1 * ww[0], v1[j][1] * r1 * ww[1]); o.y = cvtpk(v1[j][2] * r1 * ww[2], v1[j][3] * r1 * ww[3]); o1[64 * j] = o; }
}
__device__ __forceinline__ void rms_rowb2_to_bf16(const bf16_t* xrow0, const bf16_t* xrow1, const float* w, bf16_t* orow0, bf16_t* orow1, int lane) {
    const u32x4 a0 = *((const u32x4*)xrow0 + lane), a1 = *((const u32x4*)xrow0 + 64 + lane), b0 = *((const u32x4*)xrow1 + lane), b1 = *((const u32x4*)xrow1 + 64 + lane);
    float va[16], vb[16]; float s0 = 0.f, s1 = 0.f;
#pragma unroll
    for (int e = 0; e < 4; ++e) { va[2 * e] = bf_lo(a0[e]); va[2 * e + 1] = bf_hi(a0[e]); va[8 + 2 * e] = bf_lo(a1[e]); va[8 + 2 * e + 1] = bf_hi(a1[e]);
        vb[2 * e] = bf_lo(b0[e]); vb[2 * e + 1] = bf_hi(b0[e]); vb[8 + 2 * e] = bf_lo(b1[e]); vb[8 + 2 * e + 1] = bf_hi(b1[e]); }
#pragma unroll
    for (int e = 0; e < 16; ++e) { s0 += va[e] * va[e]; s1 += vb[e] * vb[e]; }
    const float r0 = __builtin_amdgcn_rsqf(wave_sum(s0) * (1.f / DM) + NORM_EPS), r1 = __builtin_amdgcn_rsqf(wave_sum(s1) * (1.f / DM) + NORM_EPS);
    const f32x4 w0 = *((const f32x4*)w + 2 * lane), w1 = *((const f32x4*)w + 2 * lane + 1), w2 = *((const f32x4*)w + 128 + 2 * lane), w3 = *((const f32x4*)w + 128 + 2 * lane + 1);
    u32x4 o;
    o.x = cvtpk(va[0] * r0 * w0[0], va[1] * r0 * w0[1]); o.y = cvtpk(va[2] * r0 * w0[2], va[3] * r0 * w0[3]); o.z = cvtpk(va[4] * r0 * w1[0], va[5] * r0 * w1[1]); o.w = cvtpk(va[6] * r0 * w1[2], va[7] * r0 * w1[3]);
    *((u32x4*)orow0 + lane) = o;
    o.x = cvtpk(va[8] * r0 * w2[0], va[9] * r0 * w2[1]); o.y = cvtpk(va[10] * r0 * w2[2], va[11] * r0 * w2[3]); o.z = cvtpk(va[12] * r0 * w3[0], va[13] * r0 * w3[1]); o.w = cvtpk(va[14] * r0 * w3[2], va[15] * r0 * w3[3]);
    *((u32x4*)orow0 + 64 + lane) = o;
    o.x = cvtpk(vb[0] * r1 * w0[0], vb[1] * r1 * w0[1]); o.y = cvtpk(vb[2] * r1 * w0[2], vb[3] * r1 * w0[3]); o.z = cvtpk(vb[4] * r1 * w1[0], vb[5] * r1 * w1[1]); o.w = cvtpk(vb[6] * r1 * w1[2], vb[7] * r1 * w1[3]);
    *((u32x4*)orow1 + lane) = o;
    o.x = cvtpk(vb[8] * r1 * w2[0], vb[9] * r1 * w2[1]); o.y = cvtpk(vb[10] * r1 * w2[2], vb[11] * r1 * w2[3]); o.z = cvtpk(vb[12] * r1 * w3[0], vb[13] * r1 * w3[1]); o.w = cvtpk(vb[14] * r1 * w3[2], vb[15] * r1 * w3[3]);
    *((u32x4*)orow1 + 64 + lane) = o;
}

namespace att {
constexpr int KVBLK = 64, LDK = INW;
constexpr int SHM_V = KVBLK * 128 * 2, SHM_K = KVBLK * 128 * 2;
constexpr float THR2 = 11.5f;
#ifndef ATT_SDEPTH
#define ATT_SDEPTH 2
#endif
constexpr int SDEPTH = ATT_SDEPTH;
#define KSWZ(row, colB) ((row) * 256 + ((colB) ^ (((row) & 7) << 4)))
#define SBAR() __builtin_amdgcn_sched_barrier(0)
__device__ __forceinline__ int crow(int r, int hi) { return (r & 3) + 8 * (r >> 2) + 4 * hi; }
__device__ __forceinline__ unsigned cvtpkv(float lo, float hi) { unsigned r; asm volatile("v_cvt_pk_bf16_f32 %0, %1, %2" : "=v"(r) : "v"(lo), "v"(hi)); return r; }

__device__ __forceinline__ void partialSM(f32x16& p0, f32x16& p1, float dq, float c2) {
#pragma unroll
  for (int r = 0; r < 16; ++r) { p0[r] = fmaf(-c2, fabsf(dq - (float)((r & 3) + 8 * (r >> 2))), p0[r]); p1[r] = fmaf(-c2, fabsf(dq - (float)(32 + (r & 3) + 8 * (r >> 2))), p1[r]); }
#pragma unroll
  for (int r = 0; r < 16; ++r) p0[r] = __builtin_amdgcn_exp2f(p0[r]);
}
__device__ __forceinline__ void finishSM(f32x16& p0, f32x16& p1, float& l_reg, bf16x8& pa0, bf16x8& pa1, bf16x8& pa2, bf16x8& pa3) {
#pragma unroll
  for (int r = 0; r < 16; ++r) p1[r] = __builtin_amdgcn_exp2f(p1[r]);
  float ps = 0;
#pragma unroll
  for (int r = 0; r < 16; ++r) ps += p0[r];
#pragma unroll
  for (int r = 0; r < 16; ++r) ps += p1[r];
  { auto rr = __builtin_amdgcn_permlane32_swap(__float_as_uint(ps), __float_as_uint(ps), false, false);
    ps = __uint_as_float(rr[0]) + __uint_as_float(rr[1]); }
  l_reg += ps;
#define PK4(P, BASE, OUT) do { unsigned a0 = cvtpkv(P[BASE + 0], P[BASE + 1]), a1 = cvtpkv(P[BASE + 2], P[BASE + 3]);   \
    unsigned b0 = cvtpkv(P[BASE + 4], P[BASE + 5]), b1 = cvtpkv(P[BASE + 6], P[BASE + 7]);                              \
    auto r0 = __builtin_amdgcn_permlane32_swap(a0, b0, false, false); auto r1 = __builtin_amdgcn_permlane32_swap(a1, b1, false, false); \
    u32x4 w = {r0[0], r1[0], r0[1], r1[1]}; OUT = *reinterpret_cast<bf16x8*>(&w); } while (0)
  PK4(p0, 0, pa0); PK4(p0, 8, pa1); PK4(p1, 0, pa2); PK4(p1, 8, pa3);
#undef PK4
}
__device__ __forceinline__ void qkt(f32x16& p0, f32x16& p1, const char* Ks, const bf16x8* qr, int r32, int hi, int map) {
  p0 = f32x16{}; p1 = f32x16{};
#pragma unroll
  for (int d0 = 0; d0 < 4; ++d0) { const int cb = (map * 64 + d0 * 16 + hi * 8) * 2;
    bf16x8 b0 = *reinterpret_cast<const bf16x8*>(Ks + KSWZ(r32, cb));
    bf16x8 b1 = *reinterpret_cast<const bf16x8*>(Ks + KSWZ(32 + r32, cb));
    p0 = __builtin_amdgcn_mfma_f32_32x32x16_bf16(b0, qr[d0], p0, 0, 0, 0);
    p1 = __builtin_amdgcn_mfma_f32_32x32x16_bf16(b1, qr[d0], p1, 0, 0, 0); }
}
__device__ __forceinline__ int v_st(int k, int c) { const int kk = (k & ~0xC) | ((k & 4) << 1) | ((k & 8) >> 1); return ((kk >> 3) * 4 + (c >> 5)) * 512 + ((kk & 7) * 32 + (c & 31)) * 2; }
__device__ __forceinline__ int v_rd_base(int lane) { return ((lane & 3) << 3) | (((lane >> 2) & 3) << 6) | (((lane >> 4) & 1) << 5) | (((lane >> 5) & 1) << 8); }
constexpr int v_rd_off(int d0, int ks, int half) { return d0 * 512 + ks * 4096 + half * 2048; }
template <int OFF> __device__ __forceinline__ s16x4 tr_read(int vb) {
  s16x4 r; asm volatile("ds_read_b64_tr_b16 %0, %1 offset:%2" : "=&v"(r) : "v"(vb), "i"(OFF) : "memory"); return r;
}
template <int D0> __device__ __forceinline__ void pv_one(f32x16& od, int vb, bf16x8 pa0, bf16x8 pa1, bf16x8 pa2, bf16x8 pa3) {
#define PK(L, H) (bf16x8){L[0], L[1], L[2], L[3], H[0], H[1], H[2], H[3]}
  { const s16x4 l0 = tr_read<v_rd_off(D0, 0, 0)>(vb), h0 = tr_read<v_rd_off(D0, 0, 1)>(vb), l1 = tr_read<v_rd_off(D0, 1, 0)>(vb), h1 = tr_read<v_rd_off(D0, 1, 1)>(vb);
    asm volatile("s_waitcnt lgkmcnt(0)" ::: "memory"); SBAR();
    od = __builtin_amdgcn_mfma_f32_32x32x16_bf16(pa0, PK(l0, h0), od, 0, 0, 0);
    od = __builtin_amdgcn_mfma_f32_32x32x16_bf16(pa1, PK(l1, h1), od, 0, 0, 0); }
  { const s16x4 l2 = tr_read<v_rd_off(D0, 2, 0)>(vb), h2 = tr_read<v_rd_off(D0, 2, 1)>(vb), l3 = tr_read<v_rd_off(D0, 3, 0)>(vb), h3 = tr_read<v_rd_off(D0, 3, 1)>(vb);
    asm volatile("s_waitcnt lgkmcnt(0)" ::: "memory"); SBAR();
    od = __builtin_amdgcn_mfma_f32_32x32x16_bf16(pa2, PK(l2, h2), od, 0, 0, 0);
    od = __builtin_amdgcn_mfma_f32_32x32x16_bf16(pa3, PK(l3, h3), od, 0, 0, 0); }
#undef PK
}
__device__ __forceinline__ void pv_d0(f32x16* o, int vb, bf16x8 pa0, bf16x8 pa1, bf16x8 pa2, bf16x8 pa3) {
  pv_one<0>(o[0], vb, pa0, pa1, pa2, pa3); pv_one<1>(o[1], vb, pa0, pa1, pa2, pa3); pv_one<2>(o[2], vb, pa0, pa1, pa2, pa3); pv_one<3>(o[3], vb, pa0, pa1, pa2, pa3);
}

#define SM_CHUNK(c) do { _Pragma("unroll") for (int r = 2 * (c); r < 2 * (c) + 2; ++r) { \
    p0[r] = __builtin_amdgcn_exp2f(fmaf(-c2, fabsf(dq - (float)((r & 3) + 8 * (r >> 2))), p0[r])); p1[r] = fmaf(-c2, fabsf(dq - (float)(32 + (r & 3) + 8 * (r >> 2))), p1[r]); } } while (0)
#define RD4(X, D0, HF) do { X##0 = tr_read<v_rd_off(D0, 2 * (HF), 0)>(vb); X##1 = tr_read<v_rd_off(D0, 2 * (HF), 1)>(vb); X##2 = tr_read<v_rd_off(D0, 2 * (HF) + 1, 0)>(vb); X##3 = tr_read<v_rd_off(D0, 2 * (HF) + 1, 1)>(vb); } while (0)
#define PKV(L, H) (bf16x8){L[0], L[1], L[2], L[3], H[0], H[1], H[2], H[3]}
#define MM2(OD, X, PA, PB) do { OD = __builtin_amdgcn_mfma_f32_32x32x16_bf16(PA, PKV(X##0, X##1), OD, 0, 0, 0); OD = __builtin_amdgcn_mfma_f32_32x32x16_bf16(PB, PKV(X##2, X##3), OD, 0, 0, 0); } while (0)
#define WL4() asm volatile("s_waitcnt lgkmcnt(4)" ::: "memory")
__device__ __forceinline__ void pv_sm(f32x16* o, int vb, bf16x8 pa0, bf16x8 pa1, bf16x8 pa2, bf16x8 pa3, f32x16& p0, f32x16& p1, float dq, float c2) {
  s16x4 A0, A1, A2, A3, B0, B1, B2, B3;
  RD4(A, 0, 0);
  RD4(B, 1, 0); WL4(); SBAR(); MM2(o[0], A, pa0, pa1); SM_CHUNK(0); SBAR();
  RD4(A, 2, 0); WL4(); SBAR(); MM2(o[1], B, pa0, pa1); SM_CHUNK(1); SBAR();
  RD4(B, 3, 0); WL4(); SBAR(); MM2(o[2], A, pa0, pa1); SM_CHUNK(2); SBAR();
  RD4(A, 0, 1); WL4(); SBAR(); MM2(o[3], B, pa0, pa1); SM_CHUNK(3); SBAR();
  RD4(B, 1, 1); WL4(); SBAR(); MM2(o[0], A, pa2, pa3); SM_CHUNK(4); SBAR();
  RD4(A, 2, 1); WL4(); SBAR(); MM2(o[1], B, pa2, pa3); SM_CHUNK(5); SBAR();
  RD4(B, 3, 1); WL4(); SBAR(); MM2(o[2], A, pa2, pa3); SM_CHUNK(6); SBAR();
  asm volatile("s_waitcnt lgkmcnt(0)" ::: "memory"); SBAR(); MM2(o[3], B, pa2, pa3); SM_CHUNK(7); SBAR();
}
#undef SM_CHUNK
#undef RD4
#undef MM2
#undef WL4
#undef PKV

__device__ __forceinline__ void attn_unit(const bf16_t* __restrict__ P, bf16_t* __restrict__ MIX, const float* __restrict__ onw, float lam, int bh, int qb, int W, char* lds) {
  const int tid = threadIdx.x, wid = tid >> 6, lane = tid & 63, r32 = lane & 31, hi = lane >> 5;
  const int qg = wid & 3, map = wid >> 2, b = bh >> 2, h = bh & 3;
  const size_t tok0 = (size_t)b * SEQL; const int q0 = qb * 128;
  char* K_lds = lds; char* V_lds = lds + 3 * SHM_K;
  float* ws = (float*)(lds + 3 * SHM_V + 3 * SHM_K) + wid * 64; float* li_l = ws; float* al_l = ws + 32;
  const float c2 = LOG2E * (h == 0 ? 0.25f : h == 1 ? 0.0625f : h == 2 ? 0.015625f : 0.00390625f);
  const int qpos = q0 + qg * 32 + r32;
  float l_reg = 0; f32x16 o[4] = {}; bf16x8 qr[4];
  const int qbase = __builtin_amdgcn_readfirstlane(q0 + qg * 32);
  const bf16_t* Qw = P + (tok0 + qpos) * INW + h * 128 + map * 64 + hi * 8;
#pragma unroll
  for (int d0 = 0; d0 < 4; ++d0) qr[d0] = *reinterpret_cast<const bf16x8*>(Qw + d0 * 16);
  const bf16_t* Kh = P + tok0 * INW + 512 + h * 128; const bf16_t* Vh = P + tok0 * INW + 1024 + h * 128;
  const int sr = tid >> 4, sc = (tid & 15) * 8, vst0 = v_st(sr, sc), vst1 = v_st(32 + sr, sc);
  const int vb0 = (int)(uintptr_t)V_lds + v_rd_base(lane);
  struct { bf16x8 vs0, vs1, ks0, ks1; } sr_;
#define SLOAD(k0) do { sr_.vs0 = *(const bf16x8*)(&Vh[(size_t)((k0) + sr) * LDK + sc]); sr_.vs1 = *(const bf16x8*)(&Vh[(size_t)((k0) + 32 + sr) * LDK + sc]); \
    sr_.ks0 = *(const bf16x8*)(&Kh[(size_t)((k0) + sr) * LDK + sc]); sr_.ks1 = *(const bf16x8*)(&Kh[(size_t)((k0) + 32 + sr) * LDK + sc]); } while (0)
#define SWRITE(slot) do { *(bf16x8*)(V_lds + (slot) * SHM_V + vst0) = sr_.vs0;          \
    *(bf16x8*)(V_lds + (slot) * SHM_V + vst1) = sr_.vs1; const int kc = sc * 2;               \
    *(bf16x8*)(K_lds + (slot) * SHM_K + KSWZ(sr, kc)) = sr_.ks0;                       \
    *(bf16x8*)(K_lds + (slot) * SHM_K + KSWZ(32 + sr, kc)) = sr_.ks1; } while (0)
#define DQ(j) ((float)(qpos - (j) * KVBLK - 4 * hi))
  f32x16 pA0, pA1, pB0, pB1; bf16x8 pa0, pa1, pa2, pa3;
  int jlo = (q0 - W) / KVBLK; if (q0 - W < 0) jlo = 0;
  int jhi = (q0 + 127 + W) / KVBLK + 1; if (jhi > SEQL / KVBLK) jhi = SEQL / KVBLK;
  if ((jhi - jlo) & 1) { if (jhi < SEQL / KVBLK) ++jhi; else --jlo; }
  const int NT = jhi - jlo;
#define TK(i) ((jlo + (i)) * KVBLK)
  if (map == 1) __builtin_amdgcn_s_setprio(1);
  {
    const bf16x8 v20 = *(const bf16x8*)(&Vh[(size_t)(TK(1) + sr) * LDK + sc]), v21 = *(const bf16x8*)(&Vh[(size_t)(TK(1) + 32 + sr) * LDK + sc]);
    const bf16x8 k20 = *(const bf16x8*)(&Kh[(size_t)(TK(1) + sr) * LDK + sc]), k21 = *(const bf16x8*)(&Kh[(size_t)(TK(1) + 32 + sr) * LDK + sc]);
    SLOAD(TK(0)); asm volatile("s_waitcnt vmcnt(0)" ::: "memory"); SWRITE(0);
    sr_.vs0 = v20; sr_.vs1 = v21; sr_.ks0 = k20; sr_.ks1 = k21; SWRITE(1); }
  if (2 < NT) SLOAD(TK(2));
  __syncthreads();
  qkt(pA0, pA1, K_lds, qr, r32, hi, map); partialSM(pA0, pA1, DQ(jlo), c2);
  int sk = 1, sv = 0, sw = 2;
#define STEP(pC0, pC1, pP0, pP1, ii, more) do { \
    SBAR(); qkt(pC0, pC1, K_lds + sk * SHM_K, qr, r32, hi, map); \
    finishSM(pP0, pP1, l_reg, pa0, pa1, pa2, pa3); SBAR(); \
    asm volatile("s_waitcnt vmcnt(0)" ::: "memory"); SWRITE(sw); if (more) SLOAD(TK((ii) + 2)); SBAR(); \
    pv_sm(o, vb0 + sv * SHM_V, pa0, pa1, pa2, pa3, pC0, pC1, DQ(jlo + (ii)), c2); \
    __syncthreads(); \
    sv = sk; sk = sw; sw = (sw == 2) ? 0 : sw + 1; } while (0)
  for (int i = 1; i + 1 < NT; i += 2) {
    STEP(pB0, pB1, pA0, pA1, i, true);
    STEP(pA0, pA1, pB0, pB1, i + 1, (i + 3 < NT));
  }
  SBAR(); qkt(pB0, pB1, K_lds + sk * SHM_K, qr, r32, hi, map);
  finishSM(pA0, pA1, l_reg, pa0, pa1, pa2, pa3); SBAR();
  pv_sm(o, vb0 + sv * SHM_V, pa0, pa1, pa2, pa3, pB0, pB1, DQ(jlo + NT - 1), c2);
  finishSM(pB0, pB1, l_reg, pa0, pa1, pa2, pa3); SBAR();
  pv_d0(o, vb0 + sk * SHM_V, pa0, pa1, pa2, pa3);
#undef STEP
#undef TK
  __builtin_amdgcn_s_setprio(0);
  if (hi == 0) li_l[r32] = l_reg; asm volatile("s_waitcnt lgkmcnt(0)" ::: "memory");
  float rli[16];
#pragma unroll
  for (int r = 0; r < 16; ++r) rli[r] = __builtin_amdgcn_rcpf(li_l[crow(r, hi)]);
  __syncthreads();
  float* X = (float*)lds + qg * 4096;
  if (map == 1) {
#pragma unroll
    for (int r = 0; r < 16; ++r) { const float s = rli[r] * lam;
#pragma unroll
      for (int d0 = 0; d0 < 4; ++d0) X[crow(r, hi) * 128 + d0 * 32 + r32] = o[d0][r] * s; }
  }
  __syncthreads();
  if (map == 0) {
#pragma unroll
    for (int r = 0; r < 16; ++r) { float ss = 0.f;
#pragma unroll
      for (int d0 = 0; d0 < 4; ++d0) { const int ix = crow(r, hi) * 128 + d0 * 32 + r32; const float v = o[d0][r] * rli[r] - X[ix]; X[ix] = v; ss += v * v; }
#pragma unroll
      for (int of = 1; of < 32; of <<= 1) ss += __shfl_xor(ss, of);
      if (r32 == 0) al_l[crow(r, hi)] = __builtin_amdgcn_rsqf(ss * (1.f / 128.f) + NORM_EPS) * 0.8f;
    }
    asm volatile("s_waitcnt lgkmcnt(0)" ::: "memory");
    const int cc = lane & 15;
    float wv[8];
#pragma unroll
    for (int e = 0; e < 8; ++e) wv[e] = onw[cc * 8 + e];
    bf16_t* Ob = MIX + (tok0 + q0 + qg * 32 + (lane >> 4)) * DM + h * 128 + cc * 8;
    const float* Xr = X + (lane >> 4) * 128 + cc * 8;
#pragma unroll
    for (int it = 0; it < 8; ++it) {
      const f32x4 x0 = *(const f32x4*)(Xr + it * 512), x1 = *(const f32x4*)(Xr + it * 512 + 4); const float rs = al_l[it * 4 + (lane >> 4)];
      u32x4 w; w.x = cvtpk(x0[0] * rs * wv[0], x0[1] * rs * wv[1]); w.y = cvtpk(x0[2] * rs * wv[2], x0[3] * rs * wv[3]);
      w.z = cvtpk(x1[0] * rs * wv[4], x1[1] * rs * wv[5]); w.w = cvtpk(x1[2] * rs * wv[6], x1[3] * rs * wv[7]);
      *(u32x4*)(Ob + (size_t)it * 4 * DM) = w;
    }
  }
  __syncthreads();
#undef SLOAD
#undef SWRITE
#undef DQ
#undef REL
}
}

namespace rec {
constexpr int CH = 32, NCH = SEQL / CH, QP = 136, SP = 40;
constexpr int OFF_QT = 0, OFF_KH = CH * QP * 2, OFF_KT = 2 * CH * QP * 2, OFF_VT = OFF_KT + 128 * SP * 2, OFF_DD = OFF_VT + 128 * SP * 2, OFF_TOT = OFF_DD + 512, DIRB = OFF_TOT + 2048;
static_assert(DIRB % 16 == 0 && 2 * DIRB <= 131072, "rec LDS map");
__device__ __forceinline__ int crow(int r, int hi) { return (r & 3) + 8 * (r >> 2) + 4 * hi; }
__device__ __forceinline__ bf16x8 pack8(float a0, float a1, float a2, float a3, float a4, float a5, float a6, float a7) {
  u32x4 w = {cvtpk(a0, a1), cvtpk(a2, a3), cvtpk(a4, a5), cvtpk(a6, a7)}; return *reinterpret_cast<bf16x8*>(&w);
}
__device__ __forceinline__ void rec_unit(const bf16_t* __restrict__ P, bf16_t* __restrict__ OF, bf16_t* __restrict__ OB, int bh, unsigned char* ldsg) {
  const int tid = threadIdx.x, wid = __builtin_amdgcn_readfirstlane(tid >> 6), lane = tid & 63, r32 = lane & 31, hi = lane >> 5;
  const int dir = wid >> 2, wv = wid & 3, b = bh >> 2, h = bh & 3;
  unsigned char* lb = ldsg + dir * DIRB;
  bf16_t* Qt = (bf16_t*)(lb + OFF_QT); bf16_t* Kh = (bf16_t*)(lb + OFF_KH); bf16_t* KtT = (bf16_t*)(lb + OFF_KT); bf16_t* VT = (bf16_t*)(lb + OFF_VT);
  float* dd = (float*)(lb + OFF_DD); float* tot = (float*)(lb + OFF_TOT);
  const bf16_t* base = P + (size_t)b * SEQL * INW;
  const int cq = 1536 + h * 128 + 2 * lane, cgt = (dir ? 2560 : 2048) + h * 128 + 2 * lane, cv = 3072 + h * 128 + 2 * lane;
  bf16_t* O = (dir ? OB : OF) + (size_t)b * SEQL * 512 + h * 128 + wv * 32 + r32;
  f32x16 S[4];
#pragma unroll
  for (int k = 0; k < 4; ++k) S[k] = f32x16{};
  unsigned pq[8], pg[8], pv[8];
#define TOKOF(s) (dir ? (SEQL - 1 - (s)) : (s))
#define LOADCHUNK(c) do { _Pragma("unroll") for (int i = 0; i < 8; ++i) { const bf16_t* rp = base + (size_t)TOKOF((c) * CH + wv * 8 + i) * INW; \
    pq[i] = *(const unsigned*)(rp + cq); pg[i] = *(const unsigned*)(rp + cgt); pv[i] = *(const unsigned*)(rp + cv); } } while (0)
  LOADCHUNK(0);
#define RBAR() asm volatile("s_waitcnt lgkmcnt(0)\n\ts_barrier" ::: "memory")
  if (dir == 1) { RBAR(); RBAR(); }
  for (int c = 0; c < NCH; ++c) {
    float gl0[8], gl1[8]; float G0 = 0.f, G1 = 0.f;
#pragma unroll
    for (int i = 0; i < 8; ++i) { G0 += bf_lo(pg[i]); G1 += bf_hi(pg[i]); gl0[i] = G0; gl1[i] = G1; }
    *(f32x2*)&tot[wv * 128 + 2 * lane] = (f32x2){G0, G1};
    RBAR();
    float P0 = 0.f, P1 = 0.f, C0 = 0.f, C1 = 0.f;
#pragma unroll
    for (int w = 0; w < 4; ++w) { const f32x2 t = *(const f32x2*)&tot[w * 128 + 2 * lane]; if (w < wv) { P0 += t[0]; P1 += t[1]; } C0 += t[0]; C1 += t[1]; }
    float kta[8], ktb[8];
#pragma unroll
    for (int i = 0; i < 8; ++i) {
      const float Ga = P0 + gl0[i], Gb = P1 + gl1[i];
      const float kfa = 1.f - ex2(bf_lo(pg[i])), kfb = 1.f - ex2(bf_hi(pg[i]));
      *(unsigned*)&Qt[(wv * 8 + i) * QP + 2 * lane] = cvtpk(bf_lo(pq[i]) * ex2(Ga), bf_hi(pq[i]) * ex2(Gb));
      *(unsigned*)&Kh[(wv * 8 + i) * QP + 2 * lane] = cvtpk(kfa * ex2(fminf(-Ga, 100.f)), kfb * ex2(fminf(-Gb, 100.f)));
      kta[i] = kfa * ex2(C0 - Ga); ktb[i] = kfb * ex2(C1 - Gb);
    }
    *(bf16x8*)&KtT[(2 * lane) * SP + wv * 8] = pack8(kta[0], kta[1], kta[2], kta[3], kta[4], kta[5], kta[6], kta[7]);
    *(bf16x8*)&KtT[(2 * lane + 1) * SP + wv * 8] = pack8(ktb[0], ktb[1], ktb[2], ktb[3], ktb[4], ktb[5], ktb[6], ktb[7]);
    { u32x4 a, bb;
      a.x = (pv[0] & 0xffffu) | (pv[1] << 16); a.y = (pv[2] & 0xffffu) | (pv[3] << 16); a.z = (pv[4] & 0xffffu) | (pv[5] << 16); a.w = (pv[6] & 0xffffu) | (pv[7] << 16);
      bb.x = (pv[0] >> 16) | (pv[1] & 0xffff0000u); bb.y = (pv[2] >> 16) | (pv[3] & 0xffff0000u); bb.z = (pv[4] >> 16) | (pv[5] & 0xffff0000u); bb.w = (pv[6] >> 16) | (pv[7] & 0xffff0000u);
      *(u32x4*)&VT[(2 * lane) * SP + wv * 8] = a; *(u32x4*)&VT[(2 * lane + 1) * SP + wv * 8] = bb; }
    if (wv == 0) *(f32x2*)&dd[2 * lane] = (f32x2){ex2(C0), ex2(C1)};
    if (c + 1 < NCH) LOADCHUNK(c + 1);
    RBAR();
    f32x16 aT = f32x16{};
#pragma unroll
    for (int ks = 0; ks < 8; ++ks) { const bf16x8 a = *(const bf16x8*)&Kh[r32 * QP + ks * 16 + hi * 8]; const bf16x8 bq = *(const bf16x8*)&Qt[r32 * QP + ks * 16 + hi * 8];
      aT = __builtin_amdgcn_mfma_f32_32x32x16_bf16(a, bq, aT, 0, 0, 0); }
#pragma unroll
    for (int r = 0; r < 16; ++r) if (crow(r, hi) > r32) aT[r] = 0.f;
    f32x16 o = f32x16{};
#pragma unroll
    for (int kt = 0; kt < 4; ++kt)
#pragma unroll
      for (int hh = 0; hh < 2; ++hh) {
        const s16x4 lo4 = *(const s16x4*)&Qt[r32 * QP + kt * 32 + hh * 16 + hi * 4], hi4 = *(const s16x4*)&Qt[r32 * QP + kt * 32 + hh * 16 + 8 + hi * 4];
        const bf16x8 a = {lo4[0], lo4[1], lo4[2], lo4[3], hi4[0], hi4[1], hi4[2], hi4[3]};
        const bf16x8 bs = pack8(S[kt][hh * 8 + 0], S[kt][hh * 8 + 1], S[kt][hh * 8 + 2], S[kt][hh * 8 + 3], S[kt][hh * 8 + 4], S[kt][hh * 8 + 5], S[kt][hh * 8 + 6], S[kt][hh * 8 + 7]);
        o = __builtin_amdgcn_mfma_f32_32x32x16_bf16(a, bs, o, 0, 0, 0);
      }
#pragma unroll
    for (int hh = 0; hh < 2; ++hh) {
      const bf16x8 a = pack8(aT[hh * 8 + 0], aT[hh * 8 + 1], aT[hh * 8 + 2], aT[hh * 8 + 3], aT[hh * 8 + 4], aT[hh * 8 + 5], aT[hh * 8 + 6], aT[hh * 8 + 7]);
      const s16x4 lo4 = *(const s16x4*)&VT[(wv * 32 + r32) * SP + hh * 16 + hi * 4], hi4 = *(const s16x4*)&VT[(wv * 32 + r32) * SP + hh * 16 + 8 + hi * 4];
      const bf16x8 bv = {lo4[0], lo4[1], lo4[2], lo4[3], hi4[0], hi4[1], hi4[2], hi4[3]};
      o = __builtin_amdgcn_mfma_f32_32x32x16_bf16(a, bv, o, 0, 0, 0);
    }
    RBAR();
#pragma unroll
    for (int kt = 0; kt < 4; ++kt) {
#pragma unroll
      for (int q4 = 0; q4 < 4; ++q4) { const f32x4 d4 = *(const f32x4*)&dd[kt * 32 + q4 * 8 + hi * 4];
#pragma unroll
        for (int j = 0; j < 4; ++j) S[kt][q4 * 4 + j] *= d4[j]; }
#pragma unroll
      for (int ks = 0; ks < 2; ++ks) { const bf16x8 a = *(const bf16x8*)&KtT[(kt * 32 + r32) * SP + ks * 16 + hi * 8]; const bf16x8 bv = *(const bf16x8*)&VT[(wv * 32 + r32) * SP + ks * 16 + hi * 8];
        S[kt] = __builtin_amdgcn_mfma_f32_32x32x16_bf16(a, bv, S[kt], 0, 0, 0); }
    }
#pragma unroll
    for (int r = 0; r < 16; ++r) { const int tk = TOKOF(c * CH + crow(r, hi)); O[(size_t)tk * 512] = (bf16_t)(cvtpk(o[r], 0.f) & 0xffffu); }
    RBAR();
  }
  if (dir == 0) { RBAR(); RBAR(); }
  __syncthreads();
#undef RBAR
#undef TOKOF
#undef LOADCHUNK
}
}

#define XB_TMO      128
#define XB_XCNT(j)  (256  + 64 * (j))
#define XB_XSUB(j)  (1280 + 64 * (j))
#define XB_XGEN(j)  (2304 + 64 * (j))
#define XB_TOP      3328
#define XB_TOPGEN   3392
#define XCD_BAR_WORDS 3456
#define XB_SPIN_CAP (1u << 18)

__device__ __forceinline__ unsigned xb_ld(unsigned* p)              { return __hip_atomic_load(p, __ATOMIC_RELAXED, __HIP_MEMORY_SCOPE_AGENT); }
__device__ __forceinline__ unsigned xb_add(unsigned* p, unsigned v) { return __hip_atomic_fetch_add(p, v, __ATOMIC_RELAXED, __HIP_MEMORY_SCOPE_AGENT); }
__device__ __forceinline__ unsigned xb_xcc_id() { return (unsigned)__builtin_amdgcn_s_getreg((3 << 11) | 20) & 0xFu; }
#define XB_SPIN(cond, bar) do { unsigned _sp = 0; while (cond) { __builtin_amdgcn_s_sleep(1); \
    if ((++_sp & 255u) == 0u) { if (xb_ld(&(bar)[XB_TMO])) break; if (_sp > XB_SPIN_CAP) { atomicAdd(&(bar)[XB_TMO], 1u); break; } } } } while (0)

struct XcdBarrier {
    unsigned* bar; unsigned x;
    volatile LAS unsigned* st;
};

__device__ __forceinline__ XcdBarrier xcd_barrier_post(unsigned* bar, volatile LAS unsigned* st) {
    XcdBarrier b; b.bar = bar; b.x = xb_xcc_id(); b.st = st;
    if (threadIdx.x == 0) (void)xb_add(&bar[XB_XCNT(b.x)], 1u);
    return b;
}
__device__ __forceinline__ void xcd_barrier_complete(unsigned* bar, unsigned x, unsigned& nloc, unsigned& nx) {
    const unsigned G = gridDim.x * gridDim.y * gridDim.z;
    unsigned sum, cnt, mine, sp = 0u;
    for (;;) {
        sum = 0u; cnt = 0u; mine = 0u;
#pragma unroll
        for (unsigned j = 0; j < 16; ++j) { const unsigned c = xb_ld(&bar[XB_XCNT(j)]); sum += c; cnt += (c > 0u) ? 1u : 0u; mine = (j == x) ? c : mine; }
        if (sum == G) break;
        __builtin_amdgcn_s_sleep(1);
        if ((++sp & 255u) == 0u) { if (xb_ld(&bar[XB_TMO])) break; if (sp > XB_SPIN_CAP) { atomicAdd(&bar[XB_TMO], 1u); break; } }
    }
    nloc = mine > 0u ? mine : 1u; nx = cnt > 0u ? cnt : 1u;
}

__device__ __forceinline__ void xcd_barrier(const XcdBarrier& b) {
    asm volatile("s_waitcnt vmcnt(0)" ::: "memory");
    __syncthreads();
    if (threadIdx.x == 0) {
        unsigned* bar = b.bar;
        __builtin_amdgcn_s_waitcnt(0);
        unsigned nloc = b.st[0], nx = b.st[1];
        if (nloc == 0u) { xcd_barrier_complete(bar, b.x, nloc, nx); b.st[0] = nloc; b.st[1] = nx; }
        const unsigned old = xb_add(&bar[XB_XSUB(b.x)], 1u);
        const unsigned gen = old / nloc;
        if (old + 1u == (gen + 1u) * nloc) {
            __builtin_amdgcn_fence(__ATOMIC_RELEASE, "agent");
            asm volatile("s_waitcnt vmcnt(0)" ::: "memory");
            const unsigned og = xb_add(&bar[XB_TOP], 1u);
            const unsigned tg = og / nx;
            if (og + 1u == (tg + 1u) * nx) xb_add(&bar[XB_TOPGEN], 1u);
            else XB_SPIN(xb_ld(&bar[XB_TOPGEN]) == tg, bar);
            __builtin_amdgcn_fence(__ATOMIC_ACQUIRE, "agent");
            xb_add(&bar[XB_XGEN(b.x)], 1u);
            asm volatile("s_waitcnt vmcnt(0)" ::: "memory");
        } else {
            XB_SPIN(xb_ld(&bar[XB_XGEN(b.x)]) == gen, bar);
            __builtin_amdgcn_fence(__ATOMIC_ACQUIRE, "agent");
            asm volatile("s_waitcnt vmcnt(0)" ::: "memory");
        }
    }
    __syncthreads();
}

struct Args { const float* in[20]; float* out; unsigned char* ws; int ph_lo, ph_hi; };
constexpr int NPH = 9;
constexpr int N_ATT_UNITS = NSEQ * NHEAD * (SEQL / 128), N_REC_UNITS = NSEQ * NHEAD;

__global__ void __launch_bounds__(512, 2) fwd_kernel(Args args) {
    extern __shared__ __attribute__((aligned(16))) unsigned char lds[];
    cg::grid_group grid = cg::this_grid();
    const int wave = __builtin_amdgcn_readfirstlane((int)threadIdx.x >> 6);
#define PHASE_IDS int tid = threadIdx.x; asm volatile("" : "+v"(tid)); const int lane = tid & 63; (void)lane;
    const int G = gridDim.x, gw = blockIdx.x * 8 + wave, NGW = G * 8;
    unsigned char* ws = args.ws;
    const float* xp = args.in[0]; const float* xs = args.in[1];
    bf16_t* W_in = (bf16_t*)(ws + WS_WIN); bf16_t* W_out = (bf16_t*)(ws + WS_WOUT); bf16_t* W_up = (bf16_t*)(ws + WS_WUP); bf16_t* W_down = (bf16_t*)(ws + WS_WDOWN);
    bf16_t* XN = (bf16_t*)(ws + WS_XN); bf16_t* PROJ = (bf16_t*)(ws + WS_PROJ); bf16_t* OFb = (bf16_t*)(ws + WS_OF); bf16_t* OBb = (bf16_t*)(ws + WS_OB);
    bf16_t* ACT = (bf16_t*)(ws + WS_ACT); bf16_t* X1B = (bf16_t*)(ws + WS_OF);
    unsigned* ctl = (unsigned*)(ws + WS_CTL);
    PG8_LAS unsigned char* ldsl = (PG8_LAS unsigned char*)lds;
    const int lo = args.ph_lo, hi = args.ph_hi;
    volatile LAS unsigned* xst = (volatile LAS unsigned*)(ldsl + LDS_MISC + 64);
    if (threadIdx.x < 2) xst[threadIdx.x] = 0u;
    __syncthreads();
    XcdBarrier xbar; xbar.bar = ctl + 4096; xbar.x = 0; xbar.st = xst;
#ifndef PHMASK
#define PHMASK 0xffff
#endif
#define IN(k) (((PHMASK >> (k)) & 1) && lo <= (k) && (k) < hi)
#define SEAM(k) do { if (IN(k) && IN((k) + 1)) { if ((k) == 0) grid.sync(); else xcd_barrier(xbar); } } while (0)
#ifndef REPEAT_PH
#define REPEAT_PH -1
#endif
#define NREP(k) ((REPEAT_PH == (k)) ? 2 : 1)

    if (IN(0)) {
        PHASE_IDS
        if (blockIdx.x == 0) for (int i = tid; i < 8192; i += 512) ctl[i] = 0u;
        LAS float* scr = (LAS float*)(ldsl + wave * 16384);
        constexpr int I_IN = (DM / 64) * (INW / 32), I_OUT = (DM / 64) * (DM / 32), I_UP = (DM / 64) * (DFF2 / 32), I_DOWN = (DFF / 64) * (DM / 32);
        for (int it = gw; it < I_IN + I_OUT + I_UP + I_DOWN; it += NGW) {
            int r = it;
            if (r < I_IN) { p0_transpose_item(args.in[3], DM, INW, W_in, scr, r, lane); continue; } r -= I_IN;
            if (r < I_OUT) { p0_transpose_item(args.in[14], DM, DM, W_out, scr, r, lane); continue; } r -= I_OUT;
            if (r < I_UP) { p0_transpose_item(args.in[16], DM, DFF2, W_up, scr, r, lane, true); continue; } r -= I_UP;
            p0_transpose_item(args.in[19], DFF, DM, W_down, scr, r, lane);
        }
        for (int m = gw * 2; m < MTOK; m += NGW * 2) rms_row2_to_bf16(xrow_ptr(xp, xs, m), xrow_ptr(xp, xs, m + 1), args.in[2], XN + (size_t)m * DM, XN + (size_t)(m + 1) * DM, lane);
    }
    SEAM(0);
    if (IN(0) && IN(1)) xbar = xcd_barrier_post(ctl + 4096, xst);
    for (int rep = 0; rep < NREP(1); ++rep) { if (rep) grid.sync();
    if (IN(1)) {
        pg8::Gemm g{XN, W_in, MTOK, INW, DM}; pg8::StaticOrder S; S.init(MTOK, INW, G, (int)blockIdx.x);
        EpiInProj E{PROJ, args.in[11], args.in[12], args.in[4], args.in[5], (PG8_LAS float*)(ldsl + 131072)};
        pg8::gemm_phase<EpiInProj, pg8::StaticOrder, true, true>(ldsl, g, S, E);
    } }
    SEAM(1);
    for (int rep = 0; rep < NREP(3); ++rep) { if (rep) grid.sync();
    if (IN(3)) {
        PHASE_IDS
        float lam; int Wh[4];
        { const float a = args.in[6][lane] * args.in[7][lane], b = args.in[8][lane] * args.in[9][lane];
          lam = ex2(wave_sum(a) * LOG2E) - ex2(wave_sum(b) * LOG2E) + 0.2f;
          float mq = fabsf(args.in[4][lane]), mk = fabsf(args.in[5][lane]);
#pragma unroll
          for (int o = 1; o < 64; o <<= 1) { mq = fmaxf(mq, __shfl_xor(mq, o)); mk = fmaxf(mk, __shfl_xor(mk, o)); }
          const float S2 = 8.f * LOG2E * 1.01f * 1.01f * mq * mk;
#pragma unroll
          for (int h = 0; h < 4; ++h) { const float c2h = LOG2E * (h == 0 ? 0.25f : h == 1 ? 0.0625f : h == 2 ? 0.015625f : 0.00390625f);
            const float need = 2.f * S2 + 24.f + lg2(2.f / (1.f - ex2(-c2h)));
            const float wf = need / c2h; Wh[h] = wf >= (float)SEQL ? SEQL : (int)wf + 1; } }
#ifndef NO_REC
#ifndef REC_REPS
#define REC_REPS 1
#endif
        for (int rr2 = 0; rr2 < REC_REPS; ++rr2)
        for (int u = blockIdx.x; u < N_REC_UNITS; u += G) rec::rec_unit(PROJ, OFb, OBb, u, lds);
#endif
        volatile int* misc = (volatile int*)(lds + LDS_MISC);
        int myq = (int)(__builtin_amdgcn_s_getreg((3 << 11) | 20) & 7u);
        constexpr int QN = 320;
        for (int tries = 0; tries < 8;) {
            if (tid == 0) misc[0] = (int)atomicAdd(ctl + 64 + 32 * myq, 1u);
            __syncthreads();
            const int t = __builtin_amdgcn_readfirstlane(misc[0]);
            __syncthreads();
            if (t >= QN) { myq = (myq + 1) & 7; ++tries; continue; }
            int b, hh, qb;
            { int i2 = t, base = 0; hh = 3;
              for (int seg = 0; seg < 4; ++seg) { if (i2 < 64) { b = myq; qb = i2; hh = 3 - seg; base = 1; break; } i2 -= 64; if (i2 < 16) { b = 8 + (i2 >> 3); qb = 8 * myq + (i2 & 7); hh = 3 - seg; base = 1; break; } i2 -= 16; }
              (void)base; }
#ifndef NO_ATT
            att::attn_unit(PROJ, XN, args.in[10], lam, b * 4 + hh, qb, hh == 0 ? Wh[0] : hh == 1 ? Wh[1] : hh == 2 ? Wh[2] : Wh[3], (char*)lds);
#endif
        }
    } }
    SEAM(3);
    for (int rep = 0; rep < NREP(4); ++rep) { if (rep) grid.sync();
    if (IN(4)) {
        PHASE_IDS
        const int h4 = lane >> 4, c8 = (lane & 15) * 8;
        float w8[8];
#pragma unroll
        for (int e = 0; e < 8; ++e) w8[e] = args.in[13][c8 + e];
        for (int m0 = gw * 4; m0 < MTOK; m0 += NGW * 4) {
            u32x4 fa[4], fb[4], fg[4];
#pragma unroll
            for (int u = 0; u < 4; ++u) { const size_t m = m0 + u;
                fa[u] = *(const u32x4*)(OFb + m * 512 + h4 * 128 + c8); fb[u] = *(const u32x4*)(OBb + m * 512 + h4 * 128 + c8); fg[u] = *(const u32x4*)(PROJ + m * INW + 3584 + h4 * 128 + c8); }
#pragma unroll
            for (int u = 0; u < 4; ++u) {
                float v[8]; float sq = 0.f;
#pragma unroll
                for (int e = 0; e < 4; ++e) { v[2 * e] = bf_lo(fa[u][e]) + bf_lo(fb[u][e]); v[2 * e + 1] = bf_hi(fa[u][e]) + bf_hi(fb[u][e]); sq += v[2 * e] * v[2 * e] + v[2 * e + 1] * v[2 * e + 1]; }
                sq += __shfl_xor(sq, 1); sq += __shfl_xor(sq, 2); sq += __shfl_xor(sq, 4); sq += __shfl_xor(sq, 8);
                const float rs = __builtin_amdgcn_rsqf(sq * (1.f / 128.f) + NORM_EPS);
                u32x4 o;
#pragma unroll
                for (int e = 0; e < 4; ++e) o[e] = cvtpk(v[2 * e] * rs * w8[2 * e] * bf_lo(fg[u][e]), v[2 * e + 1] * rs * w8[2 * e + 1] * bf_hi(fg[u][e]));
                *(u32x4*)(XN + (size_t)(m0 + u) * DM + 512 + h4 * 128 + c8) = o;
            }
        }
    }
    }
    SEAM(4);
    for (int rep = 0; rep < NREP(5); ++rep) { if (rep) grid.sync();
    if (IN(5)) {
        pg8::Gemm g{XN, W_out, MTOK, DM, DM}; pg8::StaticOrder S; S.init(MTOK, DM, G, (int)blockIdx.x);
        EpiResidB E{xp, xs, X1B};
        pg8::gemm_phase<EpiResidB, pg8::StaticOrder, true, true>(ldsl, g, S, E);
    }
    }
    SEAM(5);
    for (int rep = 0; rep < NREP(6); ++rep) { if (rep) grid.sync();
    if (IN(6)) {
        PHASE_IDS
        for (int m = gw * 2; m < MTOK; m += NGW * 2) rms_rowb2_to_bf16(X1B + (size_t)m * DM, X1B + (size_t)(m + 1) * DM, args.in[15], XN + (size_t)m * DM, XN + (size_t)(m + 1) * DM, lane);
    }
    }
    SEAM(6);
    for (int rep = 0; rep < NREP(7); ++rep) { if (rep) grid.sync();
    if (IN(7)) {
        pg8::Gemm g{XN, W_up, NSEQ * 33 * 256, DFF2, DM}; pg8::StaticOrder S; S.init(NSEQ * 33 * 256, DFF2, G, (int)blockIdx.x); S.ovl = 1;
        EpiConvAct E{ACT, args.in[17], args.in[18], (PG8_LAS float*)(ldsl + 131072)};
        pg8::gemm_phase<EpiConvAct, pg8::StaticOrder, true, true>(ldsl, g, S, E);
    } }
    SEAM(7);
    if (IN(8)) {
        pg8::Gemm g{ACT, W_down, MTOK, DM, DFF}; pg8::StaticOrder S; S.init(MTOK, DM, G, (int)blockIdx.x);
        EpiFinal E{X1B, args.out};
        pg8::gemm_phase<EpiFinal, pg8::StaticOrder, true, true>(ldsl, g, S, E);
    }
#undef IN
#undef SEAM
}

#ifndef ONE_LAUNCH
#define ONE_LAUNCH 1
#endif
extern "C" void kernel_launch(void* const* d_in, const int* in_sizes, int n_in, void* d_out, int out_size, void* d_ws, size_t ws_size, hipStream_t stream) {
    static int grid = 0;
    if (grid == 0) {
        if (n_in != 20 || out_size != MTOK * DM || ws_size < WS_END) { fprintf(stderr, "kernel_launch: unexpected shapes n_in %d out %d ws %zu (need %zu)\n", n_in, out_size, ws_size, (size_t)WS_END); grid = -1; return; }
        int dev = 0, cus = 0, per_cu = 0;
        (void)hipGetDevice(&dev); (void)hipDeviceGetAttribute(&cus, hipDeviceAttributeMultiprocessorCount, dev);
        if (hipFuncSetAttribute((const void*)fwd_kernel, hipFuncAttributeMaxDynamicSharedMemorySize, LDS_BYTES) != hipSuccess) { fprintf(stderr, "kernel_launch: hipFuncSetAttribute failed\n"); grid = -1; return; }
        (void)hipOccupancyMaxActiveBlocksPerMultiprocessor(&per_cu, (const void*)fwd_kernel, 512, LDS_BYTES);
        if (per_cu < 1) { fprintf(stderr, "kernel_launch: occupancy query says %d\n", per_cu); per_cu = 1; }
        (void)hipGetLastError();
        grid = cus * per_cu;
    }
    if (grid < 0) return;
#if !ONE_LAUNCH
    (void)hipMemsetAsync((char*)d_ws + WS_CTL, 0, 32768, stream);
#endif
    Args a{};
    for (int i = 0; i < 20; ++i) a.in[i] = (const float*)d_in[i];
    a.out = (float*)d_out; a.ws = (unsigned char*)d_ws;
#if ONE_LAUNCH
    a.ph_lo = 0; a.ph_hi = NPH;
    void* kargs[] = {&a};
    hipError_t e = hipLaunchCooperativeKernel((const void*)fwd_kernel, dim3(grid), dim3(512), kargs, LDS_BYTES, stream);
    if (e != hipSuccess) fprintf(stderr, "cooperative launch failed: %s (grid %d)\n", hipGetErrorString(e), grid);
#else
    for (int p = 0; p < NPH; ++p) {
        a.ph_lo = p; a.ph_hi = p + 1;
        hipLaunchKernelGGL(fwd_kernel, dim3(grid), dim3(512), LDS_BYTES, stream, a);
    }
#endif
}
```

```cpp
#include <hip/hip_runtime.h>
#include <hip/hip_cooperative_groups.h>
#include <cstdio>
#include <cstdint>
namespace cg = cooperative_groups;

namespace pg8 {
#define PG8_LAS __attribute__((address_space(3)))
typedef unsigned short bf16_t;
typedef short bf16x8 __attribute__((ext_vector_type(8)));
typedef float f32x4 __attribute__((ext_vector_type(4)));
typedef unsigned u32x4 __attribute__((ext_vector_type(4)));
constexpr int BM = 256, BK = 64, HALF = 128, HTB = HALF * BK * 2  , STAGE_BYTES = 8 * HTB, NXCD = 8, WGM = 8;

__host__ __device__ __forceinline__ int lds_byte(int r, int c) { const int st = (r >> 4) * 2 + (c >> 5), rr = r & 15, cc = c & 31, ob = rr * 64 + cc * 2; return st * 1024 + (ob ^ (((ob >> 9) & 1) << 5)); }
__host__ __device__ __forceinline__ void stage_rc(int b, int& R, int& C) { const int st = b / 1024, sb = b % 1024, swz = sb ^ (((sb >> 9) & 1) << 5); R = (st >> 1) * 16 + swz / 64; C = (st & 1) * 32 + (swz % 64) / 2; }
__host__ __device__ __forceinline__ int perm32(int rho) { const int n = rho >> 4, i = rho & 15; return 8 * (i >> 2) + 4 * n + (i & 3); }

struct Unit { int pm, pn; };
struct Gemm { const bf16_t* A; const bf16_t* Bt; int M, N, K; };

struct StaticOrder {
    int nM, nN, nwg, G, c;
    __host__ __device__ void init(int M, int N, int G_, int c_) { nM = M / BM; nN = N / BM; nwg = nM * nN; G = G_; c = c_; }
    __host__ __device__ bool next(int i, Unit& u) const {
        const long L = (long)i * G + c; if (L >= nwg) return false;
        int wgid = (int)L; { const int q = nwg / NXCD, r = nwg % NXCD, xcd = wgid % NXCD, off = wgid / NXCD; wgid = (xcd < r ? xcd * (q + 1) : r * (q + 1) + (xcd - r) * q) + off; }
        const int nig = WGM * nN, gid = wgid / nig, fm = gid * WGM, gsz = (nM - fm) < WGM ? (nM - fm) : WGM;
        u.pm = fm + ((wgid % nig) % gsz); u.pn = (wgid % nig) / gsz; return true;
    }
    int ovl = 0;
    __device__ __forceinline__ long arow(const Unit& u) const { return ovl ? (long)(u.pm / 33) * 8192 + 252 * (u.pm % 33) - 1 : (long)u.pm * BM; }
    __device__ __forceinline__ void a_ready(const Unit&) const {}
    __device__ __forceinline__ void done(const Unit&) const {}
};

__device__ __forceinline__ unsigned cvt_pk_bf16(float lo, float hi) { unsigned r; asm volatile("v_cvt_pk_bf16_f32 %0, %1, %2" : "=v"(r) : "v"(lo), "v"(hi)); return r; }
typedef float f32x2 __attribute__((ext_vector_type(2)));
template <class Epi, class Sched, bool ALIGN_EPI = false, bool SP2 = false>
__device__ __forceinline__ void gemm_phase(PG8_LAS unsigned char* lds, const Gemm g, const Sched& S, const Epi& E) {
    int tid = threadIdx.x; asm volatile("" : "+v"(tid));
    const int wid = __builtin_amdgcn_readfirstlane(tid >> 6), lane = tid & 63, wr = wid >> 2, wc = wid & 3, fr = lane & 15, fq = lane >> 4;
    const int K = g.K, nt = K / BK;
    unsigned voffA[2], voffB[2];
#pragma unroll
    for (int i = 0; i < 2; ++i) { int R, C; stage_rc(tid * 16 + i * 8192, R, C); const int Rb = Epi::PERM ? ((R & ~31) + perm32(R & 31)) : R;
        const int Ra = S.ovl ? (126 * (R >> 6) + 4 * (R & 15) + ((R >> 4) & 3)) : R;
        voffA[i] = (unsigned)(Ra * K + C) * 2u; voffB[i] = (unsigned)(Rb * K + C) * 2u; }
    const size_t kstep = (size_t)(BK * 2);
    const size_t hstep = (size_t)HALF * K * 2;
    const size_t tstep = 2 * hstep;
    const size_t hstepA = S.ovl ? (size_t)64 * K * 2 : hstep;
    const unsigned ldsw = (unsigned)wid * 1024u;
    const int aoff = lds_byte(wr * 64 + fr, fq * 8), boff = lds_byte(wc * 32 + fr, fq * 8);
#define PG8_SA(b, h) (((b) * 2 + (h)) * HTB)
#define PG8_SB(b, h) ((4 + (b) * 2 + (h)) * HTB)
#define PG8_STAGE(bufoff, gbase, voff) do { _Pragma("unroll") for (int _i = 0; _i < 2; ++_i) \
        __builtin_amdgcn_global_load_lds((const unsigned*)((const char*)(gbase) + (voff)[_i]), (PG8_LAS unsigned*)(lds + (bufoff) + ldsw + _i * 8192), 16, 0, 0); } while (0)
#define PG8_LDA(dst, b, h) do { _Pragma("unroll") for (int m = 0; m < 4; ++m) _Pragma("unroll") for (int k = 0; k < 2; ++k) dst[m][k] = *(const PG8_LAS bf16x8*)(lds + PG8_SA(b, h) + aoff + m * 2048 + k * 1024); } while (0)
#define PG8_LDB(dst, b, h) do { _Pragma("unroll") for (int n = 0; n < 2; ++n) _Pragma("unroll") for (int k = 0; k < 2; ++k) dst[n][k] = *(const PG8_LAS bf16x8*)(lds + PG8_SB(b, h) + boff + n * 2048 + k * 1024); } while (0)
#define PG8_MMA(ai, bj, At, Bt) do { __builtin_amdgcn_s_setprio(1); _Pragma("unroll") for (int m = 0; m < 4; ++m) _Pragma("unroll") for (int n = 0; n < 2; ++n) _Pragma("unroll") for (int k = 0; k < 2; ++k) \
        acc[ai][bj][m][n] = __builtin_amdgcn_mfma_f32_16x16x32_bf16(Bt[n][k], At[m][k], acc[ai][bj][m][n], 0, 0, 0); __builtin_amdgcn_s_setprio(0); } while (0)
#define PG8_WAIT_V(n) asm volatile("s_waitcnt vmcnt(" #n ")" ::: "memory")
#define PG8_WAIT_L(n) asm volatile("s_waitcnt lgkmcnt(" #n ")" ::: "memory")
#define PG8_BAR __builtin_amdgcn_s_barrier()
#define PG8_SCHED __builtin_amdgcn_sched_barrier(0)
    Unit cur, nxt; int ui = 0;
    if (!S.next(0, cur)) return;
    f32x4 acc[2][2][4][2];
#pragma unroll
    for (int a = 0; a < 2; ++a)
#pragma unroll
        for (int b = 0; b < 2; ++b)
#pragma unroll
            for (int m = 0; m < 4; ++m)
#pragma unroll
                for (int n = 0; n < 2; ++n) acc[a][b][m][n] = (f32x4){0.f, 0.f, 0.f, 0.f};
    bf16x8 At[4][2], B0[2][2], B1[2][2];
    const long rowb = (long)K * 2;
    const char* cA = (const char*)g.A + S.arow(cur) * rowb; const char* cB = (const char*)g.Bt + (size_t)cur.pn * tstep;
    S.a_ready(cur);
    if constexpr (SP2) {
        PG8_STAGE(PG8_SB(0, 0), cB, voffB); PG8_STAGE(PG8_SB(0, 1), cB + hstep, voffB); PG8_STAGE(PG8_SA(0, 0), cA, voffA); PG8_STAGE(PG8_SA(0, 1), cA + hstepA, voffA);
        if (wr == 1) PG8_BAR;
        PG8_WAIT_V(2); PG8_BAR;
        PG8_STAGE(PG8_SB(1, 0), cB + kstep, voffB); PG8_STAGE(PG8_SA(1, 0), cA + kstep, voffA); PG8_STAGE(PG8_SB(1, 1), cB + hstep + kstep, voffB);
        PG8_WAIT_V(6); PG8_BAR;
    } else {
        PG8_STAGE(PG8_SB(0, 0), cB, voffB); PG8_STAGE(PG8_SA(0, 0), cA, voffA); PG8_STAGE(PG8_SB(0, 1), cB + hstep, voffB); PG8_STAGE(PG8_SA(0, 1), cA + hstepA, voffA);
        if (wr == 1) PG8_BAR;
        PG8_WAIT_V(4); PG8_BAR;
        PG8_STAGE(PG8_SB(1, 0), cB + kstep, voffB); PG8_STAGE(PG8_SA(1, 0), cA + kstep, voffA); PG8_STAGE(PG8_SB(1, 1), cB + hstep + kstep, voffB);
        PG8_WAIT_V(6); PG8_BAR;
    }
    for (;;) {
        const bool has_next = S.next(ui + 1, nxt);
        const char* nA = has_next ? (const char*)g.A + S.arow(nxt) * rowb : cA; const char* nB = has_next ? (const char*)g.Bt + (size_t)nxt.pn * tstep : cB;
        for (int t = 0; t < nt; t += 2) {
            const bool last = (t == nt - 2);
            const char* a1 = cA + (size_t)(t + 1) * kstep;
            const char* a2 = last ? nA : cA + (size_t)(t + 2) * kstep; const char* b2 = last ? nB : cB + (size_t)(t + 2) * kstep;
            const char* a3 = a2 + kstep; const char* b3 = b2 + kstep;
            if (last && has_next) S.a_ready(nxt);
            if constexpr (SP2) {
            PG8_LDB(B0, 0, 0); PG8_LDB(B1, 0, 1); PG8_SCHED; PG8_LDA(At, 0, 0); PG8_STAGE(PG8_SA(1, 1), a1 + hstepA, voffA);
            PG8_WAIT_V(8); PG8_WAIT_L(0); PG8_BAR; PG8_MMA(0, 0, At, B0); PG8_MMA(0, 1, At, B1); PG8_BAR; PG8_SCHED;
            PG8_LDA(At, 0, 1); PG8_STAGE(PG8_SB(0, 0), b2, voffB); PG8_STAGE(PG8_SB(0, 1), b2 + hstep, voffB); PG8_STAGE(PG8_SA(0, 0), a2, voffA);
            PG8_WAIT_V(8); PG8_WAIT_L(0); PG8_BAR; PG8_MMA(1, 0, At, B0); PG8_MMA(1, 1, At, B1); PG8_BAR; PG8_SCHED;
            PG8_LDB(B0, 1, 0); PG8_LDB(B1, 1, 1); PG8_SCHED; PG8_LDA(At, 1, 0); PG8_STAGE(PG8_SA(0, 1), a2 + hstepA, voffA);
            PG8_WAIT_V(8); PG8_WAIT_L(0); PG8_BAR; PG8_MMA(0, 0, At, B0); PG8_MMA(0, 1, At, B1); PG8_BAR; PG8_SCHED;
            PG8_LDA(At, 1, 1); PG8_STAGE(PG8_SB(1, 0), b3, voffB); PG8_STAGE(PG8_SB(1, 1), b3 + hstep, voffB); PG8_STAGE(PG8_SA(1, 0), a3, voffA);
            PG8_WAIT_V(8); PG8_WAIT_L(0); PG8_BAR; PG8_MMA(1, 0, At, B0); PG8_MMA(1, 1, At, B1); PG8_BAR; PG8_SCHED;
            } else {
            PG8_LDB(B0, 0, 0); PG8_SCHED; PG8_LDA(At, 0, 0); PG8_STAGE(PG8_SA(1, 1), a1 + hstepA, voffA);
            PG8_WAIT_L(8); PG8_BAR; PG8_WAIT_L(0); PG8_MMA(0, 0, At, B0); PG8_BAR; PG8_SCHED;
            PG8_LDB(B1, 0, 1); PG8_STAGE(PG8_SB(0, 0), b2, voffB);
            PG8_BAR; PG8_WAIT_L(0); PG8_MMA(0, 1, At, B1); PG8_BAR;
            PG8_LDA(At, 0, 1); PG8_STAGE(PG8_SA(0, 0), a2, voffA);
            PG8_BAR; PG8_WAIT_L(0); PG8_MMA(1, 0, At, B0); PG8_BAR; PG8_SCHED;
            PG8_STAGE(PG8_SB(0, 1), b2 + hstep, voffB);
            PG8_WAIT_V(6); PG8_BAR; PG8_MMA(1, 1, At, B1); PG8_BAR;
            PG8_LDB(B0, 1, 0); PG8_SCHED; PG8_LDA(At, 1, 0); PG8_STAGE(PG8_SA(0, 1), a2 + hstepA, voffA);
            PG8_WAIT_L(8); PG8_BAR; PG8_WAIT_L(0); PG8_MMA(0, 0, At, B0); PG8_BAR; PG8_SCHED;
            PG8_LDB(B1, 1, 1); PG8_STAGE(PG8_SB(1, 0), b3, voffB);
            PG8_BAR; PG8_WAIT_L(0); PG8_MMA(0, 1, At, B1); PG8_BAR;
            PG8_LDA(At, 1, 1); PG8_STAGE(PG8_SA(1, 0), a3, voffA);
            PG8_BAR; PG8_WAIT_L(0); PG8_MMA(1, 0, At, B0); PG8_BAR; PG8_SCHED;
            PG8_STAGE(PG8_SB(1, 1), b3 + hstep, voffB);
            PG8_WAIT_V(6); PG8_BAR; PG8_MMA(1, 1, At, B1); PG8_BAR;
            }
        }
        if constexpr (ALIGN_EPI) { if (wr == 0) PG8_BAR; }
        if constexpr (!Epi::AFTER_DRAIN) { E(acc, cur, wr, wc, fr, fq); S.done(cur); }
        if (!has_next) break;
#pragma unroll
        for (int a = 0; a < 2; ++a)
#pragma unroll
            for (int b = 0; b < 2; ++b)
#pragma unroll
                for (int m = 0; m < 4; ++m)
#pragma unroll
                    for (int n = 0; n < 2; ++n) acc[a][b][m][n] = (f32x4){0.f, 0.f, 0.f, 0.f};
        cur = nxt; cA = nA; cB = nB; ++ui;
        if constexpr (ALIGN_EPI) { if (wr == 1) PG8_BAR; }
    }
    PG8_WAIT_V(0);
    if constexpr (!ALIGN_EPI) { if (wr == 0) PG8_BAR; }
    PG8_BAR;
    if constexpr (Epi::AFTER_DRAIN) { E.fused(acc, cur, wr, wc, fr, fq, lds, wid, lane); S.done(cur); }
#undef PG8_SA
#undef PG8_SB
#undef PG8_STAGE
#undef PG8_LDA
#undef PG8_LDB
#undef PG8_MMA
#undef PG8_WAIT_V
#undef PG8_WAIT_L
#undef PG8_BAR
#undef PG8_SCHED
}
}

constexpr int DM = 1024, SEQL = 8192, NSEQ = 10, MTOK = NSEQ * SEQL, INW = 4096, DFF = 2816, DFF2 = 5632, NHEAD = 4;
constexpr int MPROMPT = 2 * SEQL;
constexpr float NORM_EPS = 1e-6f;
constexpr float LOG2E = 1.4426950408889634f;
typedef unsigned short bf16_t;
typedef short bf16x8 __attribute__((ext_vector_type(8)));
typedef short s16x4 __attribute__((ext_vector_type(4)));
typedef float f32x4 __attribute__((ext_vector_type(4)));
typedef float f32x16 __attribute__((ext_vector_type(16)));
typedef unsigned u32x4 __attribute__((ext_vector_type(4)));
typedef unsigned u32x2 __attribute__((ext_vector_type(2)));
typedef float f32x2 __attribute__((ext_vector_type(2)));
#define LAS __attribute__((address_space(3)))

constexpr size_t MiB = 1u << 20;
constexpr size_t WS_CTL = 0;
constexpr size_t WS_WIN = 1 * MiB;
constexpr size_t WS_WOUT = 9 * MiB;
constexpr size_t WS_WUP = 11 * MiB;
constexpr size_t WS_WDOWN = 22 * MiB;
constexpr size_t WS_XN = 32 * MiB;
constexpr size_t WS_PROJ = 192 * MiB;
constexpr size_t WS_OF = 832 * MiB;
constexpr size_t WS_OB = 912 * MiB;
constexpr size_t WS_U = 192 * MiB;
constexpr size_t WS_ACT = 192 * MiB;
constexpr size_t WS_END = 992 * MiB;
constexpr int NSLAB = 2, SLABROWS = MTOK / NSLAB;

constexpr int LDS_BYTES = 143360;
constexpr int LDS_MISC = 131072 + 8192;

__device__ __forceinline__ unsigned cvtpk(float lo, float hi) { unsigned r; asm("v_cvt_pk_bf16_f32 %0, %1, %2" : "=v"(r) : "v"(lo), "v"(hi)); return r; }
__device__ __forceinline__ float bf_lo(unsigned u) { return __uint_as_float(u << 16); }
__device__ __forceinline__ float bf_hi(unsigned u) { return __uint_as_float(u & 0xffff0000u); }
__device__ __forceinline__ float ex2(float x) { return __builtin_amdgcn_exp2f(x); }
__device__ __forceinline__ float lg2(float x) { return __builtin_amdgcn_logf(x); }
__device__ __forceinline__ float rcpf(float x) { return __builtin_amdgcn_rcpf(x); }
__device__ __forceinline__ float siluf(float x) { return x * rcpf(1.f + ex2(-x * LOG2E)); }
__device__ __forceinline__ float wave_sum(float v) {
#pragma unroll
    for (int o = 1; o < 64; o <<= 1) v += __shfl_xor(v, o);
    return v;
}
__device__ __forceinline__ const float* xrow_ptr(const float* xp, const float* xs, int row) {
    return row < MPROMPT ? xp + (size_t)row * DM : xs + (size_t)(row - MPROMPT) * DM;
}

struct EpiInProj {
    static constexpr bool PERM = true, AFTER_DRAIN = false;
    bf16_t* P; const float* lbf; const float* lbb; const float* qnw; const float* knw; PG8_LAS float* ex;
    __device__ __forceinline__ void operator()(const pg8::f32x4 (&acc)[2][2][4][2], const pg8::Unit& u, int wr, int wc, int fr, int fq) const {
        const int sec = u.pn >> 1;
        int row0 = u.pm * 256 + wr * 64 + fr, col0 = u.pn * 256 + wc * 32 + 8 * fq;
        asm volatile("" : "+v"(row0), "+v"(col0));
        if (sec < 2) {
            float ps[2][4][2];
#pragma unroll
            for (int ai = 0; ai < 2; ++ai)
#pragma unroll
                for (int m = 0; m < 4; ++m)
#pragma unroll
                    for (int bj = 0; bj < 2; ++bj) { float q = 0.f;
#pragma unroll
                        for (int n = 0; n < 2; ++n)
#pragma unroll
                            for (int e = 0; e < 4; ++e) q += acc[ai][bj][m][n][e] * acc[ai][bj][m][n][e];
                        q += __shfl_xor(q, 16); q += __shfl_xor(q, 32); ps[ai][m][bj] = q; }
            const int wid = wr * 4 + wc;
            if (fq == 0) {
#pragma unroll
                for (int ai = 0; ai < 2; ++ai)
#pragma unroll
                    for (int m = 0; m < 4; ++m)
#pragma unroll
                        for (int bj = 0; bj < 2; ++bj) ex[(wid * 16 + (ai * 8 + m * 2 + bj)) * 16 + fr] = ps[ai][m][bj];
            }
            asm volatile("s_waitcnt lgkmcnt(0)" ::: "memory"); __builtin_amdgcn_s_barrier();
            const float* nw = (sec == 0) ? qnw : knw; const float sc = (sec == 0) ? 0.125f * LOG2E : 1.f;
            float w8[8];
#pragma unroll
            for (int e = 0; e < 8; ++e) w8[e] = nw[32 * (wc & 1) + 8 * fq + e] * sc;
#pragma unroll
            for (int ai = 0; ai < 2; ++ai)
#pragma unroll
                for (int m = 0; m < 4; ++m) {
                    bf16_t* rowp = P + (size_t)(row0 + ai * 128 + m * 16) * INW + col0;
#pragma unroll
                    for (int bj = 0; bj < 2; ++bj) {
                        const float tot = ps[ai][m][bj] + ex[((wid ^ 1) * 16 + (ai * 8 + m * 2 + bj)) * 16 + fr];
                        const float rs = __builtin_amdgcn_rsqf(tot * (1.f / 64.f) + NORM_EPS);
                        const pg8::f32x4 v0 = acc[ai][bj][m][0], v1 = acc[ai][bj][m][1];
                        u32x4 w; w.x = cvtpk(v0[0] * rs * w8[0], v0[1] * rs * w8[1]); w.y = cvtpk(v0[2] * rs * w8[2], v0[3] * rs * w8[3]);
                        w.z = cvtpk(v1[0] * rs * w8[4], v1[1] * rs * w8[5]); w.w = cvtpk(v1[2] * rs * w8[6], v1[3] * rs * w8[7]);
                        __builtin_nontemporal_store(w, (u32x4*)(rowp + bj * 128));
                    }
                }
            return;
        }
        float lbv[2][8];
        if (sec == 4 || sec == 5) {
            const float* t = (sec == 4) ? lbf : lbb; const int cs = col0 - sec * 512;
#pragma unroll
            for (int bj = 0; bj < 2; ++bj)
#pragma unroll
                for (int e = 0; e < 8; ++e) { const int c = cs + bj * 128 + e; lbv[bj][e] = rcpf(1.f + ex2((t[512 + c] - t[c]) * LOG2E)); }
        }
#pragma unroll
        for (int ai = 0; ai < 2; ++ai)
#pragma unroll
            for (int m = 0; m < 4; ++m) {
                bf16_t* rowp = P + (size_t)(row0 + ai * 128 + m * 16) * INW + col0;
#pragma unroll
                for (int bj = 0; bj < 2; ++bj) {
                    float v[8];
#pragma unroll
                    for (int e = 0; e < 4; ++e) { v[e] = acc[ai][bj][m][0][e]; v[4 + e] = acc[ai][bj][m][1][e]; }
                    if (sec == 3 || sec == 7) {
#pragma unroll
                        for (int e = 0; e < 8; ++e) v[e] = siluf(v[e]);
                    } else if (sec == 4 || sec == 5) {
#pragma unroll
                        for (int e = 0; e < 8; ++e) { const float sg = rcpf(1.f + ex2(-v[e] * LOG2E)); const float lb = lbv[bj][e]; v[e] = lg2(lb + (1.f - lb) * sg); }
                    }
                    u32x4 w; w.x = cvtpk(v[0], v[1]); w.y = cvtpk(v[2], v[3]); w.z = cvtpk(v[4], v[5]); w.w = cvtpk(v[6], v[7]);
                    __builtin_nontemporal_store(w, (u32x4*)(rowp + bj * 128));
                }
            }
    }
};
struct EpiBf16Plain {
    static constexpr bool PERM = true, AFTER_DRAIN = false;
    bf16_t* O; int ldc;
    __device__ __forceinline__ void operator()(const pg8::f32x4 (&acc)[2][2][4][2], const pg8::Unit& u, int wr, int wc, int fr, int fq) const {
        int row0 = u.pm * 256 + wr * 64 + fr, col0 = u.pn * 256 + wc * 32 + 8 * fq;
        asm volatile("" : "+v"(row0), "+v"(col0));
#pragma unroll
        for (int ai = 0; ai < 2; ++ai)
#pragma unroll
            for (int m = 0; m < 4; ++m) {
                bf16_t* rowp = O + (size_t)(row0 + ai * 128 + m * 16) * ldc + col0;
#pragma unroll
                for (int bj = 0; bj < 2; ++bj) {
                    const pg8::f32x4 v0 = acc[ai][bj][m][0], v1 = acc[ai][bj][m][1];
                    u32x4 w; w.x = cvtpk(v0[0], v0[1]); w.y = cvtpk(v0[2], v0[3]); w.z = cvtpk(v1[0], v1[1]); w.w = cvtpk(v1[2], v1[3]);
                    *(u32x4*)(rowp + bj * 128) = w;
                }
            }
    }
};
struct EpiResid {
    static constexpr bool PERM = true, AFTER_DRAIN = false;
    const float* xp; const float* xs; float* out; int row_off; int self;
    __device__ __forceinline__ void operator()(const pg8::f32x4 (&acc)[2][2][4][2], const pg8::Unit& u, int wr, int wc, int fr, int fq) const {
        const int rowt = row_off + u.pm * 256;
        const float* rb = self ? (const float*)out + (size_t)rowt * DM : xrow_ptr(xp, xs, rowt);
        float* ob = out + (size_t)rowt * DM;
        int r0 = wr * 64 + fr, col0 = u.pn * 256 + wc * 32 + 8 * fq;
        asm volatile("" : "+v"(r0), "+v"(col0));
#pragma unroll
        for (int ai = 0; ai < 2; ++ai)
#pragma unroll
            for (int m = 0; m < 4; ++m) {
                const size_t ro = (size_t)(r0 + ai * 128 + m * 16) * DM + col0;
#pragma unroll
                for (int bj = 0; bj < 2; ++bj)
#pragma unroll
                    for (int n = 0; n < 2; ++n) {
                        const f32x4 r = *(const f32x4*)(rb + ro + bj * 128 + 4 * n);
                        const pg8::f32x4 a = acc[ai][bj][m][n];
                        f32x4 o; o[0] = r[0] + a[0]; o[1] = r[1] + a[1]; o[2] = r[2] + a[2]; o[3] = r[3] + a[3];
                        *(f32x4*)(ob + ro + bj * 128 + 4 * n) = o;
                    }
            }
    }
};

struct EpiResidB {
    static constexpr bool PERM = true, AFTER_DRAIN = false;
    const float* xp; const float* xs; bf16_t* X1B;
    __device__ __forceinline__ void operator()(const pg8::f32x4 (&acc)[2][2][4][2], const pg8::Unit& u, int wr, int wc, int fr, int fq) const {
        const int rowt = u.pm * 256;
        const float* rb = xrow_ptr(xp, xs, rowt);
        bf16_t* ob = X1B + (size_t)rowt * DM;
        int r0 = wr * 64 + fr, col0 = u.pn * 256 + wc * 32 + 8 * fq;
        asm volatile("" : "+v"(r0), "+v"(col0));
#pragma unroll
        for (int ai = 0; ai < 2; ++ai)
#pragma unroll
            for (int m = 0; m < 4; ++m) {
                const size_t ro = (size_t)(r0 + ai * 128 + m * 16) * DM + col0;
#pragma unroll
                for (int bj = 0; bj < 2; ++bj) {
                    const f32x4 ra = *(const f32x4*)(rb + ro + bj * 128), rc = *(const f32x4*)(rb + ro + bj * 128 + 4);
                    const pg8::f32x4 a = acc[ai][bj][m][0], c = acc[ai][bj][m][1];
                    u32x4 w; w.x = cvtpk(ra[0] + a[0], ra[1] + a[1]); w.y = cvtpk(ra[2] + a[2], ra[3] + a[3]); w.z = cvtpk(rc[0] + c[0], rc[1] + c[1]); w.w = cvtpk(rc[2] + c[2], rc[3] + c[3]);
                    *(u32x4*)(ob + ro + bj * 128) = w;
                }
            }
    }
};
struct EpiFinal {
    static constexpr bool PERM = true, AFTER_DRAIN = false;
    const bf16_t* X1B; float* out;
    __device__ __forceinline__ void operator()(const pg8::f32x4 (&acc)[2][2][4][2], const pg8::Unit& u, int wr, int wc, int fr, int fq) const {
        const int rowt = u.pm * 256;
        const bf16_t* rb = X1B + (size_t)rowt * DM;
        float* ob = out + (size_t)rowt * DM;
        int r0 = wr * 64 + fr, col0 = u.pn * 256 + wc * 32 + 8 * fq;
        asm volatile("" : "+v"(r0), "+v"(col0));
#pragma unroll
        for (int ai = 0; ai < 2; ++ai)
#pragma unroll
            for (int m = 0; m < 4; ++m) {
                const size_t ro = (size_t)(r0 + ai * 128 + m * 16) * DM + col0;
#pragma unroll
                for (int bj = 0; bj < 2; ++bj) {
                    const u32x4 r = *(const u32x4*)(rb + ro + bj * 128);
                    const pg8::f32x4 a = acc[ai][bj][m][0], c = acc[ai][bj][m][1];
                    f32x4 o0, o1;
                    o0[0] = bf_lo(r.x) + a[0]; o0[1] = bf_hi(r.x) + a[1]; o0[2] = bf_lo(r.y) + a[2]; o0[3] = bf_hi(r.y) + a[3];
                    o1[0] = bf_lo(r.z) + c[0]; o1[1] = bf_hi(r.z) + c[1]; o1[2] = bf_lo(r.w) + c[2]; o1[3] = bf_hi(r.w) + c[3];
                    *(f32x4*)(ob + ro + bj * 128) = o0; *(f32x4*)(ob + ro + bj * 128 + 4) = o1;
                }
            }
    }
};

#define DPP_SHR1 0x111
#define DPP_SHL1 0x101
#define DPP_ROR1 0x121
#define DPP_ROR15 0x12F
__device__ __forceinline__ float dppf(float old, float src, const int ctrl_sel) {
    int r;
    if (ctrl_sel == 0) r = __builtin_amdgcn_update_dpp(__float_as_int(old), __float_as_int(src), DPP_SHR1, 0xf, 0xf, false);
    else if (ctrl_sel == 1) r = __builtin_amdgcn_update_dpp(__float_as_int(old), __float_as_int(src), DPP_SHL1, 0xf, 0xf, false);
    else if (ctrl_sel == 2) r = __builtin_amdgcn_update_dpp(__float_as_int(old), __float_as_int(src), DPP_ROR1, 0xf, 0xf, false);
    else r = __builtin_amdgcn_update_dpp(__float_as_int(old), __float_as_int(src), DPP_ROR15, 0xf, 0xf, false);
    return __int_as_float(r);
}
struct EpiConvAct {
    static constexpr bool PERM = true, AFTER_DRAIN = false;
    bf16_t* ACT; const float* cw; const float* cb; PG8_LAS float* ex;
    __device__ __forceinline__ void operator()(const pg8::f32x4 (&acc)[2][2][4][2], const pg8::Unit& u, int wr, int wc, int fr, int fq) const {
        int seq = u.pm / 33, pt = u.pm % 33;
        asm volatile("" : "+s"(seq), "+s"(pt));
        const int t0 = 252 * pt - 1 + 126 * wr;
        int cl = wc * 32 + 8 * fq;
        asm volatile("" : "+v"(cl));
        const int chb = u.pn * 128 + cl;
#pragma unroll
        for (int n = 0; n < 2; ++n) {
            const int ch = chb + 4 * n;
            const f32x4 bg = *(const f32x4*)(cb + ch), bu = *(const f32x4*)(cb + DFF + ch);
            const f32x4 g0 = *(const f32x4*)(cw + ch), g1 = *(const f32x4*)(cw + DFF2 + ch), g2 = *(const f32x4*)(cw + 2 * DFF2 + ch);
            const f32x4 u0 = *(const f32x4*)(cw + DFF + ch), u1 = *(const f32x4*)(cw + DFF2 + DFF + ch), u2 = *(const f32x4*)(cw + 2 * DFF2 + DFF + ch);
#pragma unroll
            for (int ai = 0; ai < 2; ++ai) {
#pragma unroll
                for (int m = 0; m < 4; ++m) {
                    const int row = 64 * ai + 4 * fr + m, t = t0 + row;
                    const bool keep = (row >= 1) && (row <= 126) && (t < SEQL);
                    float o4[4];
#pragma unroll
                    for (int e = 0; e < 4; ++e) {
                        float cv[2];
#pragma unroll
                        for (int bj = 0; bj < 2; ++bj) {
                            const float X = acc[ai][bj][m][n][e];
                            float pv, nv;
                            if (m > 0) pv = acc[ai][bj][m > 0 ? m - 1 : 0][n][e];
                            else { const float ob = (ai == 1) ? dppf(0.f, acc[0][bj][3][n][e], 2) : 0.f; pv = dppf(ob, acc[ai][bj][3][n][e], 0); }
                            if (m < 3) nv = acc[ai][bj][m < 3 ? m + 1 : 3][n][e];
                            else { const float ob = (ai == 0) ? dppf(0.f, acc[1][bj][0][n][e], 3) : 0.f; nv = dppf(ob, acc[ai][bj][0][n][e], 1); }
                            if (m == 1) pv = (t == 0) ? 0.f : pv;
                            if (m == 2) nv = (t == SEQL - 1) ? 0.f : nv;
                            cv[bj] = bj == 0 ? bg[e] + g0[e] * pv + g1[e] * X + g2[e] * nv : bu[e] + u0[e] * pv + u1[e] * X + u2[e] * nv;
                        }
                        o4[e] = siluf(cv[0]) * cv[1];
                    }
                    if (keep) { u32x2 w; w.x = cvtpk(o4[0], o4[1]); w.y = cvtpk(o4[2], o4[3]); *(u32x2*)(ACT + ((size_t)seq * SEQL + t) * DFF + ch) = w; }
                }
            }
        }
    }
};

__device__ __forceinline__ void p0_transpose_item(const float* W, int K, int N, bf16_t* WT, LAS float* scr, int item, int lane, bool perm_up = false) {
    const int nblk = N / 32, kb = item / nblk, nb = item % nblk, k0 = 64 * kb, n0 = 32 * nb;
#pragma unroll 8
    for (int i = 0; i < 32; ++i) { const int kk = 2 * i + (lane >> 5); scr[kk * 33 + (lane & 31)] = W[(size_t)(k0 + kk) * N + n0 + (lane & 31)]; }
    asm volatile("s_waitcnt lgkmcnt(0)" ::: "memory");
    const int c = lane & 7;
#pragma unroll
    for (int j = 0; j < 4; ++j) { const int n = (lane >> 3) + 8 * j; const LAS float* s = scr + (8 * c) * 33 + n;
        u32x4 o; o.x = cvtpk(s[0 * 33], s[1 * 33]); o.y = cvtpk(s[2 * 33], s[3 * 33]); o.z = cvtpk(s[4 * 33], s[5 * 33]); o.w = cvtpk(s[6 * 33], s[7 * 33]);
        int nd = n0 + n; if (perm_up) { const int hf = nd / DFF, rr = nd - hf * DFF; nd = (rr >> 7) * 256 + hf * 128 + (rr & 127); }
        *(u32x4*)(WT + (size_t)nd * K + k0 + 8 * c) = o; }
    asm volatile("s_waitcnt lgkmcnt(0)" ::: "memory");
}
__device__ __forceinline__ void rms_row2_to_bf16(const float* xrow0, const float* xrow1, const float* w, bf16_t* orow0, bf16_t* orow1, int lane) {
    const f32x4* xr0 = (const f32x4*)xrow0 + lane; const f32x4* xr1 = (const f32x4*)xrow1 + lane; const f32x4* wr = (const f32x4*)w + lane;
    f32x4 v0[4], v1[4]; float s0 = 0.f, s1 = 0.f;
#pragma unroll
    for (int j = 0; j < 4; ++j) { v0[j] = xr0[64 * j]; v1[j] = xr1[64 * j]; }
#pragma unroll
    for (int j = 0; j < 4; ++j) { s0 += (v0[j][0] * v0[j][0] + v0[j][1] * v0[j][1]) + (v0[j][2] * v0[j][2] + v0[j][3] * v0[j][3]); s1 += (v1[j][0] * v1[j][0] + v1[j][1] * v1[j][1]) + (v1[j][2] * v1[j][2] + v1[j][3] * v1[j][3]); }
    const float r0 = __builtin_amdgcn_rsqf(wave_sum(s0) * (1.f / DM) + NORM_EPS), r1 = __builtin_amdgcn_rsqf(wave_sum(s1) * (1.f / DM) + NORM_EPS);
    u32x2* o0 = (u32x2*)orow0 + lane; u32x2* o1 = (u32x2*)orow1 + lane;
#pragma unroll
    for (int j = 0; j < 4; ++j) { const f32x4 ww = wr[64 * j]; u32x2 o;
        o.x = cvtpk(v0[j][0] * r0 * ww[0], v0[j][1] * r0 * ww[1]); o.y = cvtpk(v0[j][2] * r0 * ww[2], v0[j][3] * r0 * ww[3]); o0[64 * j] = o;
        o.x = cvtpk(v1[j][0] * r1 * ww[0], v1[j][1] * r1 * ww[1]); o.y = cvtpk(v1[j][2] * r1 * ww[2], v1[j][3] * r1 * ww[3]); o1[64 * j] = o; }
}
__device__ __forceinline__ void rms_rowb2_to_bf16(const bf16_t* xrow0, const bf16_t* xrow1, const float* w, bf16_t* orow0, bf16_t* orow1, int lane) {
    const u32x4 a0 = *((const u32x4*)xrow0 + lane), a1 = *((const u32x4*)xrow0 + 64 + lane), b0 = *((const u32x4*)xrow1 + lane), b1 = *((const u32x4*)xrow1 + 64 + lane);
    float va[16], vb[16]; float s0 = 0.f, s1 = 0.f;
#pragma unroll
    for (int e = 0; e < 4; ++e) { va[2 * e] = bf_lo(a0[e]); va[2 * e + 1] = bf_hi(a0[e]); va[8 + 2 * e] = bf_lo(a1[e]); va[8 + 2 * e + 1] = bf_hi(a1[e]);
        vb[2 * e] = bf_lo(b0[e]); vb[2 * e + 1] = bf_hi(b0[e]); vb[8 + 2 * e] = bf_lo(b1[e]); vb[8 + 2 * e + 1] = bf_hi(b1[e]); }
#pragma unroll
    for (int e = 0; e < 16; ++e) { s0 += va[e] * va[e]; s1 += vb[e] * vb[e]; }
    const float r0 = __builtin_amdgcn_rsqf(wave_sum(s0) * (1.f / DM) + NORM_EPS), r1 = __builtin_amdgcn_rsqf(wave_sum(s1) * (1.f / DM) + NORM_EPS);
    const f32x4 w0 = *((const f32x4*)w + 2 * lane), w1 = *((const f32x4*)w + 2 * lane + 1), w2 = *((const f32x4*)w + 128 + 2 * lane), w3 = *((const f32x4*)w + 128 + 2 * lane + 1);
    u32x4 o;
    o.x = cvtpk(va[0] * r0 * w0[0], va[1] * r0 * w0[1]); o.y = cvtpk(va[2] * r0 * w0[2], va[3] * r0 * w0[3]); o.z = cvtpk(va[4] * r0 * w1[0], va[5] * r0 * w1[1]); o.w = cvtpk(va[6] * r0 * w1[2], va[7] * r0 * w1[3]);
    *((u32x4*)orow0 + lane) = o;
    o.x = cvtpk(va[8] * r0 * w2[0], va[9] * r0 * w2[1]); o.y = cvtpk(va[10] * r0 * w2[2], va[11] * r0 * w2[3]); o.z = cvtpk(va[12] * r0 * w3[0], va[13] * r0 * w3[1]); o.w = cvtpk(va[14] * r0 * w3[2], va[15] * r0 * w3[3]);
    *((u32x4*)orow0 + 64 + lane) = o;
    o.x = cvtpk(vb[0] * r1 * w0[0], vb[1] * r1 * w0[1]); o.y = cvtpk(vb[2] * r1 * w0[2], vb[3] * r1 * w0[3]); o.z = cvtpk(vb[4] * r1 * w1[0], vb[5] * r1 * w1[1]); o.w = cvtpk(vb[6] * r1 * w1[2], vb[7] * r1 * w1[3]);
    *((u32x4*)orow1 + lane) = o;
    o.x = cvtpk(vb[8] * r1 * w2[0], vb[9] * r1 * w2[1]); o.y = cvtpk(vb[10] * r1 * w2[2], vb[11] * r1 * w2[3]); o.z = cvtpk(vb[12] * r1 * w3[0], vb[13] * r1 * w3[1]); o.w = cvtpk(vb[14] * r1 * w3[2], vb[15] * r1 * w3[3]);
    *((u32x4*)orow1 + 64 + lane) = o;
}

namespace att {
constexpr int KVBLK = 64, LDK = INW;
constexpr int SHM_V = KVBLK * 128 * 2, SHM_K = KVBLK * 128 * 2;
constexpr float THR2 = 11.5f;
#ifndef ATT_SDEPTH
#define ATT_SDEPTH 2
#endif
constexpr int SDEPTH = ATT_SDEPTH;
#define KSWZ(row, colB) ((row) * 256 + ((colB) ^ (((row) & 7) << 4)))
#define SBAR() __builtin_amdgcn_sched_barrier(0)
__device__ __forceinline__ int crow(int r, int hi) { return (r & 3) + 8 * (r >> 2) + 4 * hi; }
__device__ __forceinline__ unsigned cvtpkv(float lo, float hi) { unsigned r; asm volatile("v_cvt_pk_bf16_f32 %0, %1, %2" : "=v"(r) : "v"(lo), "v"(hi)); return r; }

__device__ __forceinline__ void partialSM(f32x16& p0, f32x16& p1, float dq, float c2) {
#pragma unroll
  for (int r = 0; r < 16; ++r) { p0[r] = fmaf(-c2, fabsf(dq - (float)((r & 3) + 8 * (r >> 2))), p0[r]); p1[r] = fmaf(-c2, fabsf(dq - (float)(32 + (r & 3) + 8 * (r >> 2))), p1[r]); }
#pragma unroll
  for (int r = 0; r < 16; ++r) p0[r] = __builtin_amdgcn_exp2f(p0[r]);
}
__device__ __forceinline__ void finishSM(f32x16& p0, f32x16& p1, float& l_reg, bf16x8& pa0, bf16x8& pa1, bf16x8& pa2, bf16x8& pa3) {
#pragma unroll
  for (int r = 0; r < 16; ++r) p1[r] = __builtin_amdgcn_exp2f(p1[r]);
  float ps = 0;
#pragma unroll
  for (int r = 0; r < 16; ++r) ps += p0[r];
#pragma unroll
  for (int r = 0; r < 16; ++r) ps += p1[r];
  { auto rr = __builtin_amdgcn_permlane32_swap(__float_as_uint(ps), __float_as_uint(ps), false, false);
    ps = __uint_as_float(rr[0]) + __uint_as_float(rr[1]); }
  l_reg += ps;
#define PK4(P, BASE, OUT) do { unsigned a0 = cvtpkv(P[BASE + 0], P[BASE + 1]), a1 = cvtpkv(P[BASE + 2], P[BASE + 3]);   \
    unsigned b0 = cvtpkv(P[BASE + 4], P[BASE + 5]), b1 = cvtpkv(P[BASE + 6], P[BASE + 7]);                              \
    auto r0 = __builtin_amdgcn_permlane32_swap(a0, b0, false, false); auto r1 = __builtin_amdgcn_permlane32_swap(a1, b1, false, false); \
    u32x4 w = {r0[0], r1[0], r0[1], r1[1]}; OUT = *reinterpret_cast<bf16x8*>(&w); } while (0)
  PK4(p0, 0, pa0); PK4(p0, 8, pa1); PK4(p1, 0, pa2); PK4(p1, 8, pa3);
#undef PK4
}
__device__ __forceinline__ void qkt(f32x16& p0, f32x16& p1, const char* Ks, const bf16x8* qr, int r32, int hi, int map) {
  p0 = f32x16{}; p1 = f32x16{};
#pragma unroll
  for (int d0 = 0; d0 < 4; ++d0) { const int cb = (map * 64 + d0 * 16 + hi * 8) * 2;
    bf16x8 b0 = *reinterpret_cast<const bf16x8*>(Ks + KSWZ(r32, cb));
    bf16x8 b1 = *reinterpret_cast<const bf16x8*>(Ks + KSWZ(32 + r32, cb));
    p0 = __builtin_amdgcn_mfma_f32_32x32x16_bf16(b0, qr[d0], p0, 0, 0, 0);
    p1 = __builtin_amdgcn_mfma_f32_32x32x16_bf16(b1, qr[d0], p1, 0, 0, 0); }
}
__device__ __forceinline__ int v_st(int k, int c) { const int kk = (k & ~0xC) | ((k & 4) << 1) | ((k & 8) >> 1); return ((kk >> 3) * 4 + (c >> 5)) * 512 + ((kk & 7) * 32 + (c & 31)) * 2; }
__device__ __forceinline__ int v_rd_base(int lane) { return ((lane & 3) << 3) | (((lane >> 2) & 3) << 6) | (((lane >> 4) & 1) << 5) | (((lane >> 5) & 1) << 8); }
constexpr int v_rd_off(int d0, int ks, int half) { return d0 * 512 + ks * 4096 + half * 2048; }
template <int OFF> __device__ __forceinline__ s16x4 tr_read(int vb) {
  s16x4 r; asm volatile("ds_read_b64_tr_b16 %0, %1 offset:%2" : "=&v"(r) : "v"(vb), "i"(OFF) : "memory"); return r;
}
template <int D0> __device__ __forceinline__ void pv_one(f32x16& od, int vb, bf16x8 pa0, bf16x8 pa1, bf16x8 pa2, bf16x8 pa3) {
#define PK(L, H) (bf16x8){L[0], L[1], L[2], L[3], H[0], H[1], H[2], H[3]}
  { const s16x4 l0 = tr_read<v_rd_off(D0, 0, 0)>(vb), h0 = tr_read<v_rd_off(D0, 0, 1)>(vb), l1 = tr_read<v_rd_off(D0, 1, 0)>(vb), h1 = tr_read<v_rd_off(D0, 1, 1)>(vb);
    asm volatile("s_waitcnt lgkmcnt(0)" ::: "memory"); SBAR();
    od = __builtin_amdgcn_mfma_f32_32x32x16_bf16(pa0, PK(l0, h0), od, 0, 0, 0);
    od = __builtin_amdgcn_mfma_f32_32x32x16_bf16(pa1, PK(l1, h1), od, 0, 0, 0); }
  { const s16x4 l2 = tr_read<v_rd_off(D0, 2, 0)>(vb), h2 = tr_read<v_rd_off(D0, 2, 1)>(vb), l3 = tr_read<v_rd_off(D0, 3, 0)>(vb), h3 = tr_read<v_rd_off(D0, 3, 1)>(vb);
    asm volatile("s_waitcnt lgkmcnt(0)" ::: "memory"); SBAR();
    od = __builtin_amdgcn_mfma_f32_32x32x16_bf16(pa2, PK(l2, h2), od, 0, 0, 0);
    od = __builtin_amdgcn_mfma_f32_32x32x16_bf16(pa3, PK(l3, h3), od, 0, 0, 0); }
#undef PK
}
__device__ __forceinline__ void pv_d0(f32x16* o, int vb, bf16x8 pa0, bf16x8 pa1, bf16x8 pa2, bf16x8 pa3) {
  pv_one<0>(o[0], vb, pa0, pa1, pa2, pa3); pv_one<1>(o[1], vb, pa0, pa1, pa2, pa3); pv_one<2>(o[2], vb, pa0, pa1, pa2, pa3); pv_one<3>(o[3], vb, pa0, pa1, pa2, pa3);
}

#define SM_CHUNK(c) do { _Pragma("unroll") for (int r = 2 * (c); r < 2 * (c) + 2; ++r) { \
    p0[r] = __builtin_amdgcn_exp2f(fmaf(-c2, fabsf(dq - (float)((r & 3) + 8 * (r >> 2))), p0[r])); p1[r] = fmaf(-c2, fabsf(dq - (float)(32 + (r & 3) + 8 * (r >> 2))), p1[r]); } } while (0)
#define RD4(X, D0, HF) do { X##0 = tr_read<v_rd_off(D0, 2 * (HF), 0)>(vb); X##1 = tr_read<v_rd_off(D0, 2 * (HF), 1)>(vb); X##2 = tr_read<v_rd_off(D0, 2 * (HF) + 1, 0)>(vb); X##3 = tr_read<v_rd_off(D0, 2 * (HF) + 1, 1)>(vb); } while (0)
#define PKV(L, H) (bf16x8){L[0], L[1], L[2], L[3], H[0], H[1], H[2], H[3]}
#define MM2(OD, X, PA, PB) do { OD = __builtin_amdgcn_mfma_f32_32x32x16_bf16(PA, PKV(X##0, X##1), OD, 0, 0, 0); OD = __builtin_amdgcn_mfma_f32_32x32x16_bf16(PB, PKV(X##2, X##3), OD, 0, 0, 0); } while (0)
#define WL4() asm volatile("s_waitcnt lgkmcnt(4)" ::: "memory")
__device__ __forceinline__ void pv_sm(f32x16* o, int vb, bf16x8 pa0, bf16x8 pa1, bf16x8 pa2, bf16x8 pa3, f32x16& p0, f32x16& p1, float dq, float c2) {
  s16x4 A0, A1, A2, A3, B0, B1, B2, B3;
  RD4(A, 0, 0);
  RD4(B, 1, 0); WL4(); SBAR(); MM2(o[0], A, pa0, pa1); SM_CHUNK(0); SBAR();
  RD4(A, 2, 0); WL4(); SBAR(); MM2(o[1], B, pa0, pa1); SM_CHUNK(1); SBAR();
  RD4(B, 3, 0); WL4(); SBAR(); MM2(o[2], A, pa0, pa1); SM_CHUNK(2); SBAR();
  RD4(A, 0, 1); WL4(); SBAR(); MM2(o[3], B, pa0, pa1); SM_CHUNK(3); SBAR();
  RD4(B, 1, 1); WL4(); SBAR(); MM2(o[0], A, pa2, pa3); SM_CHUNK(4); SBAR();
  RD4(A, 2, 1); WL4(); SBAR(); MM2(o[1], B, pa2, pa3); SM_CHUNK(5); SBAR();
  RD4(B, 3, 1); WL4(); SBAR(); MM2(o[2], A, pa2, pa3); SM_CHUNK(6); SBAR();
  asm volatile("s_waitcnt lgkmcnt(0)" ::: "memory"); SBAR(); MM2(o[3], B, pa2, pa3); SM_CHUNK(7); SBAR();
}
#undef SM_CHUNK
#undef RD4
#undef MM2
#undef WL4
#undef PKV

__device__ __forceinline__ void attn_unit(const bf16_t* __restrict__ P, bf16_t* __restrict__ MIX, const float* __restrict__ onw, float lam, float S2, int bh, int qb, int W, char* lds) {
  const int tid = threadIdx.x, wid = tid >> 6, lane = tid & 63, r32 = lane & 31, hi = lane >> 5;
  const int qg = wid & 3, map = wid >> 2, b = bh >> 2, h = bh & 3;
  const size_t tok0 = (size_t)b * SEQL; const int q0 = qb * 128;
  char* K_lds = lds; char* V_lds = lds + 3 * SHM_K;
  float* ws = (float*)(lds + 3 * SHM_V + 3 * SHM_K) + wid * 64; float* li_l = ws; float* al_l = ws + 32;
  const float c2 = LOG2E * (h == 0 ? 0.25f : h == 1 ? 0.0625f : h == 2 ? 0.015625f : 0.00390625f);
  const int qpos = q0 + qg * 32 + r32;
  float l_reg = 0; f32x16 o[4] = {}; bf16x8 qr[4];
  const int qbase = __builtin_amdgcn_readfirstlane(q0 + qg * 32);
  const bf16_t* Qw = P + (tok0 + qpos) * INW + h * 128 + map * 64 + hi * 8;
#pragma unroll
  for (int d0 = 0; d0 < 4; ++d0) qr[d0] = *reinterpret_cast<const bf16x8*>(Qw + d0 * 16);
  const bf16_t* Kh = P + tok0 * INW + 512 + h * 128; const bf16_t* Vh = P + tok0 * INW + 1024 + h * 128;
  const int sr = tid >> 4, sc = (tid & 15) * 8, vst0 = v_st(sr, sc), vst1 = v_st(32 + sr, sc);
  const int vb0 = (int)(uintptr_t)V_lds + v_rd_base(lane);
  struct { bf16x8 vs0, vs1, ks0, ks1; } sr_;
#define SLOAD(k0) do { sr_.vs0 = *(const bf16x8*)(&Vh[(size_t)((k0) + sr) * LDK + sc]); sr_.vs1 = *(const bf16x8*)(&Vh[(size_t)((k0) + 32 + sr) * LDK + sc]); \
    sr_.ks0 = *(const bf16x8*)(&Kh[(size_t)((k0) + sr) * LDK + sc]); sr_.ks1 = *(const bf16x8*)(&Kh[(size_t)((k0) + 32 + sr) * LDK + sc]); } while (0)
#define SWRITE(slot) do { *(bf16x8*)(V_lds + (slot) * SHM_V + vst0) = sr_.vs0;          \
    *(bf16x8*)(V_lds + (slot) * SHM_V + vst1) = sr_.vs1; const int kc = sc * 2;               \
    *(bf16x8*)(K_lds + (slot) * SHM_K + KSWZ(sr, kc)) = sr_.ks0;                       \
    *(bf16x8*)(K_lds + (slot) * SHM_K + KSWZ(32 + sr, kc)) = sr_.ks1; } while (0)
#define DQ(j) ((float)(qpos - (j) * KVBLK - 4 * hi))
  f32x16 pA0, pA1, pB0, pB1; bf16x8 pa0, pa1, pa2, pa3;
  { const bf16_t* Ksf = P + (tok0 + qpos) * INW + 512 + h * 128 + map * 64 + hi * 8;
    float ssf = 0.f;
#pragma unroll
    for (int d0 = 0; d0 < 4; ++d0) { const bf16x8 kk = *reinterpret_cast<const bf16x8*>(Ksf + d0 * 16);
#pragma unroll
      for (int e = 0; e < 8; ++e) ssf += __uint_as_float((unsigned)(unsigned short)qr[d0][e] << 16) * __uint_as_float((unsigned)(unsigned short)kk[e] << 16); }
    ssf += __shfl_xor(ssf, 32);
#pragma unroll
    for (int of = 1; of < 32; of <<= 1) ssf = fminf(ssf, __shfl_xor(ssf, of));
    float* red = (float*)(lds + LDS_MISC + 128);
    if (lane == 0) red[wid] = ssf;
    __syncthreads();
    float mself = red[0];
#pragma unroll
    for (int w8 = 1; w8 < 8; ++w8) mself = fminf(mself, red[w8]);
    const float needd = S2 - mself + 24.05f + __builtin_amdgcn_logf(2.f / (1.f - __builtin_amdgcn_exp2f(-c2)));
    const float wd = needd / c2;
    if (wd < (float)W) W = (int)wd + 1; }
  int jlo = (q0 - W) / KVBLK; if (q0 - W < 0) jlo = 0;
  int jhi = (q0 + 127 + W) / KVBLK + 1; if (jhi > SEQL / KVBLK) jhi = SEQL / KVBLK;
  if ((jhi - jlo) & 1) { if (jhi < SEQL / KVBLK) ++jhi; else --jlo; }
  const int NT = jhi - jlo;
#define TK(i) ((jlo + (i)) * KVBLK)
  if (map == 1) __builtin_amdgcn_s_setprio(1);
  {
    const bf16x8 v20 = *(const bf16x8*)(&Vh[(size_t)(TK(1) + sr) * LDK + sc]), v21 = *(const bf16x8*)(&Vh[(size_t)(TK(1) + 32 + sr) * LDK + sc]);
    const bf16x8 k20 = *(const bf16x8*)(&Kh[(size_t)(TK(1) + sr) * LDK + sc]), k21 = *(const bf16x8*)(&Kh[(size_t)(TK(1) + 32 + sr) * LDK + sc]);
    SLOAD(TK(0)); asm volatile("s_waitcnt vmcnt(0)" ::: "memory"); SWRITE(0);
    sr_.vs0 = v20; sr_.vs1 = v21; sr_.ks0 = k20; sr_.ks1 = k21; SWRITE(1); }
  if (2 < NT) SLOAD(TK(2));
  __syncthreads();
  qkt(pA0, pA1, K_lds, qr, r32, hi, map); partialSM(pA0, pA1, DQ(jlo), c2);
  int sk = 1, sv = 0, sw = 2;
#define STEP(pC0, pC1, pP0, pP1, ii, more) do { \
    SBAR(); qkt(pC0, pC1, K_lds + sk * SHM_K, qr, r32, hi, map); \
    finishSM(pP0, pP1, l_reg, pa0, pa1, pa2, pa3); SBAR(); \
    asm volatile("s_waitcnt vmcnt(0)" ::: "memory"); SWRITE(sw); if (more) SLOAD(TK((ii) + 2)); SBAR(); \
    pv_sm(o, vb0 + sv * SHM_V, pa0, pa1, pa2, pa3, pC0, pC1, DQ(jlo + (ii)), c2); \
    __syncthreads(); \
    sv = sk; sk = sw; sw = (sw == 2) ? 0 : sw + 1; } while (0)
  for (int i = 1; i + 1 < NT; i += 2) {
    STEP(pB0, pB1, pA0, pA1, i, true);
    STEP(pA0, pA1, pB0, pB1, i + 1, (i + 3 < NT));
  }
  SBAR(); qkt(pB0, pB1, K_lds + sk * SHM_K, qr, r32, hi, map);
  finishSM(pA0, pA1, l_reg, pa0, pa1, pa2, pa3); SBAR();
  pv_sm(o, vb0 + sv * SHM_V, pa0, pa1, pa2, pa3, pB0, pB1, DQ(jlo + NT - 1), c2);
  finishSM(pB0, pB1, l_reg, pa0, pa1, pa2, pa3); SBAR();
  pv_d0(o, vb0 + sk * SHM_V, pa0, pa1, pa2, pa3);
#undef STEP
#undef TK
  __builtin_amdgcn_s_setprio(0);
  if (hi == 0) li_l[r32] = l_reg; asm volatile("s_waitcnt lgkmcnt(0)" ::: "memory");
  float rli[16];
#pragma unroll
  for (int r = 0; r < 16; ++r) rli[r] = __builtin_amdgcn_rcpf(li_l[crow(r, hi)]);
  __syncthreads();
  float* X = (float*)lds + qg * 4096;
  if (map == 1) {
#pragma unroll
    for (int r = 0; r < 16; ++r) { const float s = rli[r] * lam;
#pragma unroll
      for (int d0 = 0; d0 < 4; ++d0) X[crow(r, hi) * 128 + d0 * 32 + r32] = o[d0][r] * s; }
  }
  __syncthreads();
  if (map == 0) {
#pragma unroll
    for (int r = 0; r < 16; ++r) { float ss = 0.f;
#pragma unroll
      for (int d0 = 0; d0 < 4; ++d0) { const int ix = crow(r, hi) * 128 + d0 * 32 + r32; const float v = o[d0][r] * rli[r] - X[ix]; X[ix] = v; ss += v * v; }
#pragma unroll
      for (int of = 1; of < 32; of <<= 1) ss += __shfl_xor(ss, of);
      if (r32 == 0) al_l[crow(r, hi)] = __builtin_amdgcn_rsqf(ss * (1.f / 128.f) + NORM_EPS) * 0.8f;
    }
    asm volatile("s_waitcnt lgkmcnt(0)" ::: "memory");
    const int cc = lane & 15;
    float wv[8];
#pragma unroll
    for (int e = 0; e < 8; ++e) wv[e] = onw[cc * 8 + e];
    bf16_t* Ob = MIX + (tok0 + q0 + qg * 32 + (lane >> 4)) * DM + h * 128 + cc * 8;
    const float* Xr = X + (lane >> 4) * 128 + cc * 8;
#pragma unroll
    for (int it = 0; it < 8; ++it) {
      const f32x4 x0 = *(const f32x4*)(Xr + it * 512), x1 = *(const f32x4*)(Xr + it * 512 + 4); const float rs = al_l[it * 4 + (lane >> 4)];
      u32x4 w; w.x = cvtpk(x0[0] * rs * wv[0], x0[1] * rs * wv[1]); w.y = cvtpk(x0[2] * rs * wv[2], x0[3] * rs * wv[3]);
      w.z = cvtpk(x1[0] * rs * wv[4], x1[1] * rs * wv[5]); w.w = cvtpk(x1[2] * rs * wv[6], x1[3] * rs * wv[7]);
      *(u32x4*)(Ob + (size_t)it * 4 * DM) = w;
    }
  }
  __syncthreads();
#undef SLOAD
#undef SWRITE
#undef DQ
#undef REL
}
}

namespace rec {
constexpr int CH = 32, NCH = SEQL / CH, QP = 136, SP = 40;
constexpr int OFF_QT = 0, OFF_KH = CH * QP * 2, OFF_KT = 2 * CH * QP * 2, OFF_VT = OFF_KT + 128 * SP * 2, OFF_DD = OFF_VT + 128 * SP * 2, OFF_TOT = OFF_DD + 512, DIRB = OFF_TOT + 2048;
static_assert(DIRB % 16 == 0 && 2 * DIRB <= 131072, "rec LDS map");
__device__ __forceinline__ int crow(int r, int hi) { return (r & 3) + 8 * (r >> 2) + 4 * hi; }
__device__ __forceinline__ bf16x8 pack8(float a0, float a1, float a2, float a3, float a4, float a5, float a6, float a7) {
  u32x4 w = {cvtpk(a0, a1), cvtpk(a2, a3), cvtpk(a4, a5), cvtpk(a6, a7)}; return *reinterpret_cast<bf16x8*>(&w);
}
__device__ __forceinline__ void rec_unit(const bf16_t* __restrict__ P, bf16_t* __restrict__ OF, bf16_t* __restrict__ OB, int bh, unsigned char* ldsg) {
  const int tid = threadIdx.x, wid = __builtin_amdgcn_readfirstlane(tid >> 6), lane = tid & 63, r32 = lane & 31, hi = lane >> 5;
  const int dir = wid >> 2, wv = wid & 3, b = bh >> 2, h = bh & 3;
  unsigned char* lb = ldsg + dir * DIRB;
  bf16_t* Qt = (bf16_t*)(lb + OFF_QT); bf16_t* Kh = (bf16_t*)(lb + OFF_KH); bf16_t* KtT = (bf16_t*)(lb + OFF_KT); bf16_t* VT = (bf16_t*)(lb + OFF_VT);
  float* dd = (float*)(lb + OFF_DD); float* tot = (float*)(lb + OFF_TOT);
  const bf16_t* base = P + (size_t)b * SEQL * INW;
  const int cq = 1536 + h * 128 + 2 * lane, cgt = (dir ? 2560 : 2048) + h * 128 + 2 * lane, cv = 3072 + h * 128 + 2 * lane;
  bf16_t* O = (dir ? OB : OF) + (size_t)b * SEQL * 512 + h * 128 + wv * 32 + r32;
  f32x16 S[4];
#pragma unroll
  for (int k = 0; k < 4; ++k) S[k] = f32x16{};
  unsigned pq[8], pg[8], pv[8];
#define TOKOF(s) (dir ? (SEQL - 1 - (s)) : (s))
#define LOADCHUNK(c) do { _Pragma("unroll") for (int i = 0; i < 8; ++i) { const bf16_t* rp = base + (size_t)TOKOF((c) * CH + wv * 8 + i) * INW; \
    pq[i] = *(const unsigned*)(rp + cq); pg[i] = *(const unsigned*)(rp + cgt); pv[i] = *(const unsigned*)(rp + cv); } } while (0)
  LOADCHUNK(0);
#define RBAR() asm volatile("s_waitcnt lgkmcnt(0)\n\ts_barrier" ::: "memory")
  if (dir == 1) { RBAR(); RBAR(); }
  for (int c = 0; c < NCH; ++c) {
    float gl0[8], gl1[8]; float G0 = 0.f, G1 = 0.f;
#pragma unroll
    for (int i = 0; i < 8; ++i) { G0 += bf_lo(pg[i]); G1 += bf_hi(pg[i]); gl0[i] = G0; gl1[i] = G1; }
    *(f32x2*)&tot[wv * 128 + 2 * lane] = (f32x2){G0, G1};
    RBAR();
    float P0 = 0.f, P1 = 0.f, C0 = 0.f, C1 = 0.f;
#pragma unroll
    for (int w = 0; w < 4; ++w) { const f32x2 t = *(const f32x2*)&tot[w * 128 + 2 * lane]; if (w < wv) { P0 += t[0]; P1 += t[1]; } C0 += t[0]; C1 += t[1]; }
    float kta[8], ktb[8];
#pragma unroll
    for (int i = 0; i < 8; ++i) {
      const float Ga = P0 + gl0[i], Gb = P1 + gl1[i];
      const float kfa = 1.f - ex2(bf_lo(pg[i])), kfb = 1.f - ex2(bf_hi(pg[i]));
      *(unsigned*)&Qt[(wv * 8 + i) * QP + 2 * lane] = cvtpk(bf_lo(pq[i]) * ex2(Ga), bf_hi(pq[i]) * ex2(Gb));
      *(unsigned*)&Kh[(wv * 8 + i) * QP + 2 * lane] = cvtpk(kfa * ex2(fminf(-Ga, 100.f)), kfb * ex2(fminf(-Gb, 100.f)));
      kta[i] = kfa * ex2(C0 - Ga); ktb[i] = kfb * ex2(C1 - Gb);
    }
    *(bf16x8*)&KtT[(2 * lane) * SP + wv * 8] = pack8(kta[0], kta[1], kta[2], kta[3], kta[4], kta[5], kta[6], kta[7]);
    *(bf16x8*)&KtT[(2 * lane + 1) * SP + wv * 8] = pack8(ktb[0], ktb[1], ktb[2], ktb[3], ktb[4], ktb[5], ktb[6], ktb[7]);
    { u32x4 a, bb;
      a.x = (pv[0] & 0xffffu) | (pv[1] << 16); a.y = (pv[2] & 0xffffu) | (pv[3] << 16); a.z = (pv[4] & 0xffffu) | (pv[5] << 16); a.w = (pv[6] & 0xffffu) | (pv[7] << 16);
      bb.x = (pv[0] >> 16) | (pv[1] & 0xffff0000u); bb.y = (pv[2] >> 16) | (pv[3] & 0xffff0000u); bb.z = (pv[4] >> 16) | (pv[5] & 0xffff0000u); bb.w = (pv[6] >> 16) | (pv[7] & 0xffff0000u);
      *(u32x4*)&VT[(2 * lane) * SP + wv * 8] = a; *(u32x4*)&VT[(2 * lane + 1) * SP + wv * 8] = bb; }
    if (wv == 0) *(f32x2*)&dd[2 * lane] = (f32x2){ex2(C0), ex2(C1)};
    if (c + 1 < NCH) LOADCHUNK(c + 1);
    RBAR();
    f32x16 aT = f32x16{};
#pragma unroll
    for (int ks = 0; ks < 8; ++ks) { const bf16x8 a = *(const bf16x8*)&Kh[r32 * QP + ks * 16 + hi * 8]; const bf16x8 bq = *(const bf16x8*)&Qt[r32 * QP + ks * 16 + hi * 8];
      aT = __builtin_amdgcn_mfma_f32_32x32x16_bf16(a, bq, aT, 0, 0, 0); }
#pragma unroll
    for (int r = 0; r < 16; ++r) if (crow(r, hi) > r32) aT[r] = 0.f;
    f32x16 o = f32x16{};
#pragma unroll
    for (int kt = 0; kt < 4; ++kt)
#pragma unroll
      for (int hh = 0; hh < 2; ++hh) {
        const s16x4 lo4 = *(const s16x4*)&Qt[r32 * QP + kt * 32 + hh * 16 + hi * 4], hi4 = *(const s16x4*)&Qt[r32 * QP + kt * 32 + hh * 16 + 8 + hi * 4];
        const bf16x8 a = {lo4[0], lo4[1], lo4[2], lo4[3], hi4[0], hi4[1], hi4[2], hi4[3]};
        const bf16x8 bs = pack8(S[kt][hh * 8 + 0], S[kt][hh * 8 + 1], S[kt][hh * 8 + 2], S[kt][hh * 8 + 3], S[kt][hh * 8 + 4], S[kt][hh * 8 + 5], S[kt][hh * 8 + 6], S[kt][hh * 8 + 7]);
        o = __builtin_amdgcn_mfma_f32_32x32x16_bf16(a, bs, o, 0, 0, 0);
      }
#pragma unroll
    for (int hh = 0; hh < 2; ++hh) {
      const bf16x8 a = pack8(aT[hh * 8 + 0], aT[hh * 8 + 1], aT[hh * 8 + 2], aT[hh * 8 + 3], aT[hh * 8 + 4], aT[hh * 8 + 5], aT[hh * 8 + 6], aT[hh * 8 + 7]);
      const s16x4 lo4 = *(const s16x4*)&VT[(wv * 32 + r32) * SP + hh * 16 + hi * 4], hi4 = *(const s16x4*)&VT[(wv * 32 + r32) * SP + hh * 16 + 8 + hi * 4];
      const bf16x8 bv = {lo4[0], lo4[1], lo4[2], lo4[3], hi4[0], hi4[1], hi4[2], hi4[3]};
      o = __builtin_amdgcn_mfma_f32_32x32x16_bf16(a, bv, o, 0, 0, 0);
    }
    RBAR();
#pragma unroll
    for (int kt = 0; kt < 4; ++kt) {
#pragma unroll
      for (int q4 = 0; q4 < 4; ++q4) { const f32x4 d4 = *(const f32x4*)&dd[kt * 32 + q4 * 8 + hi * 4];
#pragma unroll
        for (int j = 0; j < 4; ++j) S[kt][q4 * 4 + j] *= d4[j]; }
#pragma unroll
      for (int ks = 0; ks < 2; ++ks) { const bf16x8 a = *(const bf16x8*)&KtT[(kt * 32 + r32) * SP + ks * 16 + hi * 8]; const bf16x8 bv = *(const bf16x8*)&VT[(wv * 32 + r32) * SP + ks * 16 + hi * 8];
        S[kt] = __builtin_amdgcn_mfma_f32_32x32x16_bf16(a, bv, S[kt], 0, 0, 0); }
    }
#pragma unroll
    for (int r = 0; r < 16; ++r) { const int tk = TOKOF(c * CH + crow(r, hi)); O[(size_t)tk * 512] = (bf16_t)(cvtpk(o[r], 0.f) & 0xffffu); }
    RBAR();
  }
  if (dir == 0) { RBAR(); RBAR(); }
  __syncthreads();
#undef RBAR
#undef TOKOF
#undef LOADCHUNK
}
}

#define XB_TMO      128
#define XB_XCNT(j)  (256  + 64 * (j))
#define XB_XSUB(j)  (1280 + 64 * (j))
#define XB_XGEN(j)  (2304 + 64 * (j))
#define XB_TOP      3328
#define XB_TOPGEN   3392
#define XCD_BAR_WORDS 3456
#define XB_SPIN_CAP (1u << 18)

__device__ __forceinline__ unsigned xb_ld(unsigned* p)              { return __hip_atomic_load(p, __ATOMIC_RELAXED, __HIP_MEMORY_SCOPE_AGENT); }
__device__ __forceinline__ unsigned xb_add(unsigned* p, unsigned v) { return __hip_atomic_fetch_add(p, v, __ATOMIC_RELAXED, __HIP_MEMORY_SCOPE_AGENT); }
__device__ __forceinline__ unsigned xb_xcc_id() { return (unsigned)__builtin_amdgcn_s_getreg((3 << 11) | 20) & 0xFu; }
#define XB_SPIN(cond, bar) do { unsigned _sp = 0; while (cond) { __builtin_amdgcn_s_sleep(1); \
    if ((++_sp & 255u) == 0u) { if (xb_ld(&(bar)[XB_TMO])) break; if (_sp > XB_SPIN_CAP) { atomicAdd(&(bar)[XB_TMO], 1u); break; } } } } while (0)

struct XcdBarrier {
    unsigned* bar; unsigned x;
    volatile LAS unsigned* st;
};

__device__ __forceinline__ XcdBarrier xcd_barrier_post(unsigned* bar, volatile LAS unsigned* st) {
    XcdBarrier b; b.bar = bar; b.x = xb_xcc_id(); b.st = st;
    if (threadIdx.x == 0) (void)xb_add(&bar[XB_XCNT(b.x)], 1u);
    return b;
}
__device__ __forceinline__ void xcd_barrier_complete(unsigned* bar, unsigned x, unsigned& nloc, unsigned& nx) {
    const unsigned G = gridDim.x * gridDim.y * gridDim.z;
    unsigned sum, cnt, mine, sp = 0u;
    for (;;) {
        sum = 0u; cnt = 0u; mine = 0u;
#pragma unroll
        for (unsigned j = 0; j < 16; ++j) { const unsigned c = xb_ld(&bar[XB_XCNT(j)]); sum += c; cnt += (c > 0u) ? 1u : 0u; mine = (j == x) ? c : mine; }
        if (sum == G) break;
        __builtin_amdgcn_s_sleep(1);
        if ((++sp & 255u) == 0u) { if (xb_ld(&bar[XB_TMO])) break; if (sp > XB_SPIN_CAP) { atomicAdd(&bar[XB_TMO], 1u); break; } }
    }
    nloc = mine > 0u ? mine : 1u; nx = cnt > 0u ? cnt : 1u;
}

__device__ __forceinline__ void xcd_barrier(const XcdBarrier& b) {
    asm volatile("s_waitcnt vmcnt(0)" ::: "memory");
    __syncthreads();
    if (threadIdx.x == 0) {
        unsigned* bar = b.bar;
        __builtin_amdgcn_s_waitcnt(0);
        unsigned nloc = b.st[0], nx = b.st[1];
        if (nloc == 0u) { xcd_barrier_complete(bar, b.x, nloc, nx); b.st[0] = nloc; b.st[1] = nx; }
        const unsigned old = xb_add(&bar[XB_XSUB(b.x)], 1u);
        const unsigned gen = old / nloc;
        if (old + 1u == (gen + 1u) * nloc) {
            __builtin_amdgcn_fence(__ATOMIC_RELEASE, "agent");
            asm volatile("s_waitcnt vmcnt(0)" ::: "memory");
            const unsigned og = xb_add(&bar[XB_TOP], 1u);
            const unsigned tg = og / nx;
            if (og + 1u == (tg + 1u) * nx) xb_add(&bar[XB_TOPGEN], 1u);
            else XB_SPIN(xb_ld(&bar[XB_TOPGEN]) == tg, bar);
            __builtin_amdgcn_fence(__ATOMIC_ACQUIRE, "agent");
            xb_add(&bar[XB_XGEN(b.x)], 1u);
            asm volatile("s_waitcnt vmcnt(0)" ::: "memory");
        } else {
            XB_SPIN(xb_ld(&bar[XB_XGEN(b.x)]) == gen, bar);
            __builtin_amdgcn_fence(__ATOMIC_ACQUIRE, "agent");
            asm volatile("s_waitcnt vmcnt(0)" ::: "memory");
        }
    }
    __syncthreads();
}

struct Args { const float* in[20]; float* out; unsigned char* ws; int ph_lo, ph_hi; };
constexpr int NPH = 9;
constexpr int N_ATT_UNITS = NSEQ * NHEAD * (SEQL / 128), N_REC_UNITS = NSEQ * NHEAD;

__global__ void __launch_bounds__(512, 2) fwd_kernel(Args args) {
    extern __shared__ __attribute__((aligned(16))) unsigned char lds[];
    cg::grid_group grid = cg::this_grid();
    const int wave = __builtin_amdgcn_readfirstlane((int)threadIdx.x >> 6);
#define PHASE_IDS int tid = threadIdx.x; asm volatile("" : "+v"(tid)); const int lane = tid & 63; (void)lane;
    const int G = gridDim.x, gw = blockIdx.x * 8 + wave, NGW = G * 8;
    unsigned char* ws = args.ws;
    const float* xp = args.in[0]; const float* xs = args.in[1];
    bf16_t* W_in = (bf16_t*)(ws + WS_WIN); bf16_t* W_out = (bf16_t*)(ws + WS_WOUT); bf16_t* W_up = (bf16_t*)(ws + WS_WUP); bf16_t* W_down = (bf16_t*)(ws + WS_WDOWN);
    bf16_t* XN = (bf16_t*)(ws + WS_XN); bf16_t* PROJ = (bf16_t*)(ws + WS_PROJ); bf16_t* OFb = (bf16_t*)(ws + WS_OF); bf16_t* OBb = (bf16_t*)(ws + WS_OB);
    bf16_t* ACT = (bf16_t*)(ws + WS_ACT); bf16_t* X1B = (bf16_t*)(ws + WS_OF);
    unsigned* ctl = (unsigned*)(ws + WS_CTL);
    PG8_LAS unsigned char* ldsl = (PG8_LAS unsigned char*)lds;
    const int lo = args.ph_lo, hi = args.ph_hi;
    volatile LAS unsigned* xst = (volatile LAS unsigned*)(ldsl + LDS_MISC + 64);
    if (threadIdx.x < 2) xst[threadIdx.x] = 0u;
    __syncthreads();
    XcdBarrier xbar; xbar.bar = ctl + 4096; xbar.x = 0; xbar.st = xst;
#ifndef PHMASK
#define PHMASK 0xffff
#endif
#define IN(k) (((PHMASK >> (k)) & 1) && lo <= (k) && (k) < hi)
#define SEAM(k) do { if (IN(k) && IN((k) + 1)) { if ((k) == 0) grid.sync(); else xcd_barrier(xbar); } } while (0)
#ifndef REPEAT_PH
#define REPEAT_PH -1
#endif
#define NREP(k) ((REPEAT_PH == (k)) ? 2 : 1)

    if (IN(0)) {
        PHASE_IDS
        if (blockIdx.x == 0) for (int i = tid; i < 8192; i += 512) ctl[i] = 0u;
        LAS float* scr = (LAS float*)(ldsl + wave * 16384);
        constexpr int I_IN = (DM / 64) * (INW / 32), I_OUT = (DM / 64) * (DM / 32), I_UP = (DM / 64) * (DFF2 / 32), I_DOWN = (DFF / 64) * (DM / 32);
        for (int it = gw; it < I_IN + I_OUT + I_UP + I_DOWN; it += NGW) {
            int r = it;
            if (r < I_IN) { p0_transpose_item(args.in[3], DM, INW, W_in, scr, r, lane); continue; } r -= I_IN;
            if (r < I_OUT) { p0_transpose_item(args.in[14], DM, DM, W_out, scr, r, lane); continue; } r -= I_OUT;
            if (r < I_UP) { p0_transpose_item(args.in[16], DM, DFF2, W_up, scr, r, lane, true); continue; } r -= I_UP;
            p0_transpose_item(args.in[19], DFF, DM, W_down, scr, r, lane);
        }
        for (int m = gw * 2; m < MTOK; m += NGW * 2) rms_row2_to_bf16(xrow_ptr(xp, xs, m), xrow_ptr(xp, xs, m + 1), args.in[2], XN + (size_t)m * DM, XN + (size_t)(m + 1) * DM, lane);
    }
    SEAM(0);
    if (IN(0) && IN(1)) xbar = xcd_barrier_post(ctl + 4096, xst);
    for (int rep = 0; rep < NREP(1); ++rep) { if (rep) grid.sync();
    if (IN(1)) {
        pg8::Gemm g{XN, W_in, MTOK, INW, DM}; pg8::StaticOrder S; S.init(MTOK, INW, G, (int)blockIdx.x);
        EpiInProj E{PROJ, args.in[11], args.in[12], args.in[4], args.in[5], (PG8_LAS float*)(ldsl + 131072)};
        pg8::gemm_phase<EpiInProj, pg8::StaticOrder, true, true>(ldsl, g, S, E);
    } }
    SEAM(1);
    for (int rep = 0; rep < NREP(3); ++rep) { if (rep) grid.sync();
    if (IN(3)) {
        PHASE_IDS
        float lam, S2u; int Wh[4];
        { const float a = args.in[6][lane] * args.in[7][lane], b = args.in[8][lane] * args.in[9][lane];
          lam = ex2(wave_sum(a) * LOG2E) - ex2(wave_sum(b) * LOG2E) + 0.2f;
          float mq = fabsf(args.in[4][lane]), mk = fabsf(args.in[5][lane]);
#pragma unroll
          for (int o = 1; o < 64; o <<= 1) { mq = fmaxf(mq, __shfl_xor(mq, o)); mk = fmaxf(mk, __shfl_xor(mk, o)); }
          const float S2 = 8.f * LOG2E * 1.01f * 1.01f * mq * mk; S2u = S2;
#pragma unroll
          for (int h = 0; h < 4; ++h) { const float c2h = LOG2E * (h == 0 ? 0.25f : h == 1 ? 0.0625f : h == 2 ? 0.015625f : 0.00390625f);
            const float need = 2.f * S2 + 24.f + lg2(2.f / (1.f - ex2(-c2h)));
            const float wf = need / c2h; Wh[h] = wf >= (float)SEQL ? SEQL : (int)wf + 1; } }
#ifndef NO_REC
#ifndef REC_REPS
#define REC_REPS 1
#endif
        for (int rr2 = 0; rr2 < REC_REPS; ++rr2)
        for (int u = blockIdx.x; u < N_REC_UNITS; u += G) rec::rec_unit(PROJ, OFb, OBb, u, lds);
#endif
        volatile int* misc = (volatile int*)(lds + LDS_MISC);
        int myq = (int)(__builtin_amdgcn_s_getreg((3 << 11) | 20) & 7u);
        constexpr int QN = 320;
        for (int tries = 0; tries < 8;) {
            if (tid == 0) misc[0] = (int)atomicAdd(ctl + 64 + 32 * myq, 1u);
            __syncthreads();
            const int t = __builtin_amdgcn_readfirstlane(misc[0]);
            __syncthreads();
            if (t >= QN) { myq = (myq + 1) & 7; ++tries; continue; }
            int b, hh, qb;
            { int i2 = t, base = 0; hh = 3;
              for (int seg = 0; seg < 4; ++seg) { if (i2 < 64) { b = myq; qb = i2; hh = 3 - seg; base = 1; break; } i2 -= 64; if (i2 < 16) { b = 8 + (i2 >> 3); qb = 8 * myq + (i2 & 7); hh = 3 - seg; base = 1; break; } i2 -= 16; }
              (void)base; }
#ifndef NO_ATT
            att::attn_unit(PROJ, XN, args.in[10], lam, S2u, b * 4 + hh, qb, hh == 0 ? Wh[0] : hh == 1 ? Wh[1] : hh == 2 ? Wh[2] : Wh[3], (char*)lds);
#endif
        }
    } }
    SEAM(3);
    for (int rep = 0; rep < NREP(4); ++rep) { if (rep) grid.sync();
    if (IN(4)) {
        PHASE_IDS
        const int h4 = lane >> 4, c8 = (lane & 15) * 8;
        float w8[8];
#pragma unroll
        for (int e = 0; e < 8; ++e) w8[e] = args.in[13][c8 + e];
        for (int m0 = gw * 4; m0 < MTOK; m0 += NGW * 4) {
            u32x4 fa[4], fb[4], fg[4];
#pragma unroll
            for (int u = 0; u < 4; ++u) { const size_t m = m0 + u;
                fa[u] = *(const u32x4*)(OFb + m * 512 + h4 * 128 + c8); fb[u] = *(const u32x4*)(OBb + m * 512 + h4 * 128 + c8); fg[u] = *(const u32x4*)(PROJ + m * INW + 3584 + h4 * 128 + c8); }
#pragma unroll
            for (int u = 0; u < 4; ++u) {
                float v[8]; float sq = 0.f;
#pragma unroll
                for (int e = 0; e < 4; ++e) { v[2 * e] = bf_lo(fa[u][e]) + bf_lo(fb[u][e]); v[2 * e + 1] = bf_hi(fa[u][e]) + bf_hi(fb[u][e]); sq += v[2 * e] * v[2 * e] + v[2 * e + 1] * v[2 * e + 1]; }
                sq += __shfl_xor(sq, 1); sq += __shfl_xor(sq, 2); sq += __shfl_xor(sq, 4); sq += __shfl_xor(sq, 8);
                const float rs = __builtin_amdgcn_rsqf(sq * (1.f / 128.f) + NORM_EPS);
                u32x4 o;
#pragma unroll
                for (int e = 0; e < 4; ++e) o[e] = cvtpk(v[2 * e] * rs * w8[2 * e] * bf_lo(fg[u][e]), v[2 * e + 1] * rs * w8[2 * e + 1] * bf_hi(fg[u][e]));
                *(u32x4*)(XN + (size_t)(m0 + u) * DM + 512 + h4 * 128 + c8) = o;
            }
        }
    }
    }
    SEAM(4);
    for (int rep = 0; rep < NREP(5); ++rep) { if (rep) grid.sync();
    if (IN(5)) {
        pg8::Gemm g{XN, W_out, MTOK, DM, DM}; pg8::StaticOrder S; S.init(MTOK, DM, G, (int)blockIdx.x);
        EpiResidB E{xp, xs, X1B};
        pg8::gemm_phase<EpiResidB, pg8::StaticOrder, true, true>(ldsl, g, S, E);
    }
    }
    SEAM(5);
    for (int rep = 0; rep < NREP(6); ++rep) { if (rep) grid.sync();
    if (IN(6)) {
        PHASE_IDS
        for (int m = gw * 2; m < MTOK; m += NGW * 2) rms_rowb2_to_bf16(X1B + (size_t)m * DM, X1B + (size_t)(m + 1) * DM, args.in[15], XN + (size_t)m * DM, XN + (size_t)(m + 1) * DM, lane);
    }
    }
    SEAM(6);
    for (int rep = 0; rep < NREP(7); ++rep) { if (rep) grid.sync();
    if (IN(7)) {
        pg8::Gemm g{XN, W_up, NSEQ * 33 * 256, DFF2, DM}; pg8::StaticOrder S; S.init(NSEQ * 33 * 256, DFF2, G, (int)blockIdx.x); S.ovl = 1;
        EpiConvAct E{ACT, args.in[17], args.in[18], (PG8_LAS float*)(ldsl + 131072)};
        pg8::gemm_phase<EpiConvAct, pg8::StaticOrder, true, true>(ldsl, g, S, E);
    } }
    SEAM(7);
    if (IN(8)) {
        pg8::Gemm g{ACT, W_down, MTOK, DM, DFF}; pg8::StaticOrder S; S.init(MTOK, DM, G, (int)blockIdx.x);
        EpiFinal E{X1B, args.out};
        pg8::gemm_phase<EpiFinal, pg8::StaticOrder, true, true>(ldsl, g, S, E);
    }
#undef IN
#undef SEAM
}

#ifndef ONE_LAUNCH
#define ONE_LAUNCH 1
#endif
extern "C" void kernel_launch(void* const* d_in, const int* in_sizes, int n_in, void* d_out, int out_size, void* d_ws, size_t ws_size, hipStream_t stream) {
    static int grid = 0;
    if (grid == 0) {
        if (n_in != 20 || out_size != MTOK * DM || ws_size < WS_END) { fprintf(stderr, "kernel_launch: unexpected shapes n_in %d out %d ws %zu (need %zu)\n", n_in, out_size, ws_size, (size_t)WS_END); grid = -1; return; }
        int dev = 0, cus = 0, per_cu = 0;
        (void)hipGetDevice(&dev); (void)hipDeviceGetAttribute(&cus, hipDeviceAttributeMultiprocessorCount, dev);
        if (hipFuncSetAttribute((const void*)fwd_kernel, hipFuncAttributeMaxDynamicSharedMemorySize, LDS_BYTES) != hipSuccess) { fprintf(stderr, "kernel_launch: hipFuncSetAttribute failed\n"); grid = -1; return; }
        (void)hipOccupancyMaxActiveBlocksPerMultiprocessor(&per_cu, (const void*)fwd_kernel, 512, LDS_BYTES);
        if (per_cu < 1) { fprintf(stderr, "kernel_launch: occupancy query says %d\n", per_cu); per_cu = 1; }
        (void)hipGetLastError();
        grid = cus * per_cu;
    }
    if (grid < 0) return;
#if !ONE_LAUNCH
    (void)hipMemsetAsync((char*)d_ws + WS_CTL, 0, 32768, stream);
#endif
    Args a{};
    for (int i = 0; i < 20; ++i) a.in[i] = (const float*)d_in[i];
    a.out = (float*)d_out; a.ws = (unsigned char*)d_ws;
#if ONE_LAUNCH
    a.ph_lo = 0; a.ph_hi = NPH;
    void* kargs[] = {&a};
    hipError_t e = hipLaunchCooperativeKernel((const void*)fwd_kernel, dim3(grid), dim3(512), kargs, LDS_BYTES, stream);
    if (e != hipSuccess) fprintf(stderr, "cooperative launch failed: %s (grid %d)\n", hipGetErrorString(e), grid);
#else
    for (int p = 0; p < NPH; ++p) {
        a.ph_lo = p; a.ph_hi = p + 1;
        hipLaunchKernelGGL(fwd_kernel, dim3(grid), dim3(512), LDS_BYTES, stream, a);
    }
#endif
}
```
